# Optimizing an MI355X kernel written in HIP

```python
import jax, jax.numpy as jnp
from jax import lax
import numpy as np

D_MODEL = 1024
BATCH = 8
SEQ = 4096
DEPTH = 1

HEAD_DIM = 64
N_HEADS = 8
N_KV_HEADS = 2
GQA_GROUP = N_HEADS // N_KV_HEADS
ATTN_WIDTH = N_HEADS * HEAD_DIM
KV_WIDTH = N_KV_HEADS * HEAD_DIM
POOL_WIDTH = D_MODEL // 2
POOL_WINDOWS = (2, 4, 8, 16)
N_POOL_GROUPS = len(POOL_WINDOWS)
POOL_GROUP_DIM = POOL_WIDTH // N_POOL_GROUPS
MAX_POOL_WINDOW = max(POOL_WINDOWS)
IN_WIDTH = ATTN_WIDTH + 2 * KV_WIDTH + POOL_WIDTH
MIX_WIDTH = ATTN_WIDTH + POOL_WIDTH

WINDOW = 128
BLOCK = 128
ROT_DIM = HEAD_DIM // 4
ROPE_THETA = 500000.0
D_FF = 4 * D_MODEL
N_MOD = 6
EPS = 1e-6
MAX_START = 1024

kernel_name = "hybrid_swa_sink_pool_adaln_block"


def rms_norm(x, g):
    xf = x.astype(jnp.float32)
    y = xf * lax.rsqrt(jnp.mean(xf * xf, axis=-1, keepdims=True) + EPS)
    return (y * g.astype(jnp.float32)).astype(x.dtype)


def apply_partial_rope(x, cos, sin):
    half = ROT_DIM // 2
    x1 = x[..., :half]
    x2 = x[..., half:ROT_DIM]
    cos = cos.astype(x.dtype)
    sin = sin.astype(x.dtype)
    return jnp.concatenate([x1 * cos - x2 * sin, x2 * cos + x1 * sin, x[..., ROT_DIM:]], axis=-1)


def band_mask(n_blocks):
    n = jnp.arange(n_blocks)[:, None, None]
    i = jnp.arange(BLOCK)[None, :, None]
    j = jnp.arange(2 * BLOCK)[None, None, :]
    qpos = n * BLOCK + i
    kpos = (n - 1) * BLOCK + j
    return (kpos <= qpos) & (qpos - kpos < WINDOW) & (kpos >= 0)


def sliding_window_sink_attention(q, k, v, sinks):
    B, S = q.shape[0], q.shape[1]
    nb = S // BLOCK
    qb = q.reshape(B, nb, BLOCK, N_KV_HEADS, GQA_GROUP, HEAD_DIM)
    kb = k.reshape(B, nb, BLOCK, N_KV_HEADS, HEAD_DIM)
    vb = v.reshape(B, nb, BLOCK, N_KV_HEADS, HEAD_DIM)
    pad = ((0, 0), (1, 0), (0, 0), (0, 0), (0, 0))
    k_band = jnp.concatenate([jnp.pad(kb[:, :-1], pad), kb], axis=2)
    v_band = jnp.concatenate([jnp.pad(vb[:, :-1], pad), vb], axis=2)
    scores = jnp.einsum('bnqhgd,bnkhd->bnhgqk', qb, k_band).astype(jnp.float32)
    scores = scores * (HEAD_DIM ** -0.5)
    mask = band_mask(nb)[None, :, None, None]
    scores = jnp.where(mask, scores, jnp.float32(-1e30))
    sink = jnp.broadcast_to(sinks.astype(jnp.float32).reshape(1, 1, N_KV_HEADS, GQA_GROUP, 1, 1),
                            scores.shape[:-1] + (1,))
    probs = jax.nn.softmax(jnp.concatenate([scores, sink], axis=-1), axis=-1)[..., :-1]
    out = jnp.einsum('bnhgqk,bnkhd->bnqhgd', probs.astype(v.dtype), v_band)
    return out.reshape(B, S, ATTN_WIDTH)


def multiscale_pool(u):
    S = u.shape[1]
    uf = u.astype(jnp.float32)
    cs = jnp.cumsum(uf, axis=1)
    cs_pad = jnp.pad(cs, ((0, 0), (MAX_POOL_WINDOW, 0), (0, 0), (0, 0)))
    t = jnp.arange(S)
    means = []
    for g, w in enumerate(POOL_WINDOWS):
        win_sum = cs[:, :, g] - cs_pad[:, MAX_POOL_WINDOW - w:MAX_POOL_WINDOW - w + S, g]
        count = jnp.minimum(t + 1, w).astype(jnp.float32)[None, :, None]
        means.append(win_sum / count)
    mean = jnp.stack(means, axis=2)
    return (mean - uf).astype(u.dtype)


def setup_inputs(seed: int = 0) -> dict:
    key = jax.random.key(seed)
    ks = jax.random.split(key, 20)
    f32 = jnp.float32
    nrm = lambda k, shape, s: jax.random.normal(k, shape, f32) * s
    x = nrm(ks[0], (BATCH, SEQ, D_MODEL), 1.0)
    c = nrm(ks[1], (BATCH, D_MODEL), 1.0)
    start = jax.random.randint(ks[2], (BATCH, 1), 0, MAX_START, dtype=jnp.int32)
    positions = (start + jnp.arange(SEQ, dtype=jnp.int32)[None, :]).astype(jnp.int32)
    return {
        "x": x,
        "c": c,
        "positions": positions,
        "w_ada": nrm(ks[3], (DEPTH, D_MODEL, N_MOD * D_MODEL), 0.5 * D_MODEL ** -0.5),
        "b_ada": nrm(ks[4], (DEPTH, N_MOD * D_MODEL), 0.01),
        "norm1_g": 1.0 + nrm(ks[5], (DEPTH, D_MODEL), 0.05),
        "w_in": nrm(ks[6], (DEPTH, D_MODEL, IN_WIDTH), D_MODEL ** -0.5),
        "q_norm_g": 1.0 + nrm(ks[7], (DEPTH, HEAD_DIM), 0.05),
        "k_norm_g": 1.0 + nrm(ks[8], (DEPTH, HEAD_DIM), 0.05),
        "attn_sinks": nrm(ks[9], (DEPTH, N_HEADS), 0.5),
        "pool_w": nrm(ks[10], (DEPTH, N_POOL_GROUPS, POOL_GROUP_DIM, POOL_GROUP_DIM), POOL_GROUP_DIM ** -0.5),
        "pool_scale": 1.0 + nrm(ks[11], (DEPTH, POOL_WIDTH), 0.1),
        "w_o": nrm(ks[12], (DEPTH, MIX_WIDTH, D_MODEL), MIX_WIDTH ** -0.5),
        "norm2_g": 1.0 + nrm(ks[13], (DEPTH, D_MODEL), 0.05),
        "w_mlp_in": nrm(ks[14], (DEPTH, D_MODEL, D_FF), D_MODEL ** -0.5),
        "w_mlp_out": nrm(ks[15], (DEPTH, D_FF, D_MODEL), D_FF ** -0.5),
    }


def reference(x, c, positions, w_ada, b_ada, norm1_g, w_in, q_norm_g, k_norm_g, attn_sinks,
              pool_w, pool_scale, w_o, norm2_g, w_mlp_in, w_mlp_out):
    B, S, D = x.shape
    inv_freq = ROPE_THETA ** (-jnp.arange(0, ROT_DIM, 2, dtype=jnp.float32) / ROT_DIM)
    ang = positions.astype(jnp.float32)[..., None] * inv_freq
    cos, sin = jnp.cos(ang), jnp.sin(ang)
    cos_q, sin_q = cos[:, :, None, None, :], sin[:, :, None, None, :]
    cos_k, sin_k = cos[:, :, None, :], sin[:, :, None, :]
    c_act = jax.nn.silu(c)
    h_res = x
    for l in range(DEPTH):
        mod = (c_act @ w_ada[l] + b_ada[l])[:, None, :]
        sh1, sc1, g1, sh2, sc2, g2 = jnp.split(mod, N_MOD, axis=-1)

        h = rms_norm(h_res, norm1_g[l]) * (1.0 + sc1) + sh1
        proj = h @ w_in[l]
        q = proj[..., :ATTN_WIDTH].reshape(B, S, N_KV_HEADS, GQA_GROUP, HEAD_DIM)
        k = proj[..., ATTN_WIDTH:ATTN_WIDTH + KV_WIDTH].reshape(B, S, N_KV_HEADS, HEAD_DIM)
        v = proj[..., ATTN_WIDTH + KV_WIDTH:ATTN_WIDTH + 2 * KV_WIDTH].reshape(B, S, N_KV_HEADS, HEAD_DIM)
        u = proj[..., ATTN_WIDTH + 2 * KV_WIDTH:].reshape(B, S, N_POOL_GROUPS, POOL_GROUP_DIM)

        q = apply_partial_rope(rms_norm(q, q_norm_g[l]), cos_q, sin_q)
        k = apply_partial_rope(rms_norm(k, k_norm_g[l]), cos_k, sin_k)
        attn_out = sliding_window_sink_attention(q, k, v, attn_sinks[l])

        pooled = multiscale_pool(u)
        pool_out = jnp.einsum('bsgc,gcd->bsgd', pooled, pool_w[l])
        pool_out = pool_out.reshape(B, S, POOL_WIDTH) * pool_scale[l]

        mixed = jnp.concatenate([attn_out, pool_out], axis=-1) @ w_o[l]
        h_res = h_res + g1 * mixed

        h2 = rms_norm(h_res, norm2_g[l]) * (1.0 + sc2) + sh2
        ff = jnp.square(jax.nn.relu(h2 @ w_mlp_in[l])) @ w_mlp_out[l]
        h_res = h_res + g2 * ff
    return h_res
```

```cpp
#include <hip/hip_runtime.h>
#include <cstdint>
#include <cstdio>

typedef unsigned short bf16_t;
typedef short bf16x8 __attribute__((ext_vector_type(8)));
typedef float f32x4 __attribute__((ext_vector_type(4)));

constexpr int BATCH = 8, SEQ = 4096, D = 1024, M = BATCH * SEQ;
constexpr int NH = 8, NKV = 2, HD = 64, AW = 512, KVW = 128, PW = 512, INW = 1280, FF = 4096, NMOD = 6;
constexpr float EPS = 1e-6f;

__device__ __forceinline__ unsigned f2bf(float f) { unsigned u = __builtin_bit_cast(unsigned, f); return (u + 0x7fffu + ((u >> 16) & 1u)) >> 16; }
__device__ __forceinline__ float bf2f(unsigned short h) { return __builtin_bit_cast(float, (unsigned)h << 16); }
__device__ __forceinline__ float wave_sum(float v) {
#pragma unroll
    for (int o = 1; o < 64; o <<= 1) v += __shfl_xor(v, o);
    return v;
}

__global__ void k_mod(const float* __restrict__ c, const float* __restrict__ w_ada, const float* __restrict__ b_ada, float* __restrict__ mod) {
    const int j = blockIdx.x * blockDim.x + threadIdx.x; const int b = blockIdx.y;
    if (j >= NMOD * D) return;
    float acc = 0.f;
    for (int k = 0; k < D; ++k) { const float cv = c[b * D + k]; const float s = cv / (1.f + __expf(-cv)); acc += s * w_ada[(size_t)k * (NMOD * D) + j]; }
    mod[b * (NMOD * D) + j] = acc + b_ada[j];
}

__global__ void k_norm(const float* __restrict__ x, const float* __restrict__ g, const float* __restrict__ mod, int sh_off, int sc_off, bf16_t* __restrict__ out) {
    const int wave = (blockIdx.x * blockDim.x + threadIdx.x) >> 6, lane = threadIdx.x & 63;
    if (wave >= M) return;
    const int b = wave / SEQ;
    const float* xr = x + (size_t)wave * D;
    float v[16]; float s = 0.f;
#pragma unroll
    for (int j = 0; j < 4; ++j) { const f32x4 t = *(const f32x4*)(xr + j * 256 + lane * 4); v[4 * j] = t[0]; v[4 * j + 1] = t[1]; v[4 * j + 2] = t[2]; v[4 * j + 3] = t[3]; s += t[0] * t[0] + t[1] * t[1] + t[2] * t[2] + t[3] * t[3]; }
    s = wave_sum(s);
    const float r = rsqrtf(s * (1.f / D) + EPS);
    const float* mb = mod + (size_t)b * NMOD * D;
#pragma unroll
    for (int j = 0; j < 4; ++j)
#pragma unroll
        for (int i = 0; i < 4; ++i) { const int col = j * 256 + lane * 4 + i; const float y = v[4 * j + i] * r * g[col] * (1.f + mb[sc_off + col]) + mb[sh_off + col]; out[(size_t)wave * D + col] = (bf16_t)f2bf(y); }
}

template <int MODE>
__global__ __launch_bounds__(256) void k_gemm(const bf16_t* __restrict__ A, const float* __restrict__ B, int N, int K, void* Cout, const float* X, const float* __restrict__ mod, int gate_off) {
    __shared__ __attribute__((aligned(16))) bf16_t sA[128][40];
    __shared__ __attribute__((aligned(16))) bf16_t sB[128][40];
    const int tid = threadIdx.x, lane = tid & 63, w = tid >> 6, wr = w >> 1, wc = w & 1;
    const int m0 = blockIdx.y * 128, n0 = blockIdx.x * 128;
    f32x4 acc[4][4];
#pragma unroll
    for (int i = 0; i < 4; ++i)
#pragma unroll
        for (int j = 0; j < 4; ++j) acc[i][j] = (f32x4){0.f, 0.f, 0.f, 0.f};
    for (int k0 = 0; k0 < K; k0 += 32) {
        { const int r = tid >> 1, cc = (tid & 1) * 16; const bf16x8* src = (const bf16x8*)(A + (size_t)(m0 + r) * K + k0 + cc);
          *(bf16x8*)&sA[r][cc] = src[0]; *(bf16x8*)&sA[r][cc + 8] = src[1]; }
        { const int kk = tid >> 3, nn = (tid & 7) * 16; const float* src = B + (size_t)(k0 + kk) * N + n0 + nn;
#pragma unroll
          for (int i = 0; i < 16; ++i) sB[nn + i][kk] = (bf16_t)f2bf(src[i]); }
        __syncthreads();
        bf16x8 a[4], b[4];
#pragma unroll
        for (int i = 0; i < 4; ++i) a[i] = *(const bf16x8*)&sA[wr * 64 + i * 16 + (lane & 15)][8 * (lane >> 4)];
#pragma unroll
        for (int j = 0; j < 4; ++j) b[j] = *(const bf16x8*)&sB[wc * 64 + j * 16 + (lane & 15)][8 * (lane >> 4)];
#pragma unroll
        for (int i = 0; i < 4; ++i)
#pragma unroll
            for (int j = 0; j < 4; ++j) acc[i][j] = __builtin_amdgcn_mfma_f32_16x16x32_bf16(a[i], b[j], acc[i][j], 0, 0, 0);
        __syncthreads();
    }
#pragma unroll
    for (int i = 0; i < 4; ++i)
#pragma unroll
        for (int j = 0; j < 4; ++j)
#pragma unroll
            for (int r = 0; r < 4; ++r) {
                const int row = m0 + wr * 64 + i * 16 + (lane >> 4) * 4 + r, col = n0 + wc * 64 + j * 16 + (lane & 15);
                const float v = acc[i][j][r]; const size_t o = (size_t)row * N + col;
                if (MODE == 0) ((bf16_t*)Cout)[o] = (bf16_t)f2bf(v);
                else if (MODE == 2) { const float t = v > 0.f ? v : 0.f; ((bf16_t*)Cout)[o] = (bf16_t)f2bf(t * t); }
                else { const int b_ = row / SEQ; const float gt = mod[(size_t)b_ * NMOD * D + gate_off + col]; const float base = (MODE == 1) ? X[o] : ((float*)Cout)[o]; ((float*)Cout)[o] = base + gt * v; }
            }
}

__global__ void k_qkrope(const bf16_t* __restrict__ proj, const int* __restrict__ positions, const float* __restrict__ qg, const float* __restrict__ kg, bf16_t* __restrict__ QN, bf16_t* __restrict__ KN) {
    const int m = (blockIdx.x * blockDim.x + threadIdx.x) >> 6, lane = threadIdx.x & 63;
    if (m >= M) return;
    const float pos = (float)positions[m];
    const int fi = lane & 7;
    const float inv_freq = (float)pow(500000.0, -(double)fi / 8.0);
    const float ang = pos * inv_freq;
    const float cs = (float)cos((double)ang), sn = (float)sin((double)ang);
    for (int h = 0; h < NH + NKV; ++h) {
        const bf16_t* src = proj + (size_t)m * INW + h * 64;
        const float v = bf2f(src[lane]);
        const float ss = wave_sum(v * v);
        const float r = rsqrtf(ss * (1.f / 64.f) + EPS);
        float y = v * r * (h < NH ? qg[lane] : kg[lane]);
        const float other = __shfl_xor(y, 8);
        if (lane < 8) y = y * cs - other * sn; else if (lane < 16) y = y * cs + other * sn;
        if (h < NH) QN[(size_t)m * AW + h * 64 + lane] = (bf16_t)f2bf(y); else KN[(size_t)m * KVW + (h - NH) * 64 + lane] = (bf16_t)f2bf(y);
    }
}

__global__ __launch_bounds__(64) void k_attn(const bf16_t* __restrict__ QN, const bf16_t* __restrict__ KN, const bf16_t* __restrict__ proj, const float* __restrict__ sinks, bf16_t* __restrict__ MIX) {
    const int id = blockIdx.x * blockDim.x + threadIdx.x;
    if (id >= M * NH) return;
    const int m = id / NH, hq = id % NH, kvh = hq / 4, b = m / SEQ, t = m % SEQ;
    float q[64], acc[64];
#pragma unroll
    for (int d = 0; d < 64; ++d) { q[d] = bf2f(QN[(size_t)m * AW + hq * 64 + d]); acc[d] = 0.f; }
    float mx = -1e30f, l = 0.f;
    const int j0 = t - 127 < 0 ? 0 : t - 127;
    for (int j = j0; j <= t; ++j) {
        const size_t kr = (size_t)(b * SEQ + j);
        float s = 0.f;
#pragma unroll
        for (int d = 0; d < 64; ++d) s += q[d] * bf2f(KN[kr * KVW + kvh * 64 + d]);
        s *= 0.125f;
        const float mn = fmaxf(mx, s); const float f = __expf(mx - mn), p = __expf(s - mn);
        l = l * f + p;
#pragma unroll
        for (int d = 0; d < 64; ++d) acc[d] = acc[d] * f + p * bf2f(proj[kr * INW + AW + KVW + kvh * 64 + d]);
        mx = mn;
    }
    const float sk = sinks[hq]; const float mn = fmaxf(mx, sk); const float f = __expf(mx - mn);
    l = l * f + __expf(sk - mn);
    const float inv = f / l;
#pragma unroll
    for (int d = 0; d < 64; ++d) MIX[(size_t)m * D + hq * 64 + d] = (bf16_t)f2bf(acc[d] * inv);
}

__global__ void k_pool(const bf16_t* __restrict__ proj, bf16_t* __restrict__ POOLED) {
    const int id = blockIdx.x * blockDim.x + threadIdx.x;
    if (id >= M * PW) return;
    const int m = id / PW, c = id % PW, g = c / 128, w = 2 << g, t = m % SEQ;
    const int cnt = (t + 1) < w ? (t + 1) : w;
    float s = 0.f;
    for (int j = 0; j < cnt; ++j) s += bf2f(proj[(size_t)(m - j) * INW + AW + 2 * KVW + c]);
    const float u = bf2f(proj[(size_t)m * INW + AW + 2 * KVW + c]);
    POOLED[(size_t)m * PW + c] = (bf16_t)f2bf(s / (float)cnt - u);
}
__global__ void k_poolmm(const bf16_t* __restrict__ POOLED, const float* __restrict__ pool_w, const float* __restrict__ pool_scale, bf16_t* __restrict__ MIX) {
    const int id = blockIdx.x * blockDim.x + threadIdx.x;
    if (id >= M * PW) return;
    const int m = id / PW, c = id % PW, g = c / 128, d = c % 128;
    float s = 0.f;
    for (int k = 0; k < 128; ++k) s += bf2f(POOLED[(size_t)m * PW + g * 128 + k]) * pool_w[(size_t)(g * 128 + k) * 128 + d];
    MIX[(size_t)m * D + AW + c] = (bf16_t)f2bf(s * pool_scale[c]);
}

extern "C" void kernel_launch(void* const* d_in, const int* in_sizes, int n_in, void* d_out, int out_size, void* d_ws, size_t ws_size, hipStream_t stream) {
    const float* x = (const float*)d_in[0]; const float* c = (const float*)d_in[1]; const int* positions = (const int*)d_in[2];
    const float* w_ada = (const float*)d_in[3]; const float* b_ada = (const float*)d_in[4]; const float* norm1_g = (const float*)d_in[5];
    const float* w_in = (const float*)d_in[6]; const float* q_norm_g = (const float*)d_in[7]; const float* k_norm_g = (const float*)d_in[8];
    const float* sinks = (const float*)d_in[9]; const float* pool_w = (const float*)d_in[10]; const float* pool_scale = (const float*)d_in[11];
    const float* w_o = (const float*)d_in[12]; const float* norm2_g = (const float*)d_in[13]; const float* w1 = (const float*)d_in[14]; const float* w2 = (const float*)d_in[15];
    float* out = (float*)d_out;
    unsigned char* ws = (unsigned char*)d_ws;
    constexpr size_t MiB = 1u << 20;
    float* mod = (float*)(ws + 0);
    bf16_t* XN = (bf16_t*)(ws + 16 * MiB);
    bf16_t* H = (bf16_t*)(ws + 80 * MiB);
    bf16_t* PROJ = (bf16_t*)(ws + 80 * MiB);
    bf16_t* QN = (bf16_t*)(ws + 160 * MiB);
    bf16_t* KN = (bf16_t*)(ws + 192 * MiB);
    bf16_t* POOLED = (bf16_t*)(ws + 200 * MiB);
    bf16_t* MIX = (bf16_t*)(ws + 232 * MiB);

    k_mod<<<dim3(NMOD * D / 256, BATCH), 256, 0, stream>>>(c, w_ada, b_ada, mod);
    k_norm<<<M / 4, 256, 0, stream>>>(x, norm1_g, mod, 0 * D, 1 * D, XN);
    k_gemm<0><<<dim3(INW / 128, M / 128), 256, 0, stream>>>(XN, w_in, INW, D, PROJ, nullptr, mod, 0);
    k_qkrope<<<M / 4, 256, 0, stream>>>(PROJ, positions, q_norm_g, k_norm_g, QN, KN);
    k_attn<<<M * NH / 64, 64, 0, stream>>>(QN, KN, PROJ, sinks, MIX);
    k_pool<<<M * PW / 256, 256, 0, stream>>>(PROJ, POOLED);
    k_poolmm<<<M * PW / 256, 256, 0, stream>>>(POOLED, pool_w, pool_scale, MIX);
    k_gemm<1><<<dim3(D / 128, M / 128), 256, 0, stream>>>(MIX, w_o, D, D, out, x, mod, 2 * D);
    k_norm<<<M / 4, 256, 0, stream>>>(out, norm2_g, mod, 3 * D, 4 * D, XN);
    k_gemm<2><<<dim3(FF / 128, M / 128), 256, 0, stream>>>(XN, w1, FF, D, H, nullptr, mod, 0);
    k_gemm<3><<<dim3(D / 128, M / 128), 256, 0, stream>>>(H, w2, D, FF, out, nullptr, mod, 5 * D);
}
```

```cpp
#define MK_N_LAUNCHES 1
#include <hip/hip_runtime.h>
#include <cstdio>
#include <cstdint>
#include <cmath>
namespace pg8 {
#define PG8_LAS __attribute__((address_space(3)))
typedef unsigned short bf16_t;
typedef short bf16x8 __attribute__((ext_vector_type(8)));
typedef float f32x4 __attribute__((ext_vector_type(4)));
typedef unsigned u32x4 __attribute__((ext_vector_type(4)));
constexpr int BM = 256, BK = 64, HALF = 128, HTB = HALF * BK * 2  , STAGE_BYTES = 8 * HTB, NXCD = 8, WGM = 8;

__host__ __device__ __forceinline__ int lds_byte(int r, int c) { const int st = (r >> 4) * 2 + (c >> 5), rr = r & 15, cc = c & 31, ob = rr * 64 + cc * 2; return st * 1024 + (ob ^ (((ob >> 9) & 1) << 5)); }
__host__ __device__ __forceinline__ void stage_rc(int b, int& R, int& C) { const int st = b / 1024, sb = b % 1024, swz = sb ^ (((sb >> 9) & 1) << 5); R = (st >> 1) * 16 + swz / 64; C = (st & 1) * 32 + (swz % 64) / 2; }
__host__ __device__ __forceinline__ int perm32(int rho) { const int n = rho >> 4, i = rho & 15; return 8 * (i >> 2) + 4 * n + (i & 3); }

struct Unit { int pm, pn; };
struct Gemm { const bf16_t* A; const bf16_t* Bt; int M, N, K; };

struct StaticOrder {
    int nM, nN, nwg, G, c;
    __host__ __device__ void init(int M, int N, int G_, int c_) { nM = M / BM; nN = N / BM; nwg = nM * nN; G = G_; c = c_; }
    __host__ __device__ bool next(int i, Unit& u) const {
        const long L = (long)i * G + c; if (L >= nwg) return false;
        int wgid = (int)L; { const int q = nwg / NXCD, r = nwg % NXCD, xcd = wgid % NXCD, off = wgid / NXCD; wgid = (xcd < r ? xcd * (q + 1) : r * (q + 1) + (xcd - r) * q) + off; }
        const int nig = WGM * nN, gid = wgid / nig, fm = gid * WGM, gsz = (nM - fm) < WGM ? (nM - fm) : WGM;
        u.pm = fm + ((wgid % nig) % gsz); u.pn = (wgid % nig) / gsz; return true;
    }
    __device__ __forceinline__ void a_ready(const Unit&) const {}
    __device__ __forceinline__ void done(const Unit&) const {}
};

__device__ __forceinline__ unsigned cvt_pk_bf16(float lo, float hi) { unsigned r; asm volatile("v_cvt_pk_bf16_f32 %0, %1, %2" : "=v"(r) : "v"(lo), "v"(hi)); return r; }
typedef float f32x2 __attribute__((ext_vector_type(2)));
constexpr int SEQ_ = 4096, DM_ = 1024, NMOD_ = 6;
constexpr float EPS_ = 1e-6f;
constexpr float QSCALE = 0.125f * 1.4426950408889634f;

__device__ __forceinline__ u32x4 pack8(const f32x4 a, const f32x4 b) { u32x4 w; w.x = cvt_pk_bf16(a[0], a[1]); w.y = cvt_pk_bf16(a[2], a[3]); w.z = cvt_pk_bf16(b[0], b[1]); w.w = cvt_pk_bf16(b[2], b[3]); return w; }

struct EpiProj {
    static constexpr bool PERM = true, AFTER_DRAIN = false;
    bf16_t *Q, *Kb, *V, *U; const float* rope; const float* qg; const float* kg;
    __device__ __forceinline__ void operator()(const f32x4 (&acc)[2][2][4][2], const Unit& u, int wr, int wc, int fr, int fq) const {
        const int row0 = u.pm * BM + wr * 64 + fr;
        if (u.pn >= 3 || (u.pn == 2 && wc >= 2)) {
            bf16_t* base; int pitch;
            if (u.pn >= 3) { base = U + (u.pn - 3) * 256 + wc * 64 + 8 * fq; pitch = 512; } else { base = V + (wc - 2) * 64 + 8 * fq; pitch = 128; }
#pragma unroll
            for (int ai = 0; ai < 2; ++ai)
#pragma unroll
                for (int m = 0; m < 4; ++m) { bf16_t* rowp = base + (size_t)(row0 + ai * HALF + m * 16) * pitch;
#pragma unroll
                    for (int bj = 0; bj < 2; ++bj) *(u32x4*)(rowp + bj * 32) = pack8(acc[ai][bj][m][0], acc[ai][bj][m][1]); }
        } else {
            const bool isq = u.pn < 2; const float* g = isq ? qg : kg; const float sc = isq ? QSCALE : 1.0f;
            bf16_t* base = isq ? Q + (4 * u.pn + wc) * 64 + 8 * fq : Kb + wc * 64 + 8 * fq; const int pitch = isq ? 512 : 128;
            f32x4 gv[2][2];
#pragma unroll
            for (int bj = 0; bj < 2; ++bj)
#pragma unroll
                for (int n = 0; n < 2; ++n) gv[bj][n] = *(const f32x4*)(g + 32 * bj + 8 * fq + 4 * n);
#pragma unroll
            for (int ai = 0; ai < 2; ++ai)
#pragma unroll
                for (int m = 0; m < 4; ++m) {
                    const int row = row0 + ai * HALF + m * 16;
                    f32x4 cs[2], sn[2];
#pragma unroll
                    for (int n = 0; n < 2; ++n) { cs[n] = *(const f32x4*)(rope + (size_t)row * 16 + 4 * n); sn[n] = *(const f32x4*)(rope + (size_t)row * 16 + 8 + 4 * n); }
                    float ss = 0.f;
#pragma unroll
                    for (int bj = 0; bj < 2; ++bj)
#pragma unroll
                        for (int n = 0; n < 2; ++n) { const f32x4 v = acc[ai][bj][m][n]; ss += (v[0] * v[0] + v[1] * v[1]) + (v[2] * v[2] + v[3] * v[3]); }
                    ss += __shfl_xor(ss, 16); ss += __shfl_xor(ss, 32);
                    const float r = rsqrtf(ss * (1.0f / 64.0f) + EPS_);
                    f32x4 y[2][2];
#pragma unroll
                    for (int bj = 0; bj < 2; ++bj)
#pragma unroll
                        for (int n = 0; n < 2; ++n) y[bj][n] = acc[ai][bj][m][n] * r * gv[bj][n];
#pragma unroll
                    for (int n = 0; n < 2; ++n)
#pragma unroll
                        for (int e = 0; e < 4; ++e) { const float mine = y[0][n][e]; const float other = __shfl_xor(mine, 16);
                            const float ro = (fq == 0) ? mine * cs[n][e] - other * sn[n][e] : mine * cs[n][e] + other * sn[n][e];
                            y[0][n][e] = (fq < 2) ? ro : mine; }
                    bf16_t* rowp = base + (size_t)row * pitch;
#pragma unroll
                    for (int bj = 0; bj < 2; ++bj) *(u32x4*)(rowp + bj * 32) = pack8(y[bj][0] * sc, y[bj][1] * sc);
                }
        }
    }
};

struct EpiWo {
    static constexpr bool PERM = true, AFTER_DRAIN = false;
    const float* x; float* x1; bf16_t* z; const float* mod; const float* a2; float* stats;
    __device__ __forceinline__ void operator()(const f32x4 (&acc)[2][2][4][2], const Unit& u, int wr, int wc, int fr, int fq) const {
        const int b = (u.pm * BM) / SEQ_; const int col0 = u.pn * BM + wc * 32 + 8 * fq; const int row0 = u.pm * BM + wr * 64 + fr;
        f32x4 gv[2][2], av[2][2];
#pragma unroll
        for (int bj = 0; bj < 2; ++bj)
#pragma unroll
            for (int n = 0; n < 2; ++n) { gv[bj][n] = *(const f32x4*)(mod + (size_t)b * NMOD_ * DM_ + 2 * DM_ + col0 + bj * HALF + 4 * n); av[bj][n] = *(const f32x4*)(a2 + (size_t)b * DM_ + col0 + bj * HALF + 4 * n); }
#pragma unroll
        for (int ai = 0; ai < 2; ++ai)
#pragma unroll
            for (int m = 0; m < 4; ++m) {
                const int row = row0 + ai * HALF + m * 16; const size_t off = (size_t)row * DM_ + col0; float ss = 0.f;
#pragma unroll
                for (int bj = 0; bj < 2; ++bj) {
                    const f32x4 xa = *(const f32x4*)(x + off + bj * HALF), xb = *(const f32x4*)(x + off + bj * HALF + 4);
                    const f32x4 v0 = xa + gv[bj][0] * acc[ai][bj][m][0], v1 = xb + gv[bj][1] * acc[ai][bj][m][1];
                    *(f32x4*)(x1 + off + bj * HALF) = v0; *(f32x4*)(x1 + off + bj * HALF + 4) = v1;
                    ss += (v0[0] * v0[0] + v0[1] * v0[1]) + (v0[2] * v0[2] + v0[3] * v0[3]) + (v1[0] * v1[0] + v1[1] * v1[1]) + (v1[2] * v1[2] + v1[3] * v1[3]);
                    *(u32x4*)(z + off + bj * HALF) = pack8(v0 * av[bj][0], v1 * av[bj][1]);
                }
                ss += __shfl_xor(ss, 16); ss += __shfl_xor(ss, 32);
                if (fq == 0) stats[(size_t)row * 16 + u.pn * 4 + wc] = ss;
            }
    }
};

struct EpiUp {
    static constexpr bool PERM = true, AFTER_DRAIN = false;
    bf16_t* H; const float* stats; const float* bias2; int ldc;
    __device__ __forceinline__ void operator()(const f32x4 (&acc)[2][2][4][2], const Unit& u, int wr, int wc, int fr, int fq) const {
        const int b = (u.pm * BM) / SEQ_; const int col0 = u.pn * BM + wc * 32 + 8 * fq; const int row0 = u.pm * BM + wr * 64 + fr;
        f32x4 bv[2][2];
#pragma unroll
        for (int bj = 0; bj < 2; ++bj)
#pragma unroll
            for (int n = 0; n < 2; ++n) bv[bj][n] = *(const f32x4*)(bias2 + (size_t)b * ldc + col0 + bj * HALF + 4 * n);
#pragma unroll
        for (int ai = 0; ai < 2; ++ai)
#pragma unroll
            for (int m = 0; m < 4; ++m) {
                const int row = row0 + ai * HALF + m * 16;
                const f32x4 st = *(const f32x4*)(stats + (size_t)row * 16 + 4 * fq);
                float s = (st[0] + st[1]) + (st[2] + st[3]); s += __shfl_xor(s, 16); s += __shfl_xor(s, 32);
                const float r = rsqrtf(s * (1.0f / DM_) + EPS_);
                bf16_t* rowp = H + (size_t)row * ldc + col0;
#pragma unroll
                for (int bj = 0; bj < 2; ++bj) {
                    f32x4 v0 = acc[ai][bj][m][0] * r + bv[bj][0], v1 = acc[ai][bj][m][1] * r + bv[bj][1];
#pragma unroll
                    for (int e = 0; e < 4; ++e) { const float t0 = fmaxf(v0[e], 0.f), t1 = fmaxf(v1[e], 0.f); v0[e] = t0 * t0; v1[e] = t1 * t1; }
                    *(u32x4*)(rowp + bj * HALF) = pack8(v0, v1);
                }
            }
    }
};

struct EpiDown {
    static constexpr bool PERM = true, AFTER_DRAIN = false;
    float* out; const float* mod;
    __device__ __forceinline__ void operator()(const f32x4 (&acc)[2][2][4][2], const Unit& u, int wr, int wc, int fr, int fq) const {
        const int b = (u.pm * BM) / SEQ_; const int col0 = u.pn * BM + wc * 32 + 8 * fq; const int row0 = u.pm * BM + wr * 64 + fr;
        f32x4 gv[2][2];
#pragma unroll
        for (int bj = 0; bj < 2; ++bj)
#pragma unroll
            for (int n = 0; n < 2; ++n) gv[bj][n] = *(const f32x4*)(mod + (size_t)b * NMOD_ * DM_ + 5 * DM_ + col0 + bj * HALF + 4 * n);
#pragma unroll
        for (int ai = 0; ai < 2; ++ai)
#pragma unroll
            for (int m = 0; m < 4; ++m) {
                const size_t off = (size_t)(row0 + ai * HALF + m * 16) * DM_ + col0;
#pragma unroll
                for (int bj = 0; bj < 2; ++bj) {
                    const f32x4 xa = *(const f32x4*)(out + off + bj * HALF), xb = *(const f32x4*)(out + off + bj * HALF + 4);
                    *(f32x4*)(out + off + bj * HALF) = xa + gv[bj][0] * acc[ai][bj][m][0]; *(f32x4*)(out + off + bj * HALF + 4) = xb + gv[bj][1] * acc[ai][bj][m][1];
                }
            }
    }
};

template <class Epi, class Sched, bool ALIGN_EPI = false, bool SP2 = false>
__device__ __forceinline__ void gemm_phase(PG8_LAS unsigned char* lds, const Gemm g, const Sched& S, const Epi& E) {
    const int tid = threadIdx.x, wid = __builtin_amdgcn_readfirstlane(tid >> 6), lane = tid & 63, wr = wid >> 2, wc = wid & 3, fr = lane & 15, fq = lane >> 4;
    const int K = g.K, nt = K / BK;
    unsigned voffA[2], voffB[2];
#pragma unroll
    for (int i = 0; i < 2; ++i) { int R, C; stage_rc(tid * 16 + i * 8192, R, C); const int Rb = Epi::PERM ? ((R & ~31) + perm32(R & 31)) : R;
        voffA[i] = (unsigned)(R * K + C) * 2u; voffB[i] = (unsigned)(Rb * K + C) * 2u; }
    const size_t kstep = (size_t)(BK * 2);
    const size_t hstep = (size_t)HALF * K * 2;
    const size_t tstep = 2 * hstep;
    const unsigned ldsw = (unsigned)wid * 1024u;
    const int aoff = lds_byte(wr * 64 + fr, fq * 8), boff = lds_byte(wc * 32 + fr, fq * 8);
#define PG8_SA(b, h) (((b) * 2 + (h)) * HTB)
#define PG8_SB(b, h) ((4 + (b) * 2 + (h)) * HTB)
#define PG8_STAGE(bufoff, gbase, voff) do { _Pragma("unroll") for (int _i = 0; _i < 2; ++_i) \
        __builtin_amdgcn_global_load_lds((const unsigned*)((const char*)(gbase) + (voff)[_i]), (PG8_LAS unsigned*)(lds + (bufoff) + ldsw + _i * 8192), 16, 0, 0); } while (0)
#define PG8_LDA(dst, b, h) do { _Pragma("unroll") for (int m = 0; m < 4; ++m) _Pragma("unroll") for (int k = 0; k < 2; ++k) dst[m][k] = *(const PG8_LAS bf16x8*)(lds + PG8_SA(b, h) + aoff + m * 2048 + k * 1024); } while (0)
#define PG8_LDB(dst, b, h) do { _Pragma("unroll") for (int n = 0; n < 2; ++n) _Pragma("unroll") for (int k = 0; k < 2; ++k) dst[n][k] = *(const PG8_LAS bf16x8*)(lds + PG8_SB(b, h) + boff + n * 2048 + k * 1024); } while (0)
#define PG8_MMA(ai, bj, At, Bt) do { __builtin_amdgcn_s_setprio(1); _Pragma("unroll") for (int m = 0; m < 4; ++m) _Pragma("unroll") for (int n = 0; n < 2; ++n) _Pragma("unroll") for (int k = 0; k < 2; ++k) \
        acc[ai][bj][m][n] = __builtin_amdgcn_mfma_f32_16x16x32_bf16(Bt[n][k], At[m][k], acc[ai][bj][m][n], 0, 0, 0); __builtin_amdgcn_s_setprio(0); } while (0)
#define PG8_WAIT_V(n) asm volatile("s_waitcnt vmcnt(" #n ")" ::: "memory")
#define PG8_WAIT_L(n) asm volatile("s_waitcnt lgkmcnt(" #n ")" ::: "memory")
#define PG8_BAR __builtin_amdgcn_s_barrier()
#define PG8_SCHED __builtin_amdgcn_sched_barrier(0)
    Unit cur, nxt; int ui = 0;
    if (!S.next(0, cur)) return;
    f32x4 acc[2][2][4][2];
#pragma unroll
    for (int a = 0; a < 2; ++a)
#pragma unroll
        for (int b = 0; b < 2; ++b)
#pragma unroll
            for (int m = 0; m < 4; ++m)
#pragma unroll
                for (int n = 0; n < 2; ++n) acc[a][b][m][n] = (f32x4){0.f, 0.f, 0.f, 0.f};
    bf16x8 At[4][2], B0[2][2], B1[2][2];
    const char* cA = (const char*)g.A + (size_t)cur.pm * tstep; const char* cB = (const char*)g.Bt + (size_t)cur.pn * tstep;
    S.a_ready(cur);
    if constexpr (SP2) {
        PG8_STAGE(PG8_SB(0, 0), cB, voffB); PG8_STAGE(PG8_SB(0, 1), cB + hstep, voffB); PG8_STAGE(PG8_SA(0, 0), cA, voffA); PG8_STAGE(PG8_SA(0, 1), cA + hstep, voffA);
        if (wr == 1) PG8_BAR;
        PG8_WAIT_V(2); PG8_BAR;
        PG8_STAGE(PG8_SB(1, 0), cB + kstep, voffB); PG8_STAGE(PG8_SA(1, 0), cA + kstep, voffA); PG8_STAGE(PG8_SB(1, 1), cB + hstep + kstep, voffB);
        PG8_WAIT_V(6); PG8_BAR;
    } else {
        PG8_STAGE(PG8_SB(0, 0), cB, voffB); PG8_STAGE(PG8_SA(0, 0), cA, voffA); PG8_STAGE(PG8_SB(0, 1), cB + hstep, voffB); PG8_STAGE(PG8_SA(0, 1), cA + hstep, voffA);
        if (wr == 1) PG8_BAR;
        PG8_WAIT_V(4); PG8_BAR;
        PG8_STAGE(PG8_SB(1, 0), cB + kstep, voffB); PG8_STAGE(PG8_SA(1, 0), cA + kstep, voffA); PG8_STAGE(PG8_SB(1, 1), cB + hstep + kstep, voffB);
        PG8_WAIT_V(6); PG8_BAR;
    }
    for (;;) {
        const bool has_next = S.next(ui + 1, nxt);
        const char* nA = has_next ? (const char*)g.A + (size_t)nxt.pm * tstep : cA; const char* nB = has_next ? (const char*)g.Bt + (size_t)nxt.pn * tstep : cB;
        for (int t = 0; t < nt; t += 2) {
            const bool last = (t == nt - 2);
            const char* a1 = cA + (size_t)(t + 1) * kstep;
            const char* a2 = last ? nA : cA + (size_t)(t + 2) * kstep; const char* b2 = last ? nB : cB + (size_t)(t + 2) * kstep;
            const char* a3 = a2 + kstep; const char* b3 = b2 + kstep;
            if (last && has_next) S.a_ready(nxt);
            if constexpr (SP2) {
            PG8_LDB(B0, 0, 0); PG8_LDB(B1, 0, 1); PG8_SCHED; PG8_LDA(At, 0, 0); PG8_STAGE(PG8_SA(1, 1), a1 + hstep, voffA);
            PG8_WAIT_V(8); PG8_WAIT_L(0); PG8_BAR; PG8_MMA(0, 0, At, B0); PG8_MMA(0, 1, At, B1); PG8_BAR; PG8_SCHED;
            PG8_LDA(At, 0, 1); PG8_STAGE(PG8_SB(0, 0), b2, voffB); PG8_STAGE(PG8_SB(0, 1), b2 + hstep, voffB); PG8_STAGE(PG8_SA(0, 0), a2, voffA);
            PG8_WAIT_V(8); PG8_WAIT_L(0); PG8_BAR; PG8_MMA(1, 0, At, B0); PG8_MMA(1, 1, At, B1); PG8_BAR; PG8_SCHED;
            PG8_LDB(B0, 1, 0); PG8_LDB(B1, 1, 1); PG8_SCHED; PG8_LDA(At, 1, 0); PG8_STAGE(PG8_SA(0, 1), a2 + hstep, voffA);
            PG8_WAIT_V(8); PG8_WAIT_L(0); PG8_BAR; PG8_MMA(0, 0, At, B0); PG8_MMA(0, 1, At, B1); PG8_BAR; PG8_SCHED;
            PG8_LDA(At, 1, 1); PG8_STAGE(PG8_SB(1, 0), b3, voffB); PG8_STAGE(PG8_SB(1, 1), b3 + hstep, voffB); PG8_STAGE(PG8_SA(1, 0), a3, voffA);
            PG8_WAIT_V(8); PG8_WAIT_L(0); PG8_BAR; PG8_MMA(1, 0, At, B0); PG8_MMA(1, 1, At, B1); PG8_BAR; PG8_SCHED;
            } else {
            PG8_LDB(B0, 0, 0); PG8_SCHED; PG8_LDA(At, 0, 0); PG8_STAGE(PG8_SA(1, 1), a1 + hstep, voffA);
            PG8_WAIT_L(8); PG8_BAR; PG8_WAIT_L(0); PG8_MMA(0, 0, At, B0); PG8_BAR; PG8_SCHED;
            PG8_LDB(B1, 0, 1); PG8_STAGE(PG8_SB(0, 0), b2, voffB);
            PG8_BAR; PG8_WAIT_L(0); PG8_MMA(0, 1, At, B1); PG8_BAR;
            PG8_LDA(At, 0, 1); PG8_STAGE(PG8_SA(0, 0), a2, voffA);
            PG8_BAR; PG8_WAIT_L(0); PG8_MMA(1, 0, At, B0); PG8_BAR; PG8_SCHED;
            PG8_STAGE(PG8_SB(0, 1), b2 + hstep, voffB);
            PG8_WAIT_V(6); PG8_BAR; PG8_MMA(1, 1, At, B1); PG8_BAR;
            PG8_LDB(B0, 1, 0); PG8_SCHED; PG8_LDA(At, 1, 0); PG8_STAGE(PG8_SA(0, 1), a2 + hstep, voffA);
            PG8_WAIT_L(8); PG8_BAR; PG8_WAIT_L(0); PG8_MMA(0, 0, At, B0); PG8_BAR; PG8_SCHED;
            PG8_LDB(B1, 1, 1); PG8_STAGE(PG8_SB(1, 0), b3, voffB);
            PG8_BAR; PG8_WAIT_L(0); PG8_MMA(0, 1, At, B1); PG8_BAR;
            PG8_LDA(At, 1, 1); PG8_STAGE(PG8_SA(1, 0), a3, voffA);
            PG8_BAR; PG8_WAIT_L(0); PG8_MMA(1, 0, At, B0); PG8_BAR; PG8_SCHED;
            PG8_STAGE(PG8_SB(1, 1), b3 + hstep, voffB);
            PG8_WAIT_V(6); PG8_BAR; PG8_MMA(1, 1, At, B1); PG8_BAR;
            }
        }
        if constexpr (ALIGN_EPI) { if (wr == 0) PG8_BAR; }
        if constexpr (!Epi::AFTER_DRAIN) { E(acc, cur, wr, wc, fr, fq); S.done(cur); }
        if (!has_next) break;
#pragma unroll
        for (int a = 0; a < 2; ++a)
#pragma unroll
            for (int b = 0; b < 2; ++b)
#pragma unroll
                for (int m = 0; m < 4; ++m)
#pragma unroll
                    for (int n = 0; n < 2; ++n) acc[a][b][m][n] = (f32x4){0.f, 0.f, 0.f, 0.f};
        cur = nxt; cA = nA; cB = nB; ++ui;
        if constexpr (ALIGN_EPI) { if (wr == 1) PG8_BAR; }
    }
    PG8_WAIT_V(0);
    if constexpr (!ALIGN_EPI) { if (wr == 0) PG8_BAR; }
    PG8_BAR;
    if constexpr (Epi::AFTER_DRAIN) { E.fused(acc, cur, wr, wc, fr, fq, lds, wid, lane); S.done(cur); }
#undef PG8_SA
#undef PG8_SB
#undef PG8_STAGE
#undef PG8_LDA
#undef PG8_LDB
#undef PG8_MMA
#undef PG8_WAIT_V
#undef PG8_WAIT_L
#undef PG8_BAR
#undef PG8_SCHED
}
}

constexpr int NWAVES = 8;
constexpr int BATCH = 8, SEQ = 4096, D = 1024, M = BATCH * SEQ;
constexpr int NH = 8, NKV = 2, HD = 64, AW = 512, KVW = 128, PW = 512, INW = 1280, FF = 4096, NMOD = 6;
constexpr float EPS = 1e-6f;
#ifndef MK_N_LAUNCHES
#define MK_N_LAUNCHES 1
#endif
constexpr int N_PHASES = 7;
constexpr int N_LAUNCHES = MK_N_LAUNCHES;

constexpr size_t MiB = 1u << 20;
constexpr size_t WS_CTL = 0, CTL_ZERO_BYTES = 64 * 1024;
constexpr size_t WS_MOD = 1 * MiB;
constexpr size_t WS_BIAS2 = 1 * MiB + 256 * 1024;
constexpr size_t WS_A2 = 1 * MiB + 512 * 1024;
constexpr size_t WS_ROPE = 2 * MiB;
constexpr size_t WS_STATS = 4 * MiB;
constexpr size_t WS_WIN = 6 * MiB, WS_WO = 9 * MiB, WS_W1 = 12 * MiB, WS_W2 = 20 * MiB;
constexpr size_t WS_Z2 = 32 * MiB;
constexpr size_t WS_H = 96 * MiB;
constexpr size_t WS_XN = 96 * MiB, WS_Q = 160 * MiB, WS_K = 192 * MiB, WS_V = 200 * MiB, WS_U = 208 * MiB, WS_MIX = 240 * MiB;
constexpr size_t WS_END = 352 * MiB;
constexpr int CW_BAR = 1024;

constexpr int LDS_BYTES = 160 * 1024;
constexpr int MISC_OFF = LDS_BYTES - 256;
constexpr int ATT_K = 0, ATT_V = 24576, ATT_WS = 49152, ATT_OST = ATT_WS + NWAVES * 256, ATT_END = ATT_OST + NWAVES * 4096;

#define GAS __attribute__((address_space(1)))
#define LAS __attribute__((address_space(3)))
typedef unsigned short bf16;
typedef unsigned v4u __attribute__((ext_vector_type(4)));
typedef float f32x4 __attribute__((ext_vector_type(4)));
typedef short bf16x8 __attribute__((ext_vector_type(8)));
typedef GAS unsigned gu32;
typedef GAS unsigned long long gu64;
#define RLX_AGENT __ATOMIC_RELAXED, __HIP_MEMORY_SCOPE_AGENT
#define LDS_WAIT() asm volatile("s_waitcnt lgkmcnt(0)" ::: "memory")
#define VM_WAIT() asm volatile("s_waitcnt vmcnt(0)" ::: "memory")
__device__ __forceinline__ unsigned long long rt() { return __builtin_amdgcn_s_memrealtime(); }
__device__ __forceinline__ unsigned f2bf(float f) { unsigned u = __builtin_bit_cast(unsigned, f); return (u + 0x7fffu + ((u >> 16) & 1u)) >> 16; }
__device__ __forceinline__ unsigned pk2(float lo, float hi) { return f2bf(lo) | (f2bf(hi) << 16); }

#define XB_TMO      128
#define XB_XCNT(j)  (256  + 64 * (j))
#define XB_XSUB(j)  (1280 + 64 * (j))
#define XB_XGEN(j)  (2304 + 64 * (j))
#define XB_TOP      3328
#define XB_TOPGEN   3392
#define XCD_BAR_WORDS 3456
#define XB_SPIN_CAP (1u << 18)

__device__ __forceinline__ unsigned xb_ld(unsigned* p)              { return __hip_atomic_load(p, __ATOMIC_RELAXED, __HIP_MEMORY_SCOPE_AGENT); }
__device__ __forceinline__ unsigned xb_add(unsigned* p, unsigned v) { return __hip_atomic_fetch_add(p, v, __ATOMIC_RELAXED, __HIP_MEMORY_SCOPE_AGENT); }
__device__ __forceinline__ unsigned xb_xcc_id() { return (unsigned)__builtin_amdgcn_s_getreg((3 << 11) | 20) & 0xFu; }
#define XB_SPIN(cond, bar) do { unsigned _sp = 0; while (cond) { __builtin_amdgcn_s_sleep(1); \
    if ((++_sp & 255u) == 0u) { if (xb_ld(&(bar)[XB_TMO])) break; if (_sp > XB_SPIN_CAP) { atomicAdd(&(bar)[XB_TMO], 1u); break; } } } } while (0)

struct XcdBarrier {
    unsigned* bar; unsigned x;
    volatile LAS unsigned* st;
};

__device__ __forceinline__ XcdBarrier xcd_barrier_post(unsigned* bar, volatile LAS unsigned* st) {
    XcdBarrier b; b.bar = bar; b.x = xb_xcc_id(); b.st = st;
    if (threadIdx.x == 0) (void)xb_add(&bar[XB_XCNT(b.x)], 1u);
    return b;
}
__device__ __forceinline__ void xcd_barrier_complete(unsigned* bar, unsigned x, unsigned& nloc, unsigned& nx) {
    const unsigned G = gridDim.x * gridDim.y * gridDim.z;
    unsigned sum, cnt, mine, sp = 0u;
    for (;;) {
        sum = 0u; cnt = 0u; mine = 0u;
#pragma unroll
        for (unsigned j = 0; j < 16; ++j) { const unsigned c = xb_ld(&bar[XB_XCNT(j)]); sum += c; cnt += (c > 0u) ? 1u : 0u; mine = (j == x) ? c : mine; }
        if (sum == G) break;
        __builtin_amdgcn_s_sleep(1);
        if ((++sp & 255u) == 0u) { if (xb_ld(&bar[XB_TMO])) break; if (sp > XB_SPIN_CAP) { atomicAdd(&bar[XB_TMO], 1u); break; } }
    }
    nloc = mine > 0u ? mine : 1u; nx = cnt > 0u ? cnt : 1u;
}

__device__ __forceinline__ void xcd_barrier(const XcdBarrier& b) {
    asm volatile("s_waitcnt vmcnt(0)" ::: "memory");
    __syncthreads();
    if (threadIdx.x == 0) {
        unsigned* bar = b.bar;
        __builtin_amdgcn_s_waitcnt(0);
        unsigned nloc = b.st[0], nx = b.st[1];
        if (nloc == 0u) { xcd_barrier_complete(bar, b.x, nloc, nx); b.st[0] = nloc; b.st[1] = nx; }
        const unsigned old = xb_add(&bar[XB_XSUB(b.x)], 1u);
        const unsigned gen = old / nloc;
        if (old + 1u == (gen + 1u) * nloc) {
            __builtin_amdgcn_fence(__ATOMIC_RELEASE, "agent");
            asm volatile("s_waitcnt vmcnt(0)" ::: "memory");
            const unsigned og = xb_add(&bar[XB_TOP], 1u);
            const unsigned tg = og / nx;
            if (og + 1u == (tg + 1u) * nx) xb_add(&bar[XB_TOPGEN], 1u);
            else XB_SPIN(xb_ld(&bar[XB_TOPGEN]) == tg, bar);
            __builtin_amdgcn_fence(__ATOMIC_ACQUIRE, "agent");
            xb_add(&bar[XB_XGEN(b.x)], 1u);
            asm volatile("s_waitcnt vmcnt(0)" ::: "memory");
        } else {
            XB_SPIN(xb_ld(&bar[XB_XGEN(b.x)]) == gen, bar);
            __builtin_amdgcn_fence(__ATOMIC_ACQUIRE, "agent");
            asm volatile("s_waitcnt vmcnt(0)" ::: "memory");
        }
    }
    __syncthreads();
}

typedef float f32x16 __attribute__((ext_vector_type(16)));
typedef short s16x4 __attribute__((ext_vector_type(4)));
struct Frame {
    LAS unsigned char* lds;
    int tid, lane, wave, vcu, G;
};
__device__ __forceinline__ float wave_sum(float v) {
#pragma unroll
    for (int o = 1; o < 64; o <<= 1) v += __shfl_xor(v, o);
    return v;
}
__device__ __forceinline__ float bf2f(unsigned short h) { return __builtin_bit_cast(float, (unsigned)h << 16); }
__device__ __forceinline__ float bflo(unsigned w) { return __builtin_bit_cast(float, w << 16); }
__device__ __forceinline__ float bfhi(unsigned w) { return __builtin_bit_cast(float, w & 0xffff0000u); }

__device__ __forceinline__ void p0_transpose_item(const float* W, int N, bf16* WT, int Kd, int k0, int n0, int dst_row0, LAS float* scr, int lane) {
#pragma unroll 8
    for (int i = 0; i < 32; ++i) { const int kk = 2 * i + (lane >> 5); scr[kk * 33 + (lane & 31)] = W[(size_t)(k0 + kk) * N + n0 + (lane & 31)]; }
    LDS_WAIT(); asm volatile("" ::: "memory");
    const int c = lane & 7;
#pragma unroll
    for (int j = 0; j < 4; ++j) { const int n = (lane >> 3) + 8 * j; const LAS float* s = scr + (8 * c) * 33 + n;
        v4u o; o.x = pk2(s[0 * 33], s[1 * 33]); o.y = pk2(s[2 * 33], s[3 * 33]); o.z = pk2(s[4 * 33], s[5 * 33]); o.w = pk2(s[6 * 33], s[7 * 33]);
        *(GAS v4u*)(WT + (size_t)(dst_row0 + n) * Kd + k0 + 8 * c) = o; }
    LDS_WAIT(); asm volatile("" ::: "memory");
}
__device__ __forceinline__ int win_slot(int n) { const int pn = n >> 8, r = n & 255; return 256 * pn + 128 * ((r >> 5) & 1) + 32 * (r >> 6) + (r & 31); }

struct Ptrs {
    const float *x, *c, *w_ada, *b_ada, *norm1_g, *w_in, *q_norm_g, *k_norm_g, *sinks, *pool_w, *pool_scale, *w_o, *norm2_g, *w1, *w2; const int* positions;
    float *out, *mod, *bias2, *a2, *rope, *stats; bf16 *Win_t, *Wo_t, *W1_t, *W2_t, *XN, *Q, *K, *V, *U, *MIX, *Z2, *H;
};

__device__ __forceinline__ void p0_mod_task(Frame& F, const Ptrs& P, int t) {
    LAS float* cact = (LAS float*)F.lds;
    LAS float* red = (LAS float*)(F.lds + 32768);
    for (int i = F.tid; i < BATCH * D; i += NWAVES * 64) { const float cv = P.c[i]; cact[i] = cv / (1.f + __expf(-cv)); }
    __syncthreads();
    const int j0 = 64 * t, kb = 128 * F.wave;
    float acc[BATCH];
#pragma unroll
    for (int b = 0; b < BATCH; ++b) acc[b] = 0.f;
#pragma unroll 8
    for (int k = 0; k < 128; ++k) { const float wv = P.w_ada[(size_t)(kb + k) * (NMOD * D) + j0 + F.lane];
#pragma unroll
        for (int b = 0; b < BATCH; ++b) acc[b] += cact[b * D + kb + k] * wv; }
#pragma unroll
    for (int b = 0; b < BATCH; ++b) red[(F.wave * BATCH + b) * 64 + F.lane] = acc[b];
    __syncthreads();
    { const int b = F.wave; float s = 0.f;
#pragma unroll
      for (int w = 0; w < NWAVES; ++w) s += red[(w * BATCH + b) * 64 + F.lane];
      P.mod[(size_t)b * NMOD * D + j0 + F.lane] = s + P.b_ada[j0 + F.lane]; }
    __syncthreads();
}
__device__ __forceinline__ void p0_fold_task(Frame& F, const Ptrs& P, int t) {
    const int g = t >> 5, n0 = (t & 31) * 32;
    LAS float* Pm = (LAS float*)F.lds;
    LAS float* Wm = (LAS float*)(F.lds + 128 * 129 * 4);
    for (int i = F.tid; i < 128 * 128; i += NWAVES * 64) { const int c = i >> 7, d = i & 127; Pm[c * 129 + d] = P.pool_w[(size_t)g * 16384 + i] * P.pool_scale[128 * g + d]; }
    for (int i = F.tid; i < 128 * 32; i += NWAVES * 64) { const int d = i >> 5, nn = i & 31; Wm[d * 33 + nn] = P.w_o[(size_t)(512 + 128 * g + d) * D + n0 + nn]; }
    __syncthreads();
    const int c = F.tid & 127, q = F.tid >> 7;
    float acc[8];
#pragma unroll
    for (int i = 0; i < 8; ++i) acc[i] = 0.f;
    for (int d = 0; d < 128; ++d) { const float p = Pm[c * 129 + d];
#pragma unroll
        for (int i = 0; i < 8; ++i) acc[i] += p * Wm[d * 33 + q + 4 * i]; }
#pragma unroll
    for (int i = 0; i < 8; ++i) P.Wo_t[(size_t)(n0 + q + 4 * i) * D + 512 + 128 * g + c] = (bf16)f2bf(acc[i]);
    __syncthreads();
}
__device__ __forceinline__ void p0a_prologue(Frame& F, const Ptrs& P) {
    for (int t = F.vcu; t < 96 + 128; t += F.G) { if (t < 96) p0_mod_task(F, P, t); else p0_fold_task(F, P, t - 96); }
    LAS float* scr = (LAS float*)(F.lds + F.wave * 16384);
    const int gw = F.vcu * NWAVES + F.wave, NGW = F.G * NWAVES;
    constexpr int I_IN = (D / 64) * (INW / 32), I_O = (AW / 64) * (D / 32), I_1 = (D / 64) * (FF / 32), I_2 = (FF / 64) * (D / 32);
    for (int it = gw; it < I_IN + I_O + I_1 + I_2; it += NGW) {
        int r = it;
        if (r < I_IN) { const int nblk = INW / 32, kb = r / nblk, nb = r % nblk; p0_transpose_item(P.w_in, INW, P.Win_t, D, 64 * kb, 32 * nb, win_slot(32 * nb), scr, F.lane); continue; } r -= I_IN;
        if (r < I_O) { const int nblk = D / 32, kb = r / nblk, nb = r % nblk; p0_transpose_item(P.w_o, D, P.Wo_t, D, 64 * kb, 32 * nb, 32 * nb, scr, F.lane); continue; } r -= I_O;
        if (r < I_1) { const int nblk = FF / 32, kb = r / nblk, nb = r % nblk; p0_transpose_item(P.w1, FF, P.W1_t, D, 64 * kb, 32 * nb, 32 * nb, scr, F.lane); continue; } r -= I_1;
        { const int nblk = D / 32, kb = r / nblk, nb = r % nblk; p0_transpose_item(P.w2, D, P.W2_t, FF, 64 * kb, 32 * nb, 32 * nb, scr, F.lane); }
    }
    for (int idx = (F.vcu * NWAVES * 64 + F.tid); idx < M * 8; idx += F.G * NWAVES * 64) {
        const int m = idx >> 3, i = idx & 7;
        const float inv_freq = (float)pow(500000.0, -(double)i / 8.0);
        const float ang = (float)P.positions[m] * inv_freq;
        P.rope[(size_t)m * 16 + i] = (float)cos((double)ang); P.rope[(size_t)m * 16 + 8 + i] = (float)sin((double)ang);
    }
}

__device__ __forceinline__ void p0b_norm(Frame& F, const Ptrs& P) {
    const int gt = F.vcu * NWAVES * 64 + F.tid, NGT = F.G * NWAVES * 64;
    for (int i = gt; i < BATCH * D; i += NGT) { const int b = i >> 10, col = i & 1023; P.a2[i] = P.norm2_g[col] * (1.f + P.mod[(size_t)b * NMOD * D + 4 * D + col]); }
    const int gw = F.vcu * NWAVES + F.wave, NGW = F.G * NWAVES;
    for (int n = gw; n < FF; n += NGW) {
        const v4u w0 = *(const GAS v4u*)(P.W1_t + (size_t)n * D + F.lane * 16), w1v = *(const GAS v4u*)(P.W1_t + (size_t)n * D + F.lane * 16 + 8);
        float wf[16]; wf[0] = bflo(w0.x); wf[1] = bfhi(w0.x); wf[2] = bflo(w0.y); wf[3] = bfhi(w0.y); wf[4] = bflo(w0.z); wf[5] = bfhi(w0.z); wf[6] = bflo(w0.w); wf[7] = bfhi(w0.w);
        wf[8] = bflo(w1v.x); wf[9] = bfhi(w1v.x); wf[10] = bflo(w1v.y); wf[11] = bfhi(w1v.y); wf[12] = bflo(w1v.z); wf[13] = bfhi(w1v.z); wf[14] = bflo(w1v.w); wf[15] = bfhi(w1v.w);
        for (int b = 0; b < BATCH; ++b) { const float* sh = P.mod + (size_t)b * NMOD * D + 3 * D + F.lane * 16; float s = 0.f;
#pragma unroll
            for (int j = 0; j < 4; ++j) { const f32x4 t = *(const f32x4*)(sh + 4 * j); s += (t[0] * wf[4 * j] + t[1] * wf[4 * j + 1]) + (t[2] * wf[4 * j + 2] + t[3] * wf[4 * j + 3]); }
            s = wave_sum(s); if (F.lane == 0) P.bias2[(size_t)b * FF + n] = s; }
    }
    for (int rb = gw; rb < M / 16; rb += NGW) {
        const int b = (rb * 16) / SEQ; const float* mb = P.mod + (size_t)b * NMOD * D;
        f32x4 av[4], sv[4];
#pragma unroll
        for (int j = 0; j < 4; ++j) { const int col = 256 * j + 4 * F.lane; const f32x4 g = *(const f32x4*)(P.norm1_g + col), sc = *(const f32x4*)(mb + D + col); av[j] = g * (sc + 1.0f); sv[j] = *(const f32x4*)(mb + col); }
        for (int rr = 0; rr < 16; ++rr) {
            const int m = rb * 16 + rr; const GAS f32x4* xr = (const GAS f32x4*)(P.x + (size_t)m * D) + F.lane;
            f32x4 v[4]; float s = 0.f;
#pragma unroll
            for (int j = 0; j < 4; ++j) { v[j] = xr[64 * j]; s += (v[j][0] * v[j][0] + v[j][1] * v[j][1]) + (v[j][2] * v[j][2] + v[j][3] * v[j][3]); }
            const float r = rsqrtf(wave_sum(s) * (1.f / D) + EPS);
            GAS unsigned long long* o8 = (GAS unsigned long long*)(P.XN + (size_t)m * D) + F.lane;
#pragma unroll
            for (int j = 0; j < 4; ++j) { const f32x4 y = v[j] * r * av[j] + sv[j]; o8[64 * j] = (unsigned long long)pk2(y[0], y[1]) | ((unsigned long long)pk2(y[2], y[3]) << 32); }
        }
    }
}

__device__ __forceinline__ int crow(int r, int hi) { return (r & 3) + 8 * (r >> 2) + 4 * hi; }
__device__ __forceinline__ unsigned cvtpk(float lo, float hi) { unsigned r; asm volatile("v_cvt_pk_bf16_f32 %0, %1, %2" : "=v"(r) : "v"(lo), "v"(hi)); return r; }
typedef short v4i16_t __attribute__((ext_vector_type(4)));
__device__ __forceinline__ s16x4 vtr(LAS const unsigned char* p) { return __builtin_bit_cast(s16x4, __builtin_amdgcn_ds_read_tr16_b64_v4i16((LAS v4i16_t*)p)); }

__device__ __forceinline__ void attn_unit(Frame& F, const Ptrs& P, int unit) {
    const int lane = F.lane, wid = F.wave, r32 = lane & 31, hi = lane >> 5;
    const int bk = unit >> 6, qb = unit & 63, b = bk >> 1, kvh = bk & 1, wh = wid & 1, hq = kvh * 4 + (wid >> 1);
    const long rowbase = (long)b * SEQ; const int q0 = qb * 64, kv0 = q0 - 128, qw0 = q0 + 32 * wh;
    LAS unsigned char* lds = F.lds;
    v4u kreg[3], vreg[3];
#pragma unroll
    for (int i = 0; i < 3; ++i) { const int kvr = kv0 + 64 * i + lane; kreg[i] = (v4u){0u, 0u, 0u, 0u}; if (kvr >= 0) kreg[i] = *(const GAS v4u*)(P.K + (rowbase + kvr) * KVW + kvh * 64 + wid * 8); }
#pragma unroll
    for (int i = 0; i < 3; ++i) { const int kvr = kv0 + 64 * i + 16 * (wid & 3) + (lane >> 2); vreg[i] = (v4u){0u, 0u, 0u, 0u}; if (kvr >= 0) vreg[i] = *(const GAS v4u*)(P.V + (rowbase + kvr) * KVW + kvh * 64 + (wid >> 2) * 32 + (lane & 3) * 8); }
    bf16x8 qr[4];
    { const bf16* Qw = P.Q + (rowbase + qw0 + r32) * AW + hq * 64 + hi * 8;
#pragma unroll
      for (int d0 = 0; d0 < 4; ++d0) qr[d0] = *(const GAS bf16x8*)(Qw + d0 * 16); }
#pragma unroll
    for (int i = 0; i < 3; ++i) { *(LAS v4u*)(lds + ATT_K + i * 8192 + wid * 1024 + lane * 16) = kreg[i]; *(LAS v4u*)(lds + ATT_V + i * 8192 + wid * 1024 + lane * 16) = vreg[i]; }
    __syncthreads();
    f32x16 p[5];
#pragma unroll
    for (int j = 0; j < 5; ++j) {
        const int hb = wh + j; const LAS unsigned char* kp = lds + ATT_K + (hb >> 1) * 8192 + hi * 1024 + ((hb & 1) * 32 + r32) * 16;
        f32x16 a = {0.f, 0.f, 0.f, 0.f, 0.f, 0.f, 0.f, 0.f, 0.f, 0.f, 0.f, 0.f, 0.f, 0.f, 0.f, 0.f};
#pragma unroll
        for (int d0 = 0; d0 < 4; ++d0) { const bf16x8 kf = *(const LAS bf16x8*)(kp + d0 * 2048); a = __builtin_amdgcn_mfma_f32_32x32x16_bf16(kf, qr[d0], a, 0, 0, 0); }
        p[j] = a;
    }
    const float NEG = -INFINITY;
#pragma unroll
    for (int j = 0; j < 5; ++j) {
        const bool valid = (qw0 - 128 + 32 * j) >= 0;
#pragma unroll
        for (int r = 0; r < 16; ++r) { bool keep = valid; if (j == 0) keep = keep && (crow(r, hi) > r32); if (j == 4) keep = keep && (crow(r, hi) <= r32); if (!keep) p[j][r] = NEG; }
    }
    const float sinkl2 = P.sinks[hq] * 1.4426950408889634f;
    float mx = sinkl2;
#pragma unroll
    for (int j = 0; j < 5; ++j)
#pragma unroll
        for (int r = 0; r < 16; ++r) mx = fmaxf(mx, p[j][r]);
    { auto rr = __builtin_amdgcn_permlane32_swap(__float_as_uint(mx), __float_as_uint(mx), false, false); mx = fmaxf(__uint_as_float(rr[0]), __uint_as_float(rr[1])); }
    float l = 0.f;
#pragma unroll
    for (int j = 0; j < 5; ++j)
#pragma unroll
        for (int r = 0; r < 16; ++r) { const float e = __builtin_amdgcn_exp2f(p[j][r] - mx); p[j][r] = e; l += e; }
    { auto rr = __builtin_amdgcn_permlane32_swap(__float_as_uint(l), __float_as_uint(l), false, false); l = __uint_as_float(rr[0]) + __uint_as_float(rr[1]); }
    l += __builtin_amdgcn_exp2f(sinkl2 - mx);
    f32x16 o[2];
    o[0] = (f32x16){0.f, 0.f, 0.f, 0.f, 0.f, 0.f, 0.f, 0.f, 0.f, 0.f, 0.f, 0.f, 0.f, 0.f, 0.f, 0.f}; o[1] = o[0];
    const LAS unsigned char* vb = lds + ATT_V + ((lane >> 4) & 1) * 32 + (lane & 3) * 8 + (4 * hi + ((lane & 15) >> 2)) * 64;
#pragma unroll
    for (int j = 0; j < 5; ++j) {
        const int hb = wh + j; const LAS unsigned char* vt = vb + (hb >> 1) * 8192 + (hb & 1) * 2048;
#pragma unroll
        for (int s = 0; s < 2; ++s) {
            v4u pw; pw.x = cvtpk(p[j][8 * s + 0], p[j][8 * s + 1]); pw.y = cvtpk(p[j][8 * s + 2], p[j][8 * s + 3]); pw.z = cvtpk(p[j][8 * s + 4], p[j][8 * s + 5]); pw.w = cvtpk(p[j][8 * s + 6], p[j][8 * s + 7]);
            const bf16x8 pf = __builtin_bit_cast(bf16x8, pw);
#pragma unroll
            for (int d0 = 0; d0 < 2; ++d0) {
                const s16x4 lo = vtr(vt + d0 * 4096 + s * 1024), hh = vtr(vt + d0 * 4096 + s * 1024 + 512);
                const bf16x8 vf = (bf16x8){lo[0], lo[1], lo[2], lo[3], hh[0], hh[1], hh[2], hh[3]};
                o[d0] = __builtin_amdgcn_mfma_f32_32x32x16_bf16(pf, vf, o[d0], 0, 0, 0);
            }
        }
    }
    LAS float* wsf = (LAS float*)(lds + ATT_WS) + wid * 64;
    if (hi == 0) wsf[r32] = l;
    LDS_WAIT(); asm volatile("" ::: "memory");
    float rli[16];
#pragma unroll
    for (int r = 0; r < 16; ++r) rli[r] = __builtin_amdgcn_rcpf(wsf[crow(r, hi)]);
    LAS bf16* stg = (LAS bf16*)(lds + ATT_OST) + wid * 2048;
#pragma unroll
    for (int r = 0; r < 16; ++r) { const int orow = crow(r, hi);
#pragma unroll
        for (int d0 = 0; d0 < 2; ++d0) stg[orow * 64 + d0 * 32 + r32] = (bf16)f2bf(o[d0][r] * rli[r]); }
    LDS_WAIT(); asm volatile("" ::: "memory");
    bf16* Ow = P.MIX + (rowbase + qw0) * D + hq * 64;
#pragma unroll
    for (int i = 0; i < 4; ++i) { const int row = i * 8 + (lane >> 3), ch = lane & 7; const v4u v = *(const LAS v4u*)(stg + row * 64 + ch * 8); *(GAS v4u*)(Ow + (size_t)row * D + ch * 8) = v; }
    __syncthreads();
}
__device__ __forceinline__ void unpack8(const v4u w, float (&f)[8]) { f[0] = bflo(w.x); f[1] = bfhi(w.x); f[2] = bflo(w.y); f[3] = bfhi(w.y); f[4] = bflo(w.z); f[5] = bfhi(w.z); f[6] = bflo(w.w); f[7] = bfhi(w.w); }
__device__ __forceinline__ void pool_task(Frame& F, const Ptrs& P, int task) {
    const int g = task & 3, rb = task >> 2, w = 2 << g;
    const int ch = F.lane & 15, run = F.lane >> 4;
    const int m0 = rb * 128 + run * 32, t0 = m0 & (SEQ - 1);
    const bf16* up = P.U + g * 128 + ch * 8;
    float S[8];
#pragma unroll
    for (int e = 0; e < 8; ++e) S[e] = 0.f;
    for (int j = 1; j <= w; ++j) if (t0 - j >= 0) { float f[8]; unpack8(*(const GAS v4u*)(up + (size_t)(m0 - j) * PW), f);
#pragma unroll
        for (int e = 0; e < 8; ++e) S[e] += f[e]; }
#pragma unroll 4
    for (int i = 0; i < 32; ++i) {
        const int m = m0 + i, t = t0 + i; float u[8]; unpack8(*(const GAS v4u*)(up + (size_t)m * PW), u);
#pragma unroll
        for (int e = 0; e < 8; ++e) S[e] += u[e];
        if (t - w >= 0) { float f[8]; unpack8(*(const GAS v4u*)(up + (size_t)(m - w) * PW), f);
#pragma unroll
            for (int e = 0; e < 8; ++e) S[e] -= f[e]; }
        const float inv = 1.0f / (float)((t + 1) < w ? (t + 1) : w);
        v4u o; o.x = pk2(S[0] * inv - u[0], S[1] * inv - u[1]); o.y = pk2(S[2] * inv - u[2], S[3] * inv - u[3]); o.z = pk2(S[4] * inv - u[4], S[5] * inv - u[5]); o.w = pk2(S[6] * inv - u[6], S[7] * inv - u[7]);
        *(GAS v4u*)(P.MIX + (size_t)m * D + AW + g * 128 + ch * 8) = o;
    }
}
__device__ __forceinline__ void p2_attn_pool(Frame& F, const Ptrs& P) {
    constexpr int NUNITS = BATCH * NKV * (SEQ / 64);
    const int upw = (NUNITS + F.G - 1) / F.G;
    for (int i = 0; i < upw; ++i) { const int unit = F.vcu * upw + i; if (unit < NUNITS) attn_unit(F, P, unit); }
    const int gw = F.vcu * NWAVES + F.wave, NGW = F.G * NWAVES;
    for (int t = gw; t < 4 * (M / 128); t += NGW) pool_task(F, P, t);
}

struct Args { const void* in[16]; float* out; unsigned char* ws; int ph_lo, ph_hi; };
__global__ void __launch_bounds__(NWAVES * 64, 2) fwd_megakernel(Args args) {
    extern __shared__ __attribute__((aligned(16))) unsigned char lds[];
    Frame F;
    F.lds = (LAS unsigned char*)lds;
    F.tid = threadIdx.x; F.lane = F.tid & 63; F.wave = __builtin_amdgcn_readfirstlane(F.tid >> 6);
    F.G = gridDim.x; { const int bx = blockIdx.x; F.vcu = (F.G % 8 == 0) ? (bx % 8) * (F.G / 8) + bx / 8 : bx; }
    unsigned char* ws = args.ws;
    Ptrs P;
    P.x = (const float*)args.in[0]; P.c = (const float*)args.in[1]; P.positions = (const int*)args.in[2]; P.w_ada = (const float*)args.in[3]; P.b_ada = (const float*)args.in[4];
    P.norm1_g = (const float*)args.in[5]; P.w_in = (const float*)args.in[6]; P.q_norm_g = (const float*)args.in[7]; P.k_norm_g = (const float*)args.in[8]; P.sinks = (const float*)args.in[9];
    P.pool_w = (const float*)args.in[10]; P.pool_scale = (const float*)args.in[11]; P.w_o = (const float*)args.in[12]; P.norm2_g = (const float*)args.in[13]; P.w1 = (const float*)args.in[14]; P.w2 = (const float*)args.in[15];
    P.out = args.out; P.mod = (float*)(ws + WS_MOD); P.bias2 = (float*)(ws + WS_BIAS2); P.a2 = (float*)(ws + WS_A2); P.rope = (float*)(ws + WS_ROPE); P.stats = (float*)(ws + WS_STATS);
    P.Win_t = (bf16*)(ws + WS_WIN); P.Wo_t = (bf16*)(ws + WS_WO); P.W1_t = (bf16*)(ws + WS_W1); P.W2_t = (bf16*)(ws + WS_W2);
    P.XN = (bf16*)(ws + WS_XN); P.Q = (bf16*)(ws + WS_Q); P.K = (bf16*)(ws + WS_K); P.V = (bf16*)(ws + WS_V); P.U = (bf16*)(ws + WS_U); P.MIX = (bf16*)(ws + WS_MIX); P.Z2 = (bf16*)(ws + WS_Z2); P.H = (bf16*)(ws + WS_H);
    volatile LAS unsigned* MISC = (volatile LAS unsigned*)(F.lds + MISC_OFF);
    if (F.tid < 64) MISC[F.tid] = 0u;
    __syncthreads();
    XcdBarrier bar; bar.bar = (unsigned*)(ws + WS_CTL) + CW_BAR; bar.x = 0; bar.st = nullptr;
    if (N_LAUNCHES == 1) bar = xcd_barrier_post((unsigned*)(ws + WS_CTL) + CW_BAR, MISC + 8);
    const int lo = args.ph_lo, hi = args.ph_hi;
#define IN(k) (lo <= (k) && (k) < hi)
#define SEAM(k) do { if (IN(k) && IN((k) + 1)) xcd_barrier(bar); } while (0)

    if (IN(0)) { p0a_prologue(F, P); SEAM(0); }
    if (IN(1)) { p0b_norm(F, P); SEAM(1); }
    if (IN(2)) {
        pg8::Gemm g{P.XN, P.Win_t, M, INW, D}; pg8::StaticOrder S; S.init(M, INW, F.G, (int)blockIdx.x);
        pg8::EpiProj E{P.Q, P.K, P.V, P.U, P.rope, P.q_norm_g, P.k_norm_g};
        pg8::gemm_phase<pg8::EpiProj, pg8::StaticOrder, true, true>(F.lds, g, S, E);
        SEAM(2);
    }
    if (IN(3)) { p2_attn_pool(F, P); SEAM(3); }
    if (IN(4)) {
        pg8::Gemm g{P.MIX, P.Wo_t, M, D, D}; pg8::StaticOrder S; S.init(M, D, F.G, (int)blockIdx.x);
        pg8::EpiWo E{P.x, P.out, P.Z2, P.mod, P.a2, P.stats};
        pg8::gemm_phase<pg8::EpiWo, pg8::StaticOrder, true, true>(F.lds, g, S, E);
        SEAM(4);
    }
    if (IN(5)) {
        pg8::Gemm g{P.Z2, P.W1_t, M, FF, D}; pg8::StaticOrder S; S.init(M, FF, F.G, (int)blockIdx.x);
        pg8::EpiUp E{P.H, P.stats, P.bias2, FF};
        pg8::gemm_phase<pg8::EpiUp, pg8::StaticOrder, true, true>(F.lds, g, S, E);
        SEAM(5);
    }
    if (IN(6)) {
        pg8::Gemm g{P.H, P.W2_t, M, D, FF}; pg8::StaticOrder S; S.init(M, D, F.G, (int)blockIdx.x);
        pg8::EpiDown E{P.out, P.mod};
        pg8::gemm_phase<pg8::EpiDown, pg8::StaticOrder, true, true>(F.lds, g, S, E);
    }
#undef IN
#undef SEAM
}

#ifndef HYB
extern "C" void kernel_launch(void* const* d_in, const int* in_sizes, int n_in, void* d_out, int out_size, void* d_ws, size_t ws_size, hipStream_t stream) {
    static int grid = 0;
    if (grid == 0) {
        if (n_in != 16 || out_size != M * D || ws_size < WS_END) { fprintf(stderr, "kernel_launch: unexpected shapes (n_in %d out %d ws %zu)\n", n_in, out_size, ws_size); grid = -1; return; }
        int dev = 0, cus = 0, per_cu = 0;
        if (hipGetDevice(&dev) != hipSuccess || hipDeviceGetAttribute(&cus, hipDeviceAttributeMultiprocessorCount, dev) != hipSuccess) { grid = -1; return; }
        if (hipFuncSetAttribute((const void*)fwd_megakernel, hipFuncAttributeMaxDynamicSharedMemorySize, LDS_BYTES) != hipSuccess) { fprintf(stderr, "kernel_launch: hipFuncSetAttribute failed\n"); grid = -1; return; }
        if (hipOccupancyMaxActiveBlocksPerMultiprocessor(&per_cu, (const void*)fwd_megakernel, NWAVES * 64, LDS_BYTES) != hipSuccess || per_cu < 1) { fprintf(stderr, "kernel_launch: occupancy query says %d\n", per_cu); per_cu = 1; }
        (void)hipGetLastError();
        if (per_cu > 1) per_cu = 1;
        grid = cus * per_cu;
    }
    if (grid < 0) return;
    (void)hipMemsetAsync((char*)d_ws + WS_CTL, 0, CTL_ZERO_BYTES, stream);
    Args a{};
    for (int i = 0; i < 16; ++i) a.in[i] = d_in[i];
    a.out = (float*)d_out; a.ws = (unsigned char*)d_ws;
    if (N_LAUNCHES == 1) { a.ph_lo = 0; a.ph_hi = N_PHASES; hipLaunchKernelGGL(fwd_megakernel, dim3(grid), dim3(NWAVES * 64), LDS_BYTES, stream, a); }
    else for (int li = 0; li < N_PHASES; ++li) { a.ph_lo = li; a.ph_hi = li + 1; hipLaunchKernelGGL(fwd_megakernel, dim3(grid), dim3(NWAVES * 64), LDS_BYTES, stream, a); }
}
#endif

#ifdef HYB
__global__ void dbg_norm(const float* __restrict__ x, const float* __restrict__ g, const float* __restrict__ mod, int sh_off, int sc_off, bf16* __restrict__ out) {
    const int wave = (blockIdx.x * blockDim.x + threadIdx.x) >> 6, lane = threadIdx.x & 63;
    if (wave >= M) return;
    const int b = wave / SEQ; const float* xr = x + (size_t)wave * D;
    float v[16]; float s = 0.f;
#pragma unroll
    for (int j = 0; j < 4; ++j) { const f32x4 t = *(const f32x4*)(xr + j * 256 + lane * 4); v[4 * j] = t[0]; v[4 * j + 1] = t[1]; v[4 * j + 2] = t[2]; v[4 * j + 3] = t[3]; s += t[0] * t[0] + t[1] * t[1] + t[2] * t[2] + t[3] * t[3]; }
    s = wave_sum(s);
    const float r = rsqrtf(s * (1.f / D) + EPS); const float* mb = mod + (size_t)b * NMOD * D;
#pragma unroll
    for (int j = 0; j < 4; ++j)
#pragma unroll
        for (int i = 0; i < 4; ++i) { const int col = j * 256 + lane * 4 + i; const float y = v[4 * j + i] * r * g[col] * (1.f + mb[sc_off + col]) + mb[sh_off + col]; out[(size_t)wave * D + col] = (bf16)f2bf(y); }
}
template <int MODE>
__global__ __launch_bounds__(256) void dbg_gemm(const bf16* __restrict__ A, const float* __restrict__ B, int N, int K, void* Cout, const float* X, const float* __restrict__ mod, int gate_off) {
    __shared__ __attribute__((aligned(16))) bf16 sA[128][40];
    __shared__ __attribute__((aligned(16))) bf16 sB[128][40];
    const int tid = threadIdx.x, lane = tid & 63, w = tid >> 6, wr = w >> 1, wc = w & 1;
    const int m0 = blockIdx.y * 128, n0 = blockIdx.x * 128;
    f32x4 acc[4][4];
#pragma unroll
    for (int i = 0; i < 4; ++i)
#pragma unroll
        for (int j = 0; j < 4; ++j) acc[i][j] = (f32x4){0.f, 0.f, 0.f, 0.f};
    for (int k0 = 0; k0 < K; k0 += 32) {
        { const int r = tid >> 1, cc = (tid & 1) * 16; const bf16x8* src = (const bf16x8*)(A + (size_t)(m0 + r) * K + k0 + cc); *(bf16x8*)&sA[r][cc] = src[0]; *(bf16x8*)&sA[r][cc + 8] = src[1]; }
        { const int kk = tid >> 3, nn = (tid & 7) * 16; const float* src = B + (size_t)(k0 + kk) * N + n0 + nn;
#pragma unroll
          for (int i = 0; i < 16; ++i) sB[nn + i][kk] = (bf16)f2bf(src[i]); }
        __syncthreads();
        bf16x8 a[4], b[4];
#pragma unroll
        for (int i = 0; i < 4; ++i) a[i] = *(const bf16x8*)&sA[wr * 64 + i * 16 + (lane & 15)][8 * (lane >> 4)];
#pragma unroll
        for (int j = 0; j < 4; ++j) b[j] = *(const bf16x8*)&sB[wc * 64 + j * 16 + (lane & 15)][8 * (lane >> 4)];
#pragma unroll
        for (int i = 0; i < 4; ++i)
#pragma unroll
            for (int j = 0; j < 4; ++j) acc[i][j] = __builtin_amdgcn_mfma_f32_16x16x32_bf16(a[i], b[j], acc[i][j], 0, 0, 0);
        __syncthreads();
    }
#pragma unroll
    for (int i = 0; i < 4; ++i)
#pragma unroll
        for (int j = 0; j < 4; ++j)
#pragma unroll
            for (int r = 0; r < 4; ++r) {
                const int row = m0 + wr * 64 + i * 16 + (lane >> 4) * 4 + r, col = n0 + wc * 64 + j * 16 + (lane & 15);
                const float v = acc[i][j][r]; const size_t o = (size_t)row * N + col;
                if (MODE == 0) ((bf16*)Cout)[o] = (bf16)f2bf(v);
                else if (MODE == 2) { const float t = v > 0.f ? v : 0.f; ((bf16*)Cout)[o] = (bf16)f2bf(t * t); }
                else { const int b_ = row / SEQ; const float gt = mod[(size_t)b_ * NMOD * D + gate_off + col]; const float base = (MODE == 1) ? X[o] : ((float*)Cout)[o]; ((float*)Cout)[o] = base + gt * v; }
            }
}
__global__ __launch_bounds__(64) void dbg_attn(const bf16* __restrict__ Q, const bf16* __restrict__ Kb, const bf16* __restrict__ Vb, const float* __restrict__ sinks, bf16* __restrict__ MIX) {
    const int id = blockIdx.x * blockDim.x + threadIdx.x;
    if (id >= M * NH) return;
    const int m = id / NH, hq = id % NH, kvh = hq / 4, b = m / SEQ, t = m % SEQ;
    float q[64], acc[64];
#pragma unroll
    for (int d = 0; d < 64; ++d) { q[d] = bf2f(Q[(size_t)m * AW + hq * 64 + d]); acc[d] = 0.f; }
    float mx = -1e30f, l = 0.f;
    const int j0 = t - 127 < 0 ? 0 : t - 127;
    for (int j = j0; j <= t; ++j) {
        const size_t kr = (size_t)(b * SEQ + j); float s = 0.f;
#pragma unroll
        for (int d = 0; d < 64; ++d) s += q[d] * bf2f(Kb[kr * KVW + kvh * 64 + d]);
        s *= 0.6931471805599453f;
        const float mn = fmaxf(mx, s); const float f = __expf(mx - mn), p = __expf(s - mn);
        l = l * f + p;
#pragma unroll
        for (int d = 0; d < 64; ++d) acc[d] = acc[d] * f + p * bf2f(Vb[kr * KVW + kvh * 64 + d]);
        mx = mn;
    }
    const float sk = sinks[hq]; const float mn = fmaxf(mx, sk); const float f = __expf(mx - mn);
    l = l * f + __expf(sk - mn);
    const float inv = f / l;
#pragma unroll
    for (int d = 0; d < 64; ++d) MIX[(size_t)m * D + hq * 64 + d] = (bf16)f2bf(acc[d] * inv);
}
__global__ void dbg_pool(const bf16* __restrict__ U, bf16* __restrict__ POOLED) {
    const int id = blockIdx.x * blockDim.x + threadIdx.x;
    if (id >= M * PW) return;
    const int m = id / PW, c = id % PW, g = c / 128, w = 2 << g, t = m % SEQ;
    const int cnt = (t + 1) < w ? (t + 1) : w; float s = 0.f;
    for (int j = 0; j < cnt; ++j) s += bf2f(U[(size_t)(m - j) * PW + c]);
    POOLED[(size_t)m * PW + c] = (bf16)f2bf(s / (float)cnt - bf2f(U[(size_t)m * PW + c]));
}
__global__ void dbg_copy_pooled(const bf16* __restrict__ MIX, bf16* __restrict__ POOLED) {
    const int id = blockIdx.x * blockDim.x + threadIdx.x;
    if (id >= M * PW) return;
    POOLED[id] = MIX[(size_t)(id / PW) * D + AW + (id % PW)];
}
__global__ void dbg_poolmm(const bf16* __restrict__ POOLED, const float* __restrict__ pool_w, const float* __restrict__ pool_scale, bf16* __restrict__ MIX) {
    const int id = blockIdx.x * blockDim.x + threadIdx.x;
    if (id >= M * PW) return;
    const int m = id / PW, c = id % PW, g = c / 128, d = c % 128; float s = 0.f;
    for (int k = 0; k < 128; ++k) s += bf2f(POOLED[(size_t)m * PW + g * 128 + k]) * pool_w[(size_t)(g * 128 + k) * 128 + d];
    MIX[(size_t)m * D + AW + c] = (bf16)f2bf(s * pool_scale[c]);
}
extern "C" void kernel_launch(void* const* d_in, const int* in_sizes, int n_in, void* d_out, int out_size, void* d_ws, size_t ws_size, hipStream_t stream) {
    static int grid = 0;
    if (grid == 0) {
        hipFuncSetAttribute((const void*)fwd_megakernel, hipFuncAttributeMaxDynamicSharedMemorySize, LDS_BYTES);
        grid = 256;
    }
    (void)hipMemsetAsync((char*)d_ws + WS_CTL, 0, CTL_ZERO_BYTES, stream);
    Args a{};
    for (int i = 0; i < 16; ++i) a.in[i] = d_in[i];
    a.out = (float*)d_out; a.ws = (unsigned char*)d_ws;
    unsigned char* ws = (unsigned char*)d_ws;
    const float* x = (const float*)d_in[0]; const float* sinks = (const float*)d_in[9]; const float* pool_w = (const float*)d_in[10]; const float* pool_scale = (const float*)d_in[11];
    const float* w_o = (const float*)d_in[12]; const float* norm2_g = (const float*)d_in[13]; const float* w1 = (const float*)d_in[14]; const float* w2 = (const float*)d_in[15];
    float* out = (float*)d_out; float* mod = (float*)(ws + WS_MOD);
    bf16 *Q = (bf16*)(ws + WS_Q), *Kb = (bf16*)(ws + WS_K), *Vb = (bf16*)(ws + WS_V), *U = (bf16*)(ws + WS_U), *MIX = (bf16*)(ws + WS_MIX), *Z2 = (bf16*)(ws + WS_Z2), *H = (bf16*)(ws + WS_H);
#define PH(lo_, hi_) do { a.ph_lo = lo_; a.ph_hi = hi_; for (int li = lo_; li < hi_; ++li) { a.ph_lo = li; a.ph_hi = li + 1; hipLaunchKernelGGL(fwd_megakernel, dim3(grid), dim3(NWAVES * 64), LDS_BYTES, stream, a); } } while (0)
    PH(0, 3);
#if HYB == 1
    dbg_attn<<<M * NH / 64, 64, 0, stream>>>(Q, Kb, Vb, sinks, MIX);
    dbg_pool<<<M * PW / 256, 256, 0, stream>>>(U, Z2);
#else
    PH(3, 4);
    dbg_copy_pooled<<<M * PW / 256, 256, 0, stream>>>(MIX, Z2);
#endif
    dbg_poolmm<<<M * PW / 256, 256, 0, stream>>>(Z2, pool_w, pool_scale, MIX);
    dbg_gemm<1><<<dim3(D / 128, M / 128), 256, 0, stream>>>(MIX, w_o, D, D, out, x, mod, 2 * D);
    dbg_norm<<<M / 4, 256, 0, stream>>>(out, norm2_g, mod, 3 * D, 4 * D, Z2);
    dbg_gemm<2><<<dim3(FF / 128, M / 128), 256, 0, stream>>>(Z2, w1, FF, D, H, nullptr, mod, 0);
    dbg_gemm<3><<<dim3(D / 128, M / 128), 256, 0, stream>>>(H, w2, D, FF, out, nullptr, mod, 5 * D);
}
#endif
```

```cpp
#define MK_N_LAUNCHES 1
#include <hip/hip_runtime.h>
#include <cstdio>
#include <cstdint>
#include <cmath>
namespace pg8 {
#define PG8_LAS __attribute__((address_space(3)))
typedef unsigned short bf16_t;
typedef short bf16x8 __attribute__((ext_vector_type(8)));
typedef float f32x4 __attribute__((ext_vector_type(4)));
typedef unsigned u32x4 __attribute__((ext_vector_type(4)));
constexpr int BM = 256, BK = 64, HALF = 128, HTB = HALF * BK * 2  , STAGE_BYTES = 8 * HTB, NXCD = 8, WGM = 8;

__host__ __device__ __forceinline__ int lds_byte(int r, int c) { const int st = (r >> 4) * 2 + (c >> 5), rr = r & 15, cc = c & 31, ob = rr * 64 + cc * 2; return st * 1024 + (ob ^ (((ob >> 9) & 1) << 5)); }
__host__ __device__ __forceinline__ void stage_rc(int b, int& R, int& C) { const int st = b / 1024, sb = b % 1024, swz = sb ^ (((sb >> 9) & 1) << 5); R = (st >> 1) * 16 + swz / 64; C = (st & 1) * 32 + (swz % 64) / 2; }
__host__ __device__ __forceinline__ int perm32(int rho) { const int n = rho >> 4, i = rho & 15; return 8 * (i >> 2) + 4 * n + (i & 3); }

struct Unit { int pm, pn; };
struct Gemm { const bf16_t* A; const bf16_t* Bt; int M, N, K; };

struct StaticOrder {
    int nM, nN, nwg, G, c;
    __host__ __device__ void init(int M, int N, int G_, int c_) { nM = M / BM; nN = N / BM; nwg = nM * nN; G = G_; c = c_; }
    __host__ __device__ bool next(int i, Unit& u) const {
        const long L = (long)i * G + c; if (L >= nwg) return false;
        int wgid = (int)L; { const int q = nwg / NXCD, r = nwg % NXCD, xcd = wgid % NXCD, off = wgid / NXCD; wgid = (xcd < r ? xcd * (q + 1) : r * (q + 1) + (xcd - r) * q) + off; }
        const int nig = WGM * nN, gid = wgid / nig, fm = gid * WGM, gsz = (nM - fm) < WGM ? (nM - fm) : WGM;
        u.pm = fm + ((wgid % nig) % gsz); u.pn = (wgid % nig) / gsz; return true;
    }
    __device__ __forceinline__ void a_ready(const Unit&) const {}
    __device__ __forceinline__ void done(const Unit&) const {}
};

__device__ __forceinline__ unsigned cvt_pk_bf16(float lo, float hi) { unsigned r; asm volatile("v_cvt_pk_bf16_f32 %0, %1, %2" : "=v"(r) : "v"(lo), "v"(hi)); return r; }
typedef float f32x2 __attribute__((ext_vector_type(2)));
constexpr int SEQ_ = 4096, DM_ = 1024, NMOD_ = 6;
constexpr float EPS_ = 1e-6f;
constexpr float QSCALE = 0.125f * 1.4426950408889634f;

__device__ __forceinline__ u32x4 pack8(const f32x4 a, const f32x4 b) { u32x4 w; w.x = cvt_pk_bf16(a[0], a[1]); w.y = cvt_pk_bf16(a[2], a[3]); w.z = cvt_pk_bf16(b[0], b[1]); w.w = cvt_pk_bf16(b[2], b[3]); return w; }

struct EpiProj {
    static constexpr bool PERM = true, AFTER_DRAIN = false;
    bf16_t *Q, *Kb, *V, *U; const float* rope; const float* qg; const float* kg;
    __device__ __forceinline__ void operator()(const f32x4 (&acc)[2][2][4][2], const Unit& u, int wr, int wc, int fr, int fq) const {
        const int row0 = u.pm * BM + wr * 64 + fr;
        if (u.pn >= 3 || (u.pn == 2 && wc >= 2)) {
            bf16_t* base; int pitch;
            if (u.pn >= 3) { base = U + (u.pn - 3) * 256 + wc * 64 + 8 * fq; pitch = 512; } else { base = V + (wc - 2) * 64 + 8 * fq; pitch = 128; }
#pragma unroll
            for (int ai = 0; ai < 2; ++ai)
#pragma unroll
                for (int m = 0; m < 4; ++m) { bf16_t* rowp = base + (size_t)(row0 + ai * HALF + m * 16) * pitch;
#pragma unroll
                    for (int bj = 0; bj < 2; ++bj) *(u32x4*)(rowp + bj * 32) = pack8(acc[ai][bj][m][0], acc[ai][bj][m][1]); }
        } else {
            const bool isq = u.pn < 2; const float* g = isq ? qg : kg; const float sc = isq ? QSCALE : 1.0f;
            bf16_t* base = isq ? Q + (4 * u.pn + wc) * 64 + 8 * fq : Kb + wc * 64 + 8 * fq; const int pitch = isq ? 512 : 128;
            f32x4 gv[2][2];
#pragma unroll
            for (int bj = 0; bj < 2; ++bj)
#pragma unroll
                for (int n = 0; n < 2; ++n) gv[bj][n] = *(const f32x4*)(g + 32 * bj + 8 * fq + 4 * n);
#pragma unroll
            for (int ai = 0; ai < 2; ++ai)
#pragma unroll
                for (int m = 0; m < 4; ++m) {
                    const int row = row0 + ai * HALF + m * 16;
                    f32x4 cs[2], sn[2];
#pragma unroll
                    for (int n = 0; n < 2; ++n) { cs[n] = *(const f32x4*)(rope + (size_t)row * 16 + 4 * n); sn[n] = *(const f32x4*)(rope + (size_t)row * 16 + 8 + 4 * n); }
                    float ss = 0.f;
#pragma unroll
                    for (int bj = 0; bj < 2; ++bj)
#pragma unroll
                        for (int n = 0; n < 2; ++n) { const f32x4 v = acc[ai][bj][m][n]; ss += (v[0] * v[0] + v[1] * v[1]) + (v[2] * v[2] + v[3] * v[3]); }
                    ss += __shfl_xor(ss, 16); ss += __shfl_xor(ss, 32);
                    const float r = rsqrtf(ss * (1.0f / 64.0f) + EPS_);
                    f32x4 y[2][2];
#pragma unroll
                    for (int bj = 0; bj < 2; ++bj)
#pragma unroll
                        for (int n = 0; n < 2; ++n) y[bj][n] = acc[ai][bj][m][n] * r * gv[bj][n];
#pragma unroll
                    for (int n = 0; n < 2; ++n)
#pragma unroll
                        for (int e = 0; e < 4; ++e) { const float mine = y[0][n][e]; const float other = __shfl_xor(mine, 16);
                            const float ro = (fq == 0) ? mine * cs[n][e] - other * sn[n][e] : mine * cs[n][e] + other * sn[n][e];
                            y[0][n][e] = (fq < 2) ? ro : mine; }
                    bf16_t* rowp = base + (size_t)row * pitch;
#pragma unroll
                    for (int bj = 0; bj < 2; ++bj) *(u32x4*)(rowp + bj * 32) = pack8(y[bj][0] * sc, y[bj][1] * sc);
                }
        }
    }
};

struct EpiWo {
    static constexpr bool PERM = true, AFTER_DRAIN = false;
    const float* x; float* x1; bf16_t* z; const float* mod; const float* a2; float* stats;
    __device__ __forceinline__ void operator()(const f32x4 (&acc)[2][2][4][2], const Unit& u, int wr, int wc, int fr, int fq) const {
        const int b = (u.pm * BM) / SEQ_; const int col0 = u.pn * BM + wc * 32 + 8 * fq; const int row0 = u.pm * BM + wr * 64 + fr;
        f32x4 gv[2][2], av[2][2];
#pragma unroll
        for (int bj = 0; bj < 2; ++bj)
#pragma unroll
            for (int n = 0; n < 2; ++n) { gv[bj][n] = *(const f32x4*)(mod + (size_t)b * NMOD_ * DM_ + 2 * DM_ + col0 + bj * HALF + 4 * n); av[bj][n] = *(const f32x4*)(a2 + (size_t)b * DM_ + col0 + bj * HALF + 4 * n); }
#pragma unroll
        for (int ai = 0; ai < 2; ++ai)
#pragma unroll
            for (int m = 0; m < 4; ++m) {
                const int row = row0 + ai * HALF + m * 16; const size_t off = (size_t)row * DM_ + col0; float ss = 0.f;
#pragma unroll
                for (int bj = 0; bj < 2; ++bj) {
                    const f32x4 xa = *(const f32x4*)(x + off + bj * HALF), xb = *(const f32x4*)(x + off + bj * HALF + 4);
                    const f32x4 v0 = xa + gv[bj][0] * acc[ai][bj][m][0], v1 = xb + gv[bj][1] * acc[ai][bj][m][1];
                    *(f32x4*)(x1 + off + bj * HALF) = v0; *(f32x4*)(x1 + off + bj * HALF + 4) = v1;
                    ss += (v0[0] * v0[0] + v0[1] * v0[1]) + (v0[2] * v0[2] + v0[3] * v0[3]) + (v1[0] * v1[0] + v1[1] * v1[1]) + (v1[2] * v1[2] + v1[3] * v1[3]);
                    *(u32x4*)(z + off + bj * HALF) = pack8(v0 * av[bj][0], v1 * av[bj][1]);
                }
                ss += __shfl_xor(ss, 16); ss += __shfl_xor(ss, 32);
                if (fq == 0) stats[(size_t)row * 16 + u.pn * 4 + wc] = ss;
            }
    }
};

struct EpiUp {
    static constexpr bool PERM = true, AFTER_DRAIN = false;
    bf16_t* H; const float* stats; const float* bias2; int ldc;
    __device__ __forceinline__ void operator()(const f32x4 (&acc)[2][2][4][2], const Unit& u, int wr, int wc, int fr, int fq) const {
        const int b = (u.pm * BM) / SEQ_; const int col0 = u.pn * BM + wc * 32 + 8 * fq; const int row0 = u.pm * BM + wr * 64 + fr;
        f32x4 bv[2][2];
#pragma unroll
        for (int bj = 0; bj < 2; ++bj)
#pragma unroll
            for (int n = 0; n < 2; ++n) bv[bj][n] = *(const f32x4*)(bias2 + (size_t)b * ldc + col0 + bj * HALF + 4 * n);
#pragma unroll
        for (int ai = 0; ai < 2; ++ai)
#pragma unroll
            for (int m = 0; m < 4; ++m) {
                const int row = row0 + ai * HALF + m * 16;
                const f32x4 st = *(const f32x4*)(stats + (size_t)row * 16 + 4 * fq);
                float s = (st[0] + st[1]) + (st[2] + st[3]); s += __shfl_xor(s, 16); s += __shfl_xor(s, 32);
                const float r = rsqrtf(s * (1.0f / DM_) + EPS_);
                bf16_t* rowp = H + (size_t)row * ldc + col0;
#pragma unroll
                for (int bj = 0; bj < 2; ++bj) {
                    f32x4 v0 = acc[ai][bj][m][0] * r + bv[bj][0], v1 = acc[ai][bj][m][1] * r + bv[bj][1];
#pragma unroll
                    for (int e = 0; e < 4; ++e) { const float t0 = fmaxf(v0[e], 0.f), t1 = fmaxf(v1[e], 0.f); v0[e] = t0 * t0; v1[e] = t1 * t1; }
                    *(u32x4*)(rowp + bj * HALF) = pack8(v0, v1);
                }
            }
    }
};

struct EpiDown {
    static constexpr bool PERM = true, AFTER_DRAIN = false;
    float* out; const float* mod;
    __device__ __forceinline__ void operator()(const f32x4 (&acc)[2][2][4][2], const Unit& u, int wr, int wc, int fr, int fq) const {
        const int b = (u.pm * BM) / SEQ_; const int col0 = u.pn * BM + wc * 32 + 8 * fq; const int row0 = u.pm * BM + wr * 64 + fr;
        f32x4 gv[2][2];
#pragma unroll
        for (int bj = 0; bj < 2; ++bj)
#pragma unroll
            for (int n = 0; n < 2; ++n) gv[bj][n] = *(const f32x4*)(mod + (size_t)b * NMOD_ * DM_ + 5 * DM_ + col0 + bj * HALF + 4 * n);
#pragma unroll
        for (int ai = 0; ai < 2; ++ai)
#pragma unroll
            for (int m = 0; m < 4; ++m) {
                const size_t off = (size_t)(row0 + ai * HALF + m * 16) * DM_ + col0;
#pragma unroll
                for (int bj = 0; bj < 2; ++bj) {
                    const f32x4 xa = *(const f32x4*)(out + off + bj * HALF), xb = *(const f32x4*)(out + off + bj * HALF + 4);
                    *(f32x4*)(out + off + bj * HALF) = xa + gv[bj][0] * acc[ai][bj][m][0]; *(f32x4*)(out + off + bj * HALF + 4) = xb + gv[bj][1] * acc[ai][bj][m][1];
                }
            }
    }
};

template <class Epi, class Sched, bool ALIGN_EPI = false, bool SP2 = false>
__device__ __forceinline__ void gemm_phase(PG8_LAS unsigned char* lds, const Gemm g, const Sched& S, const Epi& E) {
    const int tid = threadIdx.x, wid = __builtin_amdgcn_readfirstlane(tid >> 6), lane = tid & 63, wr = wid >> 2, wc = wid & 3, fr = lane & 15, fq = lane >> 4;
    const int K = g.K, nt = K / BK;
    unsigned voffA[2], voffB[2];
#pragma unroll
    for (int i = 0; i < 2; ++i) { int R, C; stage_rc(tid * 16 + i * 8192, R, C); const int Rb = Epi::PERM ? ((R & ~31) + perm32(R & 31)) : R;
        voffA[i] = (unsigned)(R * K + C) * 2u; voffB[i] = (unsigned)(Rb * K + C) * 2u; }
    const size_t kstep = (size_t)(BK * 2);
    const size_t hstep = (size_t)HALF * K * 2;
    const size_t tstep = 2 * hstep;
    const unsigned ldsw = (unsigned)wid * 1024u;
    const int aoff = lds_byte(wr * 64 + fr, fq * 8), boff = lds_byte(wc * 32 + fr, fq * 8);
#define PG8_SA(b, h) (((b) * 2 + (h)) * HTB)
#define PG8_SB(b, h) ((4 + (b) * 2 + (h)) * HTB)
#define PG8_STAGE(bufoff, gbase, voff) do { _Pragma("unroll") for (int _i = 0; _i < 2; ++_i) \
        __builtin_amdgcn_global_load_lds((const unsigned*)((const char*)(gbase) + (voff)[_i]), (PG8_LAS unsigned*)(lds + (bufoff) + ldsw + _i * 8192), 16, 0, 0); } while (0)
#define PG8_LDA(dst, b, h) do { _Pragma("unroll") for (int m = 0; m < 4; ++m) _Pragma("unroll") for (int k = 0; k < 2; ++k) dst[m][k] = *(const PG8_LAS bf16x8*)(lds + PG8_SA(b, h) + aoff + m * 2048 + k * 1024); } while (0)
#define PG8_LDB(dst, b, h) do { _Pragma("unroll") for (int n = 0; n < 2; ++n) _Pragma("unroll") for (int k = 0; k < 2; ++k) dst[n][k] = *(const PG8_LAS bf16x8*)(lds + PG8_SB(b, h) + boff + n * 2048 + k * 1024); } while (0)
#define PG8_MMA(ai, bj, At, Bt) do { __builtin_amdgcn_s_setprio(1); _Pragma("unroll") for (int m = 0; m < 4; ++m) _Pragma("unroll") for (int n = 0; n < 2; ++n) _Pragma("unroll") for (int k = 0; k < 2; ++k) \
        acc[ai][bj][m][n] = __builtin_amdgcn_mfma_f32_16x16x32_bf16(Bt[n][k], At[m][k], acc[ai][bj][m][n], 0, 0, 0); __builtin_amdgcn_s_setprio(0); } while (0)
#define PG8_WAIT_V(n) asm volatile("s_waitcnt vmcnt(" #n ")" ::: "memory")
#define PG8_WAIT_L(n) asm volatile("s_waitcnt lgkmcnt(" #n ")" ::: "memory")
#define PG8_BAR __builtin_amdgcn_s_barrier()
#define PG8_SCHED __builtin_amdgcn_sched_barrier(0)
    Unit cur, nxt; int ui = 0;
    if (!S.next(0, cur)) return;
    f32x4 acc[2][2][4][2];
#pragma unroll
    for (int a = 0; a < 2; ++a)
#pragma unroll
        for (int b = 0; b < 2; ++b)
#pragma unroll
            for (int m = 0; m < 4; ++m)
#pragma unroll
                for (int n = 0; n < 2; ++n) acc[a][b][m][n] = (f32x4){0.f, 0.f, 0.f, 0.f};
    bf16x8 At[4][2], B0[2][2], B1[2][2];
    const char* cA = (const char*)g.A + (size_t)cur.pm * tstep; const char* cB = (const char*)g.Bt + (size_t)cur.pn * tstep;
    S.a_ready(cur);
    if constexpr (SP2) {
        PG8_STAGE(PG8_SB(0, 0), cB, voffB); PG8_STAGE(PG8_SB(0, 1), cB + hstep, voffB); PG8_STAGE(PG8_SA(0, 0), cA, voffA); PG8_STAGE(PG8_SA(0, 1), cA + hstep, voffA);
        if (wr == 1) PG8_BAR;
        PG8_WAIT_V(2); PG8_BAR;
        PG8_STAGE(PG8_SB(1, 0), cB + kstep, voffB); PG8_STAGE(PG8_SA(1, 0), cA + kstep, voffA); PG8_STAGE(PG8_SB(1, 1), cB + hstep + kstep, voffB);
        PG8_WAIT_V(6); PG8_BAR;
    } else {
        PG8_STAGE(PG8_SB(0, 0), cB, voffB); PG8_STAGE(PG8_SA(0, 0), cA, voffA); PG8_STAGE(PG8_SB(0, 1), cB + hstep, voffB); PG8_STAGE(PG8_SA(0, 1), cA + hstep, voffA);
        if (wr == 1) PG8_BAR;
        PG8_WAIT_V(4); PG8_BAR;
        PG8_STAGE(PG8_SB(1, 0), cB + kstep, voffB); PG8_STAGE(PG8_SA(1, 0), cA + kstep, voffA); PG8_STAGE(PG8_SB(1, 1), cB + hstep + kstep, voffB);
        PG8_WAIT_V(6); PG8_BAR;
    }
    for (;;) {
        const bool has_next = S.next(ui + 1, nxt);
        const char* nA = has_next ? (const char*)g.A + (size_t)nxt.pm * tstep : cA; const char* nB = has_next ? (const char*)g.Bt + (size_t)nxt.pn * tstep : cB;
        for (int t = 0; t < nt; t += 2) {
            const bool last = (t == nt - 2);
            const char* a1 = cA + (size_t)(t + 1) * kstep;
            const char* a2 = last ? nA : cA + (size_t)(t + 2) * kstep; const char* b2 = last ? nB : cB + (size_t)(t + 2) * kstep;
            const char* a3 = a2 + kstep; const char* b3 = b2 + kstep;
            if (last && has_next) S.a_ready(nxt);
            if constexpr (SP2) {
            PG8_LDB(B0, 0, 0); PG8_LDB(B1, 0, 1); PG8_SCHED; PG8_LDA(At, 0, 0); PG8_STAGE(PG8_SA(1, 1), a1 + hstep, voffA);
            PG8_WAIT_V(8); PG8_WAIT_L(0); PG8_BAR; PG8_MMA(0, 0, At, B0); PG8_MMA(0, 1, At, B1); PG8_BAR; PG8_SCHED;
            PG8_LDA(At, 0, 1); PG8_STAGE(PG8_SB(0, 0), b2, voffB); PG8_STAGE(PG8_SB(0, 1), b2 + hstep, voffB); PG8_STAGE(PG8_SA(0, 0), a2, voffA);
            PG8_WAIT_V(8); PG8_WAIT_L(0); PG8_BAR; PG8_MMA(1, 0, At, B0); PG8_MMA(1, 1, At, B1); PG8_BAR; PG8_SCHED;
            PG8_LDB(B0, 1, 0); PG8_LDB(B1, 1, 1); PG8_SCHED; PG8_LDA(At, 1, 0); PG8_STAGE(PG8_SA(0, 1), a2 + hstep, voffA);
            PG8_WAIT_V(8); PG8_WAIT_L(0); PG8_BAR; PG8_MMA(0, 0, At, B0); PG8_MMA(0, 1, At, B1); PG8_BAR; PG8_SCHED;
            PG8_LDA(At, 1, 1); PG8_STAGE(PG8_SB(1, 0), b3, voffB); PG8_STAGE(PG8_SB(1, 1), b3 + hstep, voffB); PG8_STAGE(PG8_SA(1, 0), a3, voffA);
            PG8_WAIT_V(8); PG8_WAIT_L(0); PG8_BAR; PG8_MMA(1, 0, At, B0); PG8_MMA(1, 1, At, B1); PG8_BAR; PG8_SCHED;
            } else {
            PG8_LDB(B0, 0, 0); PG8_SCHED; PG8_LDA(At, 0, 0); PG8_STAGE(PG8_SA(1, 1), a1 + hstep, voffA);
            PG8_WAIT_L(8); PG8_BAR; PG8_WAIT_L(0); PG8_MMA(0, 0, At, B0); PG8_BAR; PG8_SCHED;
            PG8_LDB(B1, 0, 1); PG8_STAGE(PG8_SB(0, 0), b2, voffB);
            PG8_BAR; PG8_WAIT_L(0); PG8_MMA(0, 1, At, B1); PG8_BAR;
            PG8_LDA(At, 0, 1); PG8_STAGE(PG8_SA(0, 0), a2, voffA);
            PG8_BAR; PG8_WAIT_L(0); PG8_MMA(1, 0, At, B0); PG8_BAR; PG8_SCHED;
            PG8_STAGE(PG8_SB(0, 1), b2 + hstep, voffB);
            PG8_WAIT_V(6); PG8_BAR; PG8_MMA(1, 1, At, B1); PG8_BAR;
            PG8_LDB(B0, 1, 0); PG8_SCHED; PG8_LDA(At, 1, 0); PG8_STAGE(PG8_SA(0, 1), a2 + hstep, voffA);
            PG8_WAIT_L(8); PG8_BAR; PG8_WAIT_L(0); PG8_MMA(0, 0, At, B0); PG8_BAR; PG8_SCHED;
            PG8_LDB(B1, 1, 1); PG8_STAGE(PG8_SB(1, 0), b3, voffB);
            PG8_BAR; PG8_WAIT_L(0); PG8_MMA(0, 1, At, B1); PG8_BAR;
            PG8_LDA(At, 1, 1); PG8_STAGE(PG8_SA(1, 0), a3, voffA);
            PG8_BAR; PG8_WAIT_L(0); PG8_MMA(1, 0, At, B0); PG8_BAR; PG8_SCHED;
            PG8_STAGE(PG8_SB(1, 1), b3 + hstep, voffB);
            PG8_WAIT_V(6); PG8_BAR; PG8_MMA(1, 1, At, B1); PG8_BAR;
            }
        }
        if constexpr (ALIGN_EPI) { if (wr == 0) PG8_BAR; }
        if constexpr (!Epi::AFTER_DRAIN) { E(acc, cur, wr, wc, fr, fq); S.done(cur); }
        if (!has_next) break;
#pragma unroll
        for (int a = 0; a < 2; ++a)
#pragma unroll
            for (int b = 0; b < 2; ++b)
#pragma unroll
                for (int m = 0; m < 4; ++m)
#pragma unroll
                    for (int n = 0; n < 2; ++n) acc[a][b][m][n] = (f32x4){0.f, 0.f, 0.f, 0.f};
        cur = nxt; cA = nA; cB = nB; ++ui;
        if constexpr (ALIGN_EPI) { if (wr == 1) PG8_BAR; }
    }
    PG8_WAIT_V(0);
    if constexpr (!ALIGN_EPI) { if (wr == 0) PG8_BAR; }
    PG8_BAR;
    if constexpr (Epi::AFTER_DRAIN) { E.fused(acc, cur, wr, wc, fr, fq, lds, wid, lane); S.done(cur); }
#undef PG8_SA
#undef PG8_SB
#undef PG8_STAGE
#undef PG8_LDA
#undef PG8_LDB
#undef PG8_MMA
#undef PG8_WAIT_V
#undef PG8_WAIT_L
#undef PG8_BAR
#undef PG8_SCHED
}
}

constexpr int NWAVES = 8;
constexpr int BATCH = 8, SEQ = 4096, D = 1024, M = BATCH * SEQ;
constexpr int NH = 8, NKV = 2, HD = 64, AW = 512, KVW = 128, PW = 512, INW = 1280, FF = 4096, NMOD = 6;
constexpr float EPS = 1e-6f;
#ifndef MK_N_LAUNCHES
#define MK_N_LAUNCHES 1
#endif
#ifndef DUP_PHASE
#define DUP_PHASE -1
#endif
#ifndef EPI_PHASE
#define EPI_PHASE -1
#endif
constexpr int N_PHASES = 7;
constexpr int N_LAUNCHES = MK_N_LAUNCHES;

constexpr size_t MiB = 1u << 20;
constexpr size_t WS_CTL = 0, CTL_ZERO_BYTES = 64 * 1024;
constexpr size_t WS_MOD = 1 * MiB;
constexpr size_t WS_BIAS2 = 1 * MiB + 256 * 1024;
constexpr size_t WS_A2 = 1 * MiB + 512 * 1024;
constexpr size_t WS_ROPE = 2 * MiB;
constexpr size_t WS_STATS = 4 * MiB;
constexpr size_t WS_WIN = 6 * MiB, WS_WO = 9 * MiB, WS_W1 = 12 * MiB, WS_W2 = 20 * MiB;
constexpr size_t WS_Z2 = 32 * MiB;
constexpr size_t WS_H = 96 * MiB;
constexpr size_t WS_XN = 96 * MiB, WS_Q = 160 * MiB, WS_K = 192 * MiB, WS_V = 200 * MiB, WS_U = 208 * MiB, WS_MIX = 240 * MiB;
constexpr size_t WS_END = 352 * MiB;
constexpr int CW_BAR = 1024;

constexpr int LDS_BYTES = 160 * 1024;
constexpr int MISC_OFF = LDS_BYTES - 256;
constexpr int ATT_K = 0, ATT_V = 24576, ATT_WS = 49152, ATT_OST = ATT_WS + NWAVES * 256, ATT_END = ATT_OST + NWAVES * 4096;

#define GAS __attribute__((address_space(1)))
#define LAS __attribute__((address_space(3)))
typedef unsigned short bf16;
typedef unsigned v4u __attribute__((ext_vector_type(4)));
typedef float f32x4 __attribute__((ext_vector_type(4)));
typedef short bf16x8 __attribute__((ext_vector_type(8)));
typedef GAS unsigned gu32;
typedef GAS unsigned long long gu64;
#define RLX_AGENT __ATOMIC_RELAXED, __HIP_MEMORY_SCOPE_AGENT
#define LDS_WAIT() asm volatile("s_waitcnt lgkmcnt(0)" ::: "memory")
#define VM_WAIT() asm volatile("s_waitcnt vmcnt(0)" ::: "memory")
__device__ __forceinline__ unsigned long long rt() { return __builtin_amdgcn_s_memrealtime(); }
__device__ __forceinline__ unsigned f2bf(float f) { unsigned u = __builtin_bit_cast(unsigned, f); return (u + 0x7fffu + ((u >> 16) & 1u)) >> 16; }
__device__ __forceinline__ unsigned pk2(float lo, float hi) { return f2bf(lo) | (f2bf(hi) << 16); }

#define XB_TMO      128
#define XB_XCNT(j)  (256  + 64 * (j))
#define XB_XSUB(j)  (1280 + 64 * (j))
#define XB_XGEN(j)  (2304 + 64 * (j))
#define XB_TOP      3328
#define XB_TOPGEN   3392
#define XCD_BAR_WORDS 3456
#define XB_SPIN_CAP (1u << 18)

__device__ __forceinline__ unsigned xb_ld(unsigned* p)              { return __hip_atomic_load(p, __ATOMIC_RELAXED, __HIP_MEMORY_SCOPE_AGENT); }
__device__ __forceinline__ unsigned xb_add(unsigned* p, unsigned v) { return __hip_atomic_fetch_add(p, v, __ATOMIC_RELAXED, __HIP_MEMORY_SCOPE_AGENT); }
__device__ __forceinline__ unsigned xb_xcc_id() { return (unsigned)__builtin_amdgcn_s_getreg((3 << 11) | 20) & 0xFu; }
#define XB_SPIN(cond, bar) do { unsigned _sp = 0; while (cond) { __builtin_amdgcn_s_sleep(1); \
    if ((++_sp & 255u) == 0u) { if (xb_ld(&(bar)[XB_TMO])) break; if (_sp > XB_SPIN_CAP) { atomicAdd(&(bar)[XB_TMO], 1u); break; } } } } while (0)

struct XcdBarrier {
    unsigned* bar; unsigned x;
    volatile LAS unsigned* st;
};

__device__ __forceinline__ XcdBarrier xcd_barrier_post(unsigned* bar, volatile LAS unsigned* st) {
    XcdBarrier b; b.bar = bar; b.x = xb_xcc_id(); b.st = st;
    if (threadIdx.x == 0) (void)xb_add(&bar[XB_XCNT(b.x)], 1u);
    return b;
}
__device__ __forceinline__ void xcd_barrier_complete(unsigned* bar, unsigned x, unsigned& nloc, unsigned& nx) {
    const unsigned G = gridDim.x * gridDim.y * gridDim.z;
    unsigned sum, cnt, mine, sp = 0u;
    for (;;) {
        sum = 0u; cnt = 0u; mine = 0u;
#pragma unroll
        for (unsigned j = 0; j < 16; ++j) { const unsigned c = xb_ld(&bar[XB_XCNT(j)]); sum += c; cnt += (c > 0u) ? 1u : 0u; mine = (j == x) ? c : mine; }
        if (sum == G) break;
        __builtin_amdgcn_s_sleep(1);
        if ((++sp & 255u) == 0u) { if (xb_ld(&bar[XB_TMO])) break; if (sp > XB_SPIN_CAP) { atomicAdd(&bar[XB_TMO], 1u); break; } }
    }
    nloc = mine > 0u ? mine : 1u; nx = cnt > 0u ? cnt : 1u;
}

__device__ __forceinline__ void xcd_barrier(const XcdBarrier& b) {
    asm volatile("s_waitcnt vmcnt(0)" ::: "memory");
    __syncthreads();
    if (threadIdx.x == 0) {
        unsigned* bar = b.bar;
        __builtin_amdgcn_s_waitcnt(0);
        unsigned nloc = b.st[0], nx = b.st[1];
        if (nloc == 0u) { xcd_barrier_complete(bar, b.x, nloc, nx); b.st[0] = nloc; b.st[1] = nx; }
        const unsigned old = xb_add(&bar[XB_XSUB(b.x)], 1u);
        const unsigned gen = old / nloc;
        if (old + 1u == (gen + 1u) * nloc) {
            __builtin_amdgcn_fence(__ATOMIC_RELEASE, "agent");
            asm volatile("s_waitcnt vmcnt(0)" ::: "memory");
            const unsigned og = xb_add(&bar[XB_TOP], 1u);
            const unsigned tg = og / nx;
            if (og + 1u == (tg + 1u) * nx) xb_add(&bar[XB_TOPGEN], 1u);
            else XB_SPIN(xb_ld(&bar[XB_TOPGEN]) == tg, bar);
            __builtin_amdgcn_fence(__ATOMIC_ACQUIRE, "agent");
            xb_add(&bar[XB_XGEN(b.x)], 1u);
            asm volatile("s_waitcnt vmcnt(0)" ::: "memory");
        } else {
            XB_SPIN(xb_ld(&bar[XB_XGEN(b.x)]) == gen, bar);
            __builtin_amdgcn_fence(__ATOMIC_ACQUIRE, "agent");
            asm volatile("s_waitcnt vmcnt(0)" ::: "memory");
        }
    }
    __syncthreads();
}

typedef float f32x16 __attribute__((ext_vector_type(16)));
typedef short s16x4 __attribute__((ext_vector_type(4)));
struct Frame {
    LAS unsigned char* lds;
    int tid, lane, wave, vcu, G;
};
__device__ __forceinline__ float wave_sum(float v) {
#pragma unroll
    for (int o = 1; o < 64; o <<= 1) v += __shfl_xor(v, o);
    return v;
}
__device__ __forceinline__ float bf2f(unsigned short h) { return __builtin_bit_cast(float, (unsigned)h << 16); }
__device__ __forceinline__ float bflo(unsigned w) { return __builtin_bit_cast(float, w << 16); }
__device__ __forceinline__ float bfhi(unsigned w) { return __builtin_bit_cast(float, w & 0xffff0000u); }

__device__ __forceinline__ void p0_transpose_item(const float* W, int N, bf16* WT, int Kd, int k0, int n0, int dst_row0, LAS float* scr, int lane) {
    f32x4 v[8];
#pragma unroll
    for (int i = 0; i < 8; ++i) v[i] = *(const GAS f32x4*)(W + (size_t)(k0 + 8 * i + (lane >> 3)) * N + n0 + 4 * (lane & 7));
#pragma unroll
    for (int i = 0; i < 8; ++i) { LAS float* d = scr + (8 * i + (lane >> 3)) * 33 + 4 * (lane & 7); d[0] = v[i][0]; d[1] = v[i][1]; d[2] = v[i][2]; d[3] = v[i][3]; }
    LDS_WAIT(); asm volatile("" ::: "memory");
    const int c = lane & 7;
#pragma unroll
    for (int j = 0; j < 4; ++j) { const int n = (lane >> 3) + 8 * j; const LAS float* s = scr + (8 * c) * 33 + n;
        v4u o; o.x = pk2(s[0 * 33], s[1 * 33]); o.y = pk2(s[2 * 33], s[3 * 33]); o.z = pk2(s[4 * 33], s[5 * 33]); o.w = pk2(s[6 * 33], s[7 * 33]);
        *(GAS v4u*)(WT + (size_t)(dst_row0 + n) * Kd + k0 + 8 * c) = o; }
    LDS_WAIT(); asm volatile("" ::: "memory");
}
__device__ __forceinline__ int win_slot(int n) { const int pn = n >> 8, r = n & 255; return 256 * pn + 128 * ((r >> 5) & 1) + 32 * (r >> 6) + (r & 31); }

struct Ptrs {
    const float *x, *c, *w_ada, *b_ada, *norm1_g, *w_in, *q_norm_g, *k_norm_g, *sinks, *pool_w, *pool_scale, *w_o, *norm2_g, *w1, *w2; const int* positions;
    float *out, *mod, *bias2, *a2, *rope, *stats; bf16 *Win_t, *Wo_t, *W1_t, *W2_t, *XN, *Q, *K, *V, *U, *MIX, *Z2, *H;
};

__device__ __forceinline__ void p0_mod_task(Frame& F, const Ptrs& P, int t) {
    LAS float* cact = (LAS float*)F.lds;
    LAS float* red = (LAS float*)(F.lds + 32768);
    for (int i = F.tid; i < BATCH * D; i += NWAVES * 64) { const float cv = P.c[i]; cact[i] = cv / (1.f + __expf(-cv)); }
    __syncthreads();
    const int j0 = 64 * t, kb = 128 * F.wave;
    float acc[BATCH];
#pragma unroll
    for (int b = 0; b < BATCH; ++b) acc[b] = 0.f;
#pragma unroll 32
    for (int k = 0; k < 128; ++k) { const float wv = P.w_ada[(size_t)(kb + k) * (NMOD * D) + j0 + F.lane];
#pragma unroll
        for (int b = 0; b < BATCH; ++b) acc[b] += cact[b * D + kb + k] * wv; }
#pragma unroll
    for (int b = 0; b < BATCH; ++b) red[(F.wave * BATCH + b) * 64 + F.lane] = acc[b];
    __syncthreads();
    { const int b = F.wave; float s = 0.f;
#pragma unroll
      for (int w = 0; w < NWAVES; ++w) s += red[(w * BATCH + b) * 64 + F.lane];
      P.mod[(size_t)b * NMOD * D + j0 + F.lane] = s + P.b_ada[j0 + F.lane]; }
    __syncthreads();
}
__device__ __forceinline__ void p0_fold_task(Frame& F, const Ptrs& P, int t) {
    const int g = t >> 5, n0 = (t & 31) * 32;
    LAS float* Pm = (LAS float*)F.lds;
    LAS float* Wm = (LAS float*)(F.lds + 128 * 129 * 4);
    for (int i = F.tid; i < 128 * 128; i += NWAVES * 64) { const int c = i >> 7, d = i & 127; Pm[c * 129 + d] = P.pool_w[(size_t)g * 16384 + i] * P.pool_scale[128 * g + d]; }
    for (int i = F.tid; i < 128 * 32; i += NWAVES * 64) { const int d = i >> 5, nn = i & 31; Wm[d * 33 + nn] = P.w_o[(size_t)(512 + 128 * g + d) * D + n0 + nn]; }
    __syncthreads();
    const int c = F.tid & 127, q = F.tid >> 7;
    float acc[8];
#pragma unroll
    for (int i = 0; i < 8; ++i) acc[i] = 0.f;
    for (int d = 0; d < 128; ++d) { const float p = Pm[c * 129 + d];
#pragma unroll
        for (int i = 0; i < 8; ++i) acc[i] += p * Wm[d * 33 + q + 4 * i]; }
#pragma unroll
    for (int i = 0; i < 8; ++i) P.Wo_t[(size_t)(n0 + q + 4 * i) * D + 512 + 128 * g + c] = (bf16)f2bf(acc[i]);
    __syncthreads();
}
__device__ __forceinline__ void p0a_prologue(Frame& F, const Ptrs& P) {
    for (int t = F.vcu; t < 96 + 128; t += F.G) { if (t < 96) p0_mod_task(F, P, t); else p0_fold_task(F, P, t - 96); }
    LAS float* scr = (LAS float*)(F.lds + F.wave * 16384);
    const int gw = F.vcu * NWAVES + F.wave, NGW = F.G * NWAVES;
    constexpr int I_IN = (D / 64) * (INW / 32), I_O = (AW / 64) * (D / 32);
    for (int it = gw; it < I_IN + I_O; it += NGW) {
        int r = it;
        if (r < I_IN) { const int nblk = INW / 32, kb = r / nblk, nb = r % nblk; p0_transpose_item(P.w_in, INW, P.Win_t, D, 64 * kb, 32 * nb, win_slot(32 * nb), scr, F.lane); continue; } r -= I_IN;
        { const int nblk = D / 32, kb = r / nblk, nb = r % nblk; p0_transpose_item(P.w_o, D, P.Wo_t, D, 64 * kb, 32 * nb, 32 * nb, scr, F.lane); }
    }
    for (int idx = (F.vcu * NWAVES * 64 + F.tid); idx < M * 8; idx += F.G * NWAVES * 64) {
        const int m = idx >> 3, i = idx & 7;
        const float inv_freq = (float)pow(500000.0, -(double)i / 8.0);
        const float ang = (float)P.positions[m] * inv_freq;
        P.rope[(size_t)m * 16 + i] = (float)cos((double)ang); P.rope[(size_t)m * 16 + 8 + i] = (float)sin((double)ang);
    }
}

__device__ __forceinline__ void p1_tail_convert(Frame& F, const Ptrs& P, int ord, int cnt) {
    LAS float* scr = (LAS float*)(F.lds + F.wave * 16384);
    constexpr int I_1 = (D / 64) * (FF / 32), I_2 = (FF / 64) * (D / 32);
    for (int it = ord * NWAVES + F.wave; it < I_1 + I_2; it += cnt * NWAVES) {
        if (it < I_1) { const int nblk = FF / 32, kb = it / nblk, nb = it % nblk; p0_transpose_item(P.w1, FF, P.W1_t, D, 64 * kb, 32 * nb, 32 * nb, scr, F.lane); }
        else { const int r = it - I_1, nblk = D / 32, kb = r / nblk, nb = r % nblk; p0_transpose_item(P.w2, D, P.W2_t, FF, 64 * kb, 32 * nb, 32 * nb, scr, F.lane); }
    }
}

__device__ __forceinline__ void p0b_norm(Frame& F, const Ptrs& P) {
    const int gt = F.vcu * NWAVES * 64 + F.tid, NGT = F.G * NWAVES * 64;
    for (int i = gt; i < BATCH * D; i += NGT) { const int b = i >> 10, col = i & 1023; P.a2[i] = P.norm2_g[col] * (1.f + P.mod[(size_t)b * NMOD * D + 4 * D + col]); }
    const int gw = F.vcu * NWAVES + F.wave, NGW = F.G * NWAVES;
    for (int rb = gw; rb < M / 16; rb += NGW) {
        const int b = (rb * 16) / SEQ; const float* mb = P.mod + (size_t)b * NMOD * D;
        f32x4 av[4], sv[4];
#pragma unroll
        for (int j = 0; j < 4; ++j) { const int col = 256 * j + 4 * F.lane; const f32x4 g = *(const f32x4*)(P.norm1_g + col), sc = *(const f32x4*)(mb + D + col); av[j] = g * (sc + 1.0f); sv[j] = *(const f32x4*)(mb + col); }
        for (int rr = 0; rr < 16; rr += 4) {
            f32x4 v[4][4]; float s[4];
#pragma unroll
            for (int q = 0; q < 4; ++q) { const GAS f32x4* xr = (const GAS f32x4*)(P.x + (size_t)(rb * 16 + rr + q) * D) + F.lane;
#pragma unroll
                for (int j = 0; j < 4; ++j) v[q][j] = xr[64 * j]; }
#pragma unroll
            for (int q = 0; q < 4; ++q) { float t = 0.f;
#pragma unroll
                for (int j = 0; j < 4; ++j) t += (v[q][j][0] * v[q][j][0] + v[q][j][1] * v[q][j][1]) + (v[q][j][2] * v[q][j][2] + v[q][j][3] * v[q][j][3]);
                s[q] = t; }
#pragma unroll
            for (int o = 1; o < 64; o <<= 1) {
#pragma unroll
                for (int q = 0; q < 4; ++q) s[q] += __shfl_xor(s[q], o); }
#pragma unroll
            for (int q = 0; q < 4; ++q) { const float r = rsqrtf(s[q] * (1.f / D) + EPS);
                GAS unsigned long long* o8 = (GAS unsigned long long*)(P.XN + (size_t)(rb * 16 + rr + q) * D) + F.lane;
#pragma unroll
                for (int j = 0; j < 4; ++j) { const f32x4 y = v[q][j] * r * av[j] + sv[j]; o8[64 * j] = (unsigned long long)pk2(y[0], y[1]) | ((unsigned long long)pk2(y[2], y[3]) << 32); } }
        }
    }
}
__device__ __forceinline__ void bias2_tasks(Frame& F, const Ptrs& P) {
    const int gw = F.vcu * NWAVES + F.wave, NGW = F.G * NWAVES;
    for (int n = gw; n < FF; n += NGW) {
        const v4u w0 = *(const GAS v4u*)(P.W1_t + (size_t)n * D + F.lane * 16), w1v = *(const GAS v4u*)(P.W1_t + (size_t)n * D + F.lane * 16 + 8);
        float wf[16]; wf[0] = bflo(w0.x); wf[1] = bfhi(w0.x); wf[2] = bflo(w0.y); wf[3] = bfhi(w0.y); wf[4] = bflo(w0.z); wf[5] = bfhi(w0.z); wf[6] = bflo(w0.w); wf[7] = bfhi(w0.w);
        wf[8] = bflo(w1v.x); wf[9] = bfhi(w1v.x); wf[10] = bflo(w1v.y); wf[11] = bfhi(w1v.y); wf[12] = bflo(w1v.z); wf[13] = bfhi(w1v.z); wf[14] = bflo(w1v.w); wf[15] = bfhi(w1v.w);
        float sb[BATCH];
#pragma unroll
        for (int b = 0; b < BATCH; ++b) { const float* sh = P.mod + (size_t)b * NMOD * D + 3 * D + F.lane * 16; float t = 0.f;
#pragma unroll
            for (int j = 0; j < 4; ++j) { const f32x4 q = *(const f32x4*)(sh + 4 * j); t += (q[0] * wf[4 * j] + q[1] * wf[4 * j + 1]) + (q[2] * wf[4 * j + 2] + q[3] * wf[4 * j + 3]); }
            sb[b] = t; }
#pragma unroll
        for (int o = 1; o < 64; o <<= 1) {
#pragma unroll
            for (int b = 0; b < BATCH; ++b) sb[b] += __shfl_xor(sb[b], o); }
        if (F.lane < BATCH) { float r = sb[0];
#pragma unroll
            for (int b = 1; b < BATCH; ++b) r = (F.lane == b) ? sb[b] : r;
            P.bias2[(size_t)F.lane * FF + n] = r; }
    }
}

__device__ __forceinline__ int crow(int r, int hi) { return (r & 3) + 8 * (r >> 2) + 4 * hi; }
__device__ __forceinline__ unsigned cvtpk(float lo, float hi) { unsigned r; asm volatile("v_cvt_pk_bf16_f32 %0, %1, %2" : "=v"(r) : "v"(lo), "v"(hi)); return r; }
typedef short v4i16_t __attribute__((ext_vector_type(4)));
__device__ __forceinline__ s16x4 vtr(LAS const unsigned char* p) { return __builtin_bit_cast(s16x4, __builtin_amdgcn_ds_read_tr16_b64_v4i16((LAS v4i16_t*)p)); }

struct AttnRegs { v4u k[3], v[3]; bf16x8 q[4]; };
__device__ __forceinline__ void attn_load(Frame& F, const Ptrs& P, int unit, AttnRegs& R) {
    const int lane = F.lane, wid = F.wave, r32 = lane & 31, hi = lane >> 5;
    const int bk = unit >> 6, qb = unit & 63, b = bk >> 1, kvh = bk & 1, wh = wid & 1, hq = kvh * 4 + (wid >> 1);
    const long rowbase = (long)b * SEQ; const int q0 = qb * 64, kv0 = q0 - 128, qw0 = q0 + 32 * wh;
#pragma unroll
    for (int i = 0; i < 3; ++i) { const int kvr = kv0 + 64 * i + lane; R.k[i] = (v4u){0u, 0u, 0u, 0u}; if (kvr >= 0) R.k[i] = *(const GAS v4u*)(P.K + (rowbase + kvr) * KVW + kvh * 64 + wid * 8); }
#pragma unroll
    for (int i = 0; i < 3; ++i) { const int kvr = kv0 + 64 * i + 16 * (wid & 3) + (lane >> 2); R.v[i] = (v4u){0u, 0u, 0u, 0u}; if (kvr >= 0) R.v[i] = *(const GAS v4u*)(P.V + (rowbase + kvr) * KVW + kvh * 64 + (wid >> 2) * 32 + (lane & 3) * 8); }
    const bf16* Qw = P.Q + (rowbase + qw0 + r32) * AW + hq * 64 + hi * 8;
#pragma unroll
    for (int d0 = 0; d0 < 4; ++d0) R.q[d0] = *(const GAS bf16x8*)(Qw + d0 * 16);
}
__device__ __forceinline__ void attn_compute(Frame& F, const Ptrs& P, int unit, const bf16x8 (&qr)[4]) {
    const int lane = F.lane, wid = F.wave, r32 = lane & 31, hi = lane >> 5;
    const int bk = unit >> 6, qb = unit & 63, b = bk >> 1, kvh = bk & 1, wh = wid & 1, hq = kvh * 4 + (wid >> 1);
    const long rowbase = (long)b * SEQ; const int q0 = qb * 64, qw0 = q0 + 32 * wh;
    LAS unsigned char* lds = F.lds;
    f32x16 p[5];
#pragma unroll
    for (int j = 0; j < 5; ++j) {
        const int hb = wh + j; const LAS unsigned char* kp = lds + ATT_K + (hb >> 1) * 8192 + hi * 1024 + ((hb & 1) * 32 + r32) * 16;
        f32x16 a = {0.f, 0.f, 0.f, 0.f, 0.f, 0.f, 0.f, 0.f, 0.f, 0.f, 0.f, 0.f, 0.f, 0.f, 0.f, 0.f};
#pragma unroll
        for (int d0 = 0; d0 < 4; ++d0) { const bf16x8 kf = *(const LAS bf16x8*)(kp + d0 * 2048); a = __builtin_amdgcn_mfma_f32_32x32x16_bf16(kf, qr[d0], a, 0, 0, 0); }
        p[j] = a;
    }
    const float NEG = -INFINITY;
#pragma unroll
    for (int j = 0; j < 5; ++j) {
        const bool valid = (qw0 - 128 + 32 * j) >= 0;
#pragma unroll
        for (int r = 0; r < 16; ++r) { bool keep = valid; if (j == 0) keep = keep && (crow(r, hi) > r32); if (j == 4) keep = keep && (crow(r, hi) <= r32); if (!keep) p[j][r] = NEG; }
    }
    const float sinkl2 = P.sinks[hq] * 1.4426950408889634f;
    float mx = sinkl2;
#pragma unroll
    for (int j = 0; j < 5; ++j)
#pragma unroll
        for (int r = 0; r < 16; ++r) mx = fmaxf(mx, p[j][r]);
    { auto rr = __builtin_amdgcn_permlane32_swap(__float_as_uint(mx), __float_as_uint(mx), false, false); mx = fmaxf(__uint_as_float(rr[0]), __uint_as_float(rr[1])); }
    float l = 0.f;
#pragma unroll
    for (int j = 0; j < 5; ++j)
#pragma unroll
        for (int r = 0; r < 16; ++r) { const float e = __builtin_amdgcn_exp2f(p[j][r] - mx); p[j][r] = e; l += e; }
    { auto rr = __builtin_amdgcn_permlane32_swap(__float_as_uint(l), __float_as_uint(l), false, false); l = __uint_as_float(rr[0]) + __uint_as_float(rr[1]); }
    l += __builtin_amdgcn_exp2f(sinkl2 - mx);
    f32x16 o[2];
    o[0] = (f32x16){0.f, 0.f, 0.f, 0.f, 0.f, 0.f, 0.f, 0.f, 0.f, 0.f, 0.f, 0.f, 0.f, 0.f, 0.f, 0.f}; o[1] = o[0];
    const LAS unsigned char* vb = lds + ATT_V + ((lane >> 4) & 1) * 32 + (lane & 3) * 8 + (4 * hi + ((lane & 15) >> 2)) * 64;
#pragma unroll
    for (int j = 0; j < 5; ++j) {
        const int hb = wh + j; const LAS unsigned char* vt = vb + (hb >> 1) * 8192 + (hb & 1) * 2048;
#pragma unroll
        for (int s = 0; s < 2; ++s) {
            v4u pw; pw.x = cvtpk(p[j][8 * s + 0], p[j][8 * s + 1]); pw.y = cvtpk(p[j][8 * s + 2], p[j][8 * s + 3]); pw.z = cvtpk(p[j][8 * s + 4], p[j][8 * s + 5]); pw.w = cvtpk(p[j][8 * s + 6], p[j][8 * s + 7]);
            const bf16x8 pf = __builtin_bit_cast(bf16x8, pw);
#pragma unroll
            for (int d0 = 0; d0 < 2; ++d0) {
                const s16x4 lo = vtr(vt + d0 * 4096 + s * 1024), hh = vtr(vt + d0 * 4096 + s * 1024 + 512);
                const bf16x8 vf = (bf16x8){lo[0], lo[1], lo[2], lo[3], hh[0], hh[1], hh[2], hh[3]};
                o[d0] = __builtin_amdgcn_mfma_f32_32x32x16_bf16(pf, vf, o[d0], 0, 0, 0);
            }
        }
    }
    LAS float* wsf = (LAS float*)(lds + ATT_WS) + wid * 64;
    if (hi == 0) wsf[r32] = l;
    LDS_WAIT(); asm volatile("" ::: "memory");
    float rli[16];
#pragma unroll
    for (int r = 0; r < 16; ++r) rli[r] = __builtin_amdgcn_rcpf(wsf[crow(r, hi)]);
    LAS bf16* stg = (LAS bf16*)(lds + ATT_OST) + wid * 2048;
#pragma unroll
    for (int r = 0; r < 16; ++r) { const int orow = crow(r, hi);
#pragma unroll
        for (int d0 = 0; d0 < 2; ++d0) stg[orow * 64 + d0 * 32 + r32] = (bf16)f2bf(o[d0][r] * rli[r]); }
    LDS_WAIT(); asm volatile("" ::: "memory");
    bf16* Ow = P.MIX + (rowbase + qw0) * D + hq * 64;
#pragma unroll
    for (int i = 0; i < 4; ++i) { const int row = i * 8 + (lane >> 3), ch = lane & 7; const v4u v = *(const LAS v4u*)(stg + row * 64 + ch * 8); *(GAS v4u*)(Ow + (size_t)row * D + ch * 8) = v; }
}
__device__ __forceinline__ void unpack8(const v4u w, float (&f)[8]) { f[0] = bflo(w.x); f[1] = bfhi(w.x); f[2] = bflo(w.y); f[3] = bfhi(w.y); f[4] = bflo(w.z); f[5] = bfhi(w.z); f[6] = bflo(w.w); f[7] = bfhi(w.w); }
__device__ __forceinline__ void pool_task(Frame& F, const Ptrs& P, int task) {
    const int g = task & 3, rb = task >> 2, w = 2 << g;
    const int ch = F.lane & 15, run = F.lane >> 4;
    const int t0 = (rb * 64 + run * 16) & (SEQ - 1);
    const GAS char* ub = (const GAS char*)(P.U + (size_t)(rb * 64) * PW + g * 128);
    GAS char* ob = (GAS char*)(P.MIX + (size_t)(rb * 64) * D + AW + g * 128);
    const unsigned loff = (unsigned)((run * 16 * PW + ch * 8) * 2), ooff = (unsigned)((run * 16 * D + ch * 8) * 2);
    const v4u zero = (v4u){0u, 0u, 0u, 0u};
    v4u cur[16], prev[16];
#pragma unroll
    for (int i = 0; i < 16; ++i) cur[i] = *(const GAS v4u*)(ub + (size_t)i * (PW * 2) + loff);
#pragma unroll
    for (int j = 1; j <= 16; ++j) { prev[j - 1] = zero; if (j <= w && t0 - j >= 0) prev[j - 1] = *(const GAS v4u*)(ub - (size_t)j * (PW * 2) + loff); }
    float S[8];
#pragma unroll
    for (int e = 0; e < 8; ++e) S[e] = 0.f;
#pragma unroll
    for (int j = 1; j <= 16; ++j) { float f[8]; unpack8(prev[j - 1], f);
#pragma unroll
        for (int e = 0; e < 8; ++e) S[e] += f[e]; }
#pragma unroll
    for (int i = 0; i < 16; ++i) {
        const int t = t0 + i; float u[8]; unpack8(cur[i], u);
#pragma unroll
        for (int e = 0; e < 8; ++e) S[e] += u[e];
        { float f[8];
          if (w == 2) { unpack8(i < 2 ? prev[1 - i >= 0 ? 1 - i : 0] : cur[i >= 2 ? i - 2 : 0], f); }
          else if (w == 4) { unpack8(i < 4 ? prev[3 - i >= 0 ? 3 - i : 0] : cur[i >= 4 ? i - 4 : 0], f); }
          else if (w == 8) { unpack8(i < 8 ? prev[7 - i >= 0 ? 7 - i : 0] : cur[i >= 8 ? i - 8 : 0], f); }
          else { unpack8(prev[15 - i], f); }
#pragma unroll
          for (int e = 0; e < 8; ++e) S[e] -= f[e]; }
        const float inv = 1.0f / (float)((t + 1) < w ? (t + 1) : w);
        v4u o; o.x = pk2(S[0] * inv - u[0], S[1] * inv - u[1]); o.y = pk2(S[2] * inv - u[2], S[3] * inv - u[3]); o.z = pk2(S[4] * inv - u[4], S[5] * inv - u[5]); o.w = pk2(S[6] * inv - u[6], S[7] * inv - u[7]);
        *(GAS v4u*)(ob + (size_t)i * (D * 2) + ooff) = o;
    }
}
__device__ __forceinline__ void p2_attn_pool(Frame& F, const Ptrs& P) {
    constexpr int NUNITS = BATCH * NKV * (SEQ / 64);
    const int upw = (NUNITS + F.G - 1) / F.G, first = F.vcu * upw;
    int n = NUNITS - first; n = n < 0 ? 0 : (n > upw ? upw : n);
    AttnRegs R;
    if (n > 0) attn_load(F, P, first, R);
    for (int i = 0; i < n; ++i) {
        bf16x8 qr[4];
#pragma unroll
        for (int d0 = 0; d0 < 4; ++d0) qr[d0] = R.q[d0];
#pragma unroll
        for (int t = 0; t < 3; ++t) { *(LAS v4u*)(F.lds + ATT_K + t * 8192 + F.wave * 1024 + F.lane * 16) = R.k[t]; *(LAS v4u*)(F.lds + ATT_V + t * 8192 + F.wave * 1024 + F.lane * 16) = R.v[t]; }
        __syncthreads();
        if (i + 1 < n) attn_load(F, P, first + i + 1, R);
        attn_compute(F, P, first + i, qr);
        __syncthreads();
    }
    const int gw = F.vcu * NWAVES + F.wave, NGW = F.G * NWAVES;
    for (int t = gw; t < 4 * (M / 64); t += NGW) pool_task(F, P, t);
    bias2_tasks(F, P);
}

struct Args { const void* in[16]; float* out; unsigned char* ws; int ph_lo, ph_hi; };
__global__ void __launch_bounds__(NWAVES * 64, 2) fwd_megakernel(Args args) {
    extern __shared__ __attribute__((aligned(16))) unsigned char lds[];
    Frame F;
    F.lds = (LAS unsigned char*)lds;
    F.tid = threadIdx.x; F.lane = F.tid & 63; F.wave = __builtin_amdgcn_readfirstlane(F.tid >> 6);
    F.G = gridDim.x; { const int bx = blockIdx.x; F.vcu = (F.G % 8 == 0) ? (bx % 8) * (F.G / 8) + bx / 8 : bx; }
    unsigned char* ws = args.ws;
    Ptrs P;
    P.x = (const float*)args.in[0]; P.c = (const float*)args.in[1]; P.positions = (const int*)args.in[2]; P.w_ada = (const float*)args.in[3]; P.b_ada = (const float*)args.in[4];
    P.norm1_g = (const float*)args.in[5]; P.w_in = (const float*)args.in[6]; P.q_norm_g = (const float*)args.in[7]; P.k_norm_g = (const float*)args.in[8]; P.sinks = (const float*)args.in[9];
    P.pool_w = (const float*)args.in[10]; P.pool_scale = (const float*)args.in[11]; P.w_o = (const float*)args.in[12]; P.norm2_g = (const float*)args.in[13]; P.w1 = (const float*)args.in[14]; P.w2 = (const float*)args.in[15];
    P.out = args.out; P.mod = (float*)(ws + WS_MOD); P.bias2 = (float*)(ws + WS_BIAS2); P.a2 = (float*)(ws + WS_A2); P.rope = (float*)(ws + WS_ROPE); P.stats = (float*)(ws + WS_STATS);
    P.Win_t = (bf16*)(ws + WS_WIN); P.Wo_t = (bf16*)(ws + WS_WO); P.W1_t = (bf16*)(ws + WS_W1); P.W2_t = (bf16*)(ws + WS_W2);
    P.XN = (bf16*)(ws + WS_XN); P.Q = (bf16*)(ws + WS_Q); P.K = (bf16*)(ws + WS_K); P.V = (bf16*)(ws + WS_V); P.U = (bf16*)(ws + WS_U); P.MIX = (bf16*)(ws + WS_MIX); P.Z2 = (bf16*)(ws + WS_Z2); P.H = (bf16*)(ws + WS_H);
    volatile LAS unsigned* MISC = (volatile LAS unsigned*)(F.lds + MISC_OFF);
    if (F.tid < 64) MISC[F.tid] = 0u;
    __syncthreads();
    XcdBarrier bar; bar.bar = (unsigned*)(ws + WS_CTL) + CW_BAR; bar.x = 0; bar.st = nullptr;
    if (N_LAUNCHES == 1) bar = xcd_barrier_post((unsigned*)(ws + WS_CTL) + CW_BAR, MISC + 8);
    const int lo = args.ph_lo, hi = args.ph_hi;
#define IN(k) (lo <= (k) && (k) < hi)
#define SEAM(k) do { if (IN(k) && IN((k) + 1)) xcd_barrier(bar); } while (0)

    if (IN(0)) { p0a_prologue(F, P); SEAM(0); }
    if (IN(1)) { p0b_norm(F, P); SEAM(1); }
    if (IN(2)) {
        pg8::Gemm g{P.XN, P.Win_t, M, INW, D}; pg8::StaticOrder S; S.init(M, INW, F.G, (int)blockIdx.x);
        pg8::EpiProj E{P.Q, P.K, P.V, P.U, P.rope, P.q_norm_g, P.k_norm_g};
        pg8::gemm_phase<pg8::EpiProj, pg8::StaticOrder, true, true>(F.lds, g, S, E);
        { const int nwg = (M / 256) * (INW / 256), rem = nwg % F.G;
          if (rem == 0) p1_tail_convert(F, P, (int)blockIdx.x, F.G); else if ((int)blockIdx.x >= rem) p1_tail_convert(F, P, (int)blockIdx.x - rem, F.G - rem); }
        SEAM(2);
    }
    if (IN(3)) { p2_attn_pool(F, P); SEAM(3); }
    if (IN(4)) {
        pg8::Gemm g{P.MIX, P.Wo_t, M, D, D}; pg8::StaticOrder S; S.init(M, D, F.G, (int)blockIdx.x);
        pg8::EpiWo E{P.x, P.out, P.Z2, P.mod, P.a2, P.stats};
        pg8::gemm_phase<pg8::EpiWo, pg8::StaticOrder, true, true>(F.lds, g, S, E);
        SEAM(4);
    }
    if (IN(5)) {
        pg8::Gemm g{P.Z2, P.W1_t, M, FF, D}; pg8::StaticOrder S; S.init(M, FF, F.G, (int)blockIdx.x);
        pg8::EpiUp E{P.H, P.stats, P.bias2, FF};
        pg8::gemm_phase<pg8::EpiUp, pg8::StaticOrder, true, true>(F.lds, g, S, E);
        SEAM(5);
    }
    if (IN(6)) {
        pg8::Gemm g{P.H, P.W2_t, M, D, FF}; pg8::StaticOrder S; S.init(M, D, F.G, (int)blockIdx.x);
        pg8::EpiDown E{P.out, P.mod};
        pg8::gemm_phase<pg8::EpiDown, pg8::StaticOrder, true, true>(F.lds, g, S, E);
    }
#undef IN
#undef SEAM
}

#ifndef HYB
extern "C" void kernel_launch(void* const* d_in, const int* in_sizes, int n_in, void* d_out, int out_size, void* d_ws, size_t ws_size, hipStream_t stream) {
    static int grid = 0;
    if (grid == 0) {
        if (n_in != 16 || out_size != M * D || ws_size < WS_END) { fprintf(stderr, "kernel_launch: unexpected shapes (n_in %d out %d ws %zu)\n", n_in, out_size, ws_size); grid = -1; return; }
        int dev = 0, cus = 0, per_cu = 0;
        if (hipGetDevice(&dev) != hipSuccess || hipDeviceGetAttribute(&cus, hipDeviceAttributeMultiprocessorCount, dev) != hipSuccess) { grid = -1; return; }
        if (hipFuncSetAttribute((const void*)fwd_megakernel, hipFuncAttributeMaxDynamicSharedMemorySize, LDS_BYTES) != hipSuccess) { fprintf(stderr, "kernel_launch: hipFuncSetAttribute failed\n"); grid = -1; return; }
        if (hipOccupancyMaxActiveBlocksPerMultiprocessor(&per_cu, (const void*)fwd_megakernel, NWAVES * 64, LDS_BYTES) != hipSuccess || per_cu < 1) { fprintf(stderr, "kernel_launch: occupancy query says %d\n", per_cu); per_cu = 1; }
        (void)hipGetLastError();
        if (per_cu > 1) per_cu = 1;
        grid = cus * per_cu;
    }
    if (grid < 0) return;
    (void)hipMemsetAsync((char*)d_ws + WS_CTL, 0, CTL_ZERO_BYTES, stream);
    Args a{};
    for (int i = 0; i < 16; ++i) a.in[i] = d_in[i];
    a.out = (float*)d_out; a.ws = (unsigned char*)d_ws;
    if (N_LAUNCHES == 1 && DUP_PHASE >= 0) {
        a.ph_lo = 0; a.ph_hi = DUP_PHASE + 1; hipLaunchKernelGGL(fwd_megakernel, dim3(grid), dim3(NWAVES * 64), LDS_BYTES, stream, a);
        (void)hipMemsetAsync((char*)d_ws + WS_CTL, 0, CTL_ZERO_BYTES, stream);
        a.ph_lo = DUP_PHASE; a.ph_hi = DUP_PHASE + 1; hipLaunchKernelGGL(fwd_megakernel, dim3(grid), dim3(NWAVES * 64), LDS_BYTES, stream, a);
        (void)hipMemsetAsync((char*)d_ws + WS_CTL, 0, CTL_ZERO_BYTES, stream);
        a.ph_lo = DUP_PHASE + 1; a.ph_hi = N_PHASES; hipLaunchKernelGGL(fwd_megakernel, dim3(grid), dim3(NWAVES * 64), LDS_BYTES, stream, a);
    } else if (N_LAUNCHES == 1) { a.ph_lo = 0; a.ph_hi = N_PHASES; hipLaunchKernelGGL(fwd_megakernel, dim3(grid), dim3(NWAVES * 64), LDS_BYTES, stream, a); }
    else for (int li = 0; li < N_PHASES; ++li) { a.ph_lo = li; a.ph_hi = li + 1; hipLaunchKernelGGL(fwd_megakernel, dim3(grid), dim3(NWAVES * 64), LDS_BYTES, stream, a); }
}
#endif

#ifdef HYB
__global__ void dbg_norm(const float* __restrict__ x, const float* __restrict__ g, const float* __restrict__ mod, int sh_off, int sc_off, bf16* __restrict__ out) {
    const int wave = (blockIdx.x * blockDim.x + threadIdx.x) >> 6, lane = threadIdx.x & 63;
    if (wave >= M) return;
    const int b = wave / SEQ; const float* xr = x + (size_t)wave * D;
    float v[16]; float s = 0.f;
#pragma unroll
    for (int j = 0; j < 4; ++j) { const f32x4 t = *(const f32x4*)(xr + j * 256 + lane * 4); v[4 * j] = t[0]; v[4 * j + 1] = t[1]; v[4 * j + 2] = t[2]; v[4 * j + 3] = t[3]; s += t[0] * t[0] + t[1] * t[1] + t[2] * t[2] + t[3] * t[3]; }
    s = wave_sum(s);
    const float r = rsqrtf(s * (1.f / D) + EPS); const float* mb = mod + (size_t)b * NMOD * D;
#pragma unroll
    for (int j = 0; j < 4; ++j)
#pragma unroll
        for (int i = 0; i < 4; ++i) { const int col = j * 256 + lane * 4 + i; const float y = v[4 * j + i] * r * g[col] * (1.f + mb[sc_off + col]) + mb[sh_off + col]; out[(size_t)wave * D + col] = (bf16)f2bf(y); }
}
template <int MODE>
__global__ __launch_bounds__(256) void dbg_gemm(const bf16* __restrict__ A, const float* __restrict__ B, int N, int K, void* Cout, const float* X, const float* __restrict__ mod, int gate_off) {
    __shared__ __attribute__((aligned(16))) bf16 sA[128][40];
    __shared__ __attribute__((aligned(16))) bf16 sB[128][40];
    const int tid = threadIdx.x, lane = tid & 63, w = tid >> 6, wr = w >> 1, wc = w & 1;
    const int m0 = blockIdx.y * 128, n0 = blockIdx.x * 128;
    f32x4 acc[4][4];
#pragma unroll
    for (int i = 0; i < 4; ++i)
#pragma unroll
        for (int j = 0; j < 4; ++j) acc[i][j] = (f32x4){0.f, 0.f, 0.f, 0.f};
    for (int k0 = 0; k0 < K; k0 += 32) {
        { const int r = tid >> 1, cc = (tid & 1) * 16; const bf16x8* src = (const bf16x8*)(A + (size_t)(m0 + r) * K + k0 + cc); *(bf16x8*)&sA[r][cc] = src[0]; *(bf16x8*)&sA[r][cc + 8] = src[1]; }
        { const int kk = tid >> 3, nn = (tid & 7) * 16; const float* src = B + (size_t)(k0 + kk) * N + n0 + nn;
#pragma unroll
          for (int i = 0; i < 16; ++i) sB[nn + i][kk] = (bf16)f2bf(src[i]); }
        __syncthreads();
        bf16x8 a[4], b[4];
#pragma unroll
        for (int i = 0; i < 4; ++i) a[i] = *(const bf16x8*)&sA[wr * 64 + i * 16 + (lane & 15)][8 * (lane >> 4)];
#pragma unroll
        for (int j = 0; j < 4; ++j) b[j] = *(const bf16x8*)&sB[wc * 64 + j * 16 + (lane & 15)][8 * (lane >> 4)];
#pragma unroll
        for (int i = 0; i < 4; ++i)
#pragma unroll
            for (int j = 0; j < 4; ++j) acc[i][j] = __builtin_amdgcn_mfma_f32_16x16x32_bf16(a[i], b[j], acc[i][j], 0, 0, 0);
        __syncthreads();
    }
#pragma unroll
    for (int i = 0; i < 4; ++i)
#pragma unroll
        for (int j = 0; j < 4; ++j)
#pragma unroll
            for (int r = 0; r < 4; ++r) {
                const int row = m0 + wr * 64 + i * 16 + (lane >> 4) * 4 + r, col = n0 + wc * 64 + j * 16 + (lane & 15);
                const float v = acc[i][j][r]; const size_t o = (size_t)row * N + col;
                if (MODE == 0) ((bf16*)Cout)[o] = (bf16)f2bf(v);
                else if (MODE == 2) { const float t = v > 0.f ? v : 0.f; ((bf16*)Cout)[o] = (bf16)f2bf(t * t); }
                else { const int b_ = row / SEQ; const float gt = mod[(size_t)b_ * NMOD * D + gate_off + col]; const float base = (MODE == 1) ? X[o] : ((float*)Cout)[o]; ((float*)Cout)[o] = base + gt * v; }
            }
}
__global__ __launch_bounds__(64) void dbg_attn(const bf16* __restrict__ Q, const bf16* __restrict__ Kb, const bf16* __restrict__ Vb, const float* __restrict__ sinks, bf16* __restrict__ MIX) {
    const int id = blockIdx.x * blockDim.x + threadIdx.x;
    if (id >= M * NH) return;
    const int m = id / NH, hq = id % NH, kvh = hq / 4, b = m / SEQ, t = m % SEQ;
    float q[64], acc[64];
#pragma unroll
    for (int d = 0; d < 64; ++d) { q[d] = bf2f(Q[(size_t)m * AW + hq * 64 + d]); acc[d] = 0.f; }
    float mx = -1e30f, l = 0.f;
    const int j0 = t - 127 < 0 ? 0 : t - 127;
    for (int j = j0; j <= t; ++j) {
        const size_t kr = (size_t)(b * SEQ + j); float s = 0.f;
#pragma unroll
        for (int d = 0; d < 64; ++d) s += q[d] * bf2f(Kb[kr * KVW + kvh * 64 + d]);
        s *= 0.6931471805599453f;
        const float mn = fmaxf(mx, s); const float f = __expf(mx - mn), p = __expf(s - mn);
        l = l * f + p;
#pragma unroll
        for (int d = 0; d < 64; ++d) acc[d] = acc[d] * f + p * bf2f(Vb[kr * KVW + kvh * 64 + d]);
        mx = mn;
    }
    const float sk = sinks[hq]; const float mn = fmaxf(mx, sk); const float f = __expf(mx - mn);
    l = l * f + __expf(sk - mn);
    const float inv = f / l;
#pragma unroll
    for (int d = 0; d < 64; ++d) MIX[(size_t)m * D + hq * 64 + d] = (bf16)f2bf(acc[d] * inv);
}
__global__ void dbg_pool(const bf16* __restrict__ U, bf16* __restrict__ POOLED) {
    const int id = blockIdx.x * blockDim.x + threadIdx.x;
    if (id >= M * PW) return;
    const int m = id / PW, c = id % PW, g = c / 128, w = 2 << g, t = m % SEQ;
    const int cnt = (t + 1) < w ? (t + 1) : w; float s = 0.f;
    for (int j = 0; j < cnt; ++j) s += bf2f(U[(size_t)(m - j) * PW + c]);
    POOLED[(size_t)m * PW + c] = (bf16)f2bf(s / (float)cnt - bf2f(U[(size_t)m * PW + c]));
}
__global__ void dbg_copy_pooled(const bf16* __restrict__ MIX, bf16* __restrict__ POOLED) {
    const int id = blockIdx.x * blockDim.x + threadIdx.x;
    if (id >= M * PW) return;
    POOLED[id] = MIX[(size_t)(id / PW) * D + AW + (id % PW)];
}
__global__ void dbg_poolmm(const bf16* __restrict__ POOLED, const float* __restrict__ pool_w, const float* __restrict__ pool_scale, bf16* __restrict__ MIX) {
    const int id = blockIdx.x * blockDim.x + threadIdx.x;
    if (id >= M * PW) return;
    const int m = id / PW, c = id % PW, g = c / 128, d = c % 128; float s = 0.f;
    for (int k = 0; k < 128; ++k) s += bf2f(POOLED[(size_t)m * PW + g * 128 + k]) * pool_w[(size_t)(g * 128 + k) * 128 + d];
    MIX[(size_t)m * D + AW + c] = (bf16)f2bf(s * pool_scale[c]);
}
extern "C" void kernel_launch(void* const* d_in, const int* in_sizes, int n_in, void* d_out, int out_size, void* d_ws, size_t ws_size, hipStream_t stream) {
    static int grid = 0;
    if (grid == 0) {
        hipFuncSetAttribute((const void*)fwd_megakernel, hipFuncAttributeMaxDynamicSharedMemorySize, LDS_BYTES);
        grid = 256;
    }
    (void)hipMemsetAsync((char*)d_ws + WS_CTL, 0, CTL_ZERO_BYTES, stream);
    Args a{};
    for (int i = 0; i < 16; ++i) a.in[i] = d_in[i];
    a.out = (float*)d_out; a.ws = (unsigned char*)d_ws;
    unsigned char* ws = (unsigned char*)d_ws;
    const float* x = (const float*)d_in[0]; const float* sinks = (const float*)d_in[9]; const float* pool_w = (const float*)d_in[10]; const float* pool_scale = (const float*)d_in[11];
    const float* w_o = (const float*)d_in[12]; const float* norm2_g = (const float*)d_in[13]; const float* w1 = (const float*)d_in[14]; const float* w2 = (const float*)d_in[15];
    float* out = (float*)d_out; float* mod = (float*)(ws + WS_MOD);
    bf16 *Q = (bf16*)(ws + WS_Q), *Kb = (bf16*)(ws + WS_K), *Vb = (bf16*)(ws + WS_V), *U = (bf16*)(ws + WS_U), *MIX = (bf16*)(ws + WS_MIX), *Z2 = (bf16*)(ws + WS_Z2), *H = (bf16*)(ws + WS_H);
#define PH(lo_, hi_) do { a.ph_lo = lo_; a.ph_hi = hi_; for (int li = lo_; li < hi_; ++li) { a.ph_lo = li; a.ph_hi = li + 1; hipLaunchKernelGGL(fwd_megakernel, dim3(grid), dim3(NWAVES * 64), LDS_BYTES, stream, a); } } while (0)
    PH(0, 3);
#if HYB == 1
    dbg_attn<<<M * NH / 64, 64, 0, stream>>>(Q, Kb, Vb, sinks, MIX);
    dbg_pool<<<M * PW / 256, 256, 0, stream>>>(U, Z2);
#else
    PH(3, 4);
    dbg_copy_pooled<<<M * PW / 256, 256, 0, stream>>>(MIX, Z2);
#endif
    dbg_poolmm<<<M * PW / 256, 256, 0, stream>>>(Z2, pool_w, pool_scale, MIX);
    dbg_gemm<1><<<dim3(D / 128, M / 128), 256, 0, stream>>>(MIX, w_o, D, D, out, x, mod, 2 * D);
    dbg_norm<<<M / 4, 256, 0, stream>>>(out, norm2_g, mod, 3 * D, 4 * D, Z2);
    dbg_gemm<2><<<dim3(FF / 128, M / 128), 256, 0, stream>>>(Z2, w1, FF, D, H, nullptr, mod, 0);
    dbg_gemm<3><<<dim3(D / 128, M / 128), 256, 0, stream>>>(H, w2, D, FF, out, nullptr, mod, 5 * D);
}
#endif
```

```cpp
#define MK_N_LAUNCHES 1
#include <hip/hip_runtime.h>
#include <cstdio>
#include <cstdint>
#include <cmath>
#define MODUNROLL 8
namespace pg8 {
#define PG8_LAS __attribute__((address_space(3)))
typedef unsigned short bf16_t;
typedef short bf16x8 __attribute__((ext_vector_type(8)));
typedef float f32x4 __attribute__((ext_vector_type(4)));
typedef unsigned u32x4 __attribute__((ext_vector_type(4)));
constexpr int BM = 256, BK = 64, HALF = 128, HTB = HALF * BK * 2  , STAGE_BYTES = 8 * HTB, NXCD = 8, WGM = 8;

__host__ __device__ __forceinline__ int lds_byte(int r, int c) { const int st = (r >> 4) * 2 + (c >> 5), rr = r & 15, cc = c & 31, ob = rr * 64 + cc * 2; return st * 1024 + (ob ^ (((ob >> 9) & 1) << 5)); }
__host__ __device__ __forceinline__ void stage_rc(int b, int& R, int& C) { const int st = b / 1024, sb = b % 1024, swz = sb ^ (((sb >> 9) & 1) << 5); R = (st >> 1) * 16 + swz / 64; C = (st & 1) * 32 + (swz % 64) / 2; }
__host__ __device__ __forceinline__ int perm32(int rho) { const int n = rho >> 4, i = rho & 15; return 8 * (i >> 2) + 4 * n + (i & 3); }

struct Unit { int pm, pn; };
struct Gemm { const bf16_t* A; const bf16_t* Bt; int M, N, K; };

struct StaticOrder {
    int nM, nN, nwg, G, c;
    __host__ __device__ void init(int M, int N, int G_, int c_) { nM = M / BM; nN = N / BM; nwg = nM * nN; G = G_; c = c_; }
    __host__ __device__ bool next(int i, Unit& u) const {
        const long L = (long)i * G + c; if (L >= nwg) return false;
        int wgid = (int)L; { const int q = nwg / NXCD, r = nwg % NXCD, xcd = wgid % NXCD, off = wgid / NXCD; wgid = (xcd < r ? xcd * (q + 1) : r * (q + 1) + (xcd - r) * q) + off; }
        const int nig = WGM * nN, gid = wgid / nig, fm = gid * WGM, gsz = (nM - fm) < WGM ? (nM - fm) : WGM;
        u.pm = fm + ((wgid % nig) % gsz); u.pn = (wgid % nig) / gsz; return true;
    }
    __device__ __forceinline__ void a_ready(const Unit&) const {}
    __device__ __forceinline__ void done(const Unit&) const {}
};

__device__ __forceinline__ unsigned cvt_pk_bf16(float lo, float hi) { unsigned r; asm volatile("v_cvt_pk_bf16_f32 %0, %1, %2" : "=v"(r) : "v"(lo), "v"(hi)); return r; }
typedef float f32x2 __attribute__((ext_vector_type(2)));
constexpr int SEQ_ = 4096, DM_ = 1024, NMOD_ = 6;
constexpr float EPS_ = 1e-6f;
constexpr float QSCALE = 0.125f * 1.4426950408889634f;

__device__ __forceinline__ u32x4 pack8(const f32x4 a, const f32x4 b) { u32x4 w; w.x = cvt_pk_bf16(a[0], a[1]); w.y = cvt_pk_bf16(a[2], a[3]); w.z = cvt_pk_bf16(b[0], b[1]); w.w = cvt_pk_bf16(b[2], b[3]); return w; }

struct EpiProj {
    static constexpr bool PERM = true, AFTER_DRAIN = false;
    bf16_t *Q, *Kb, *V, *U; const float* rope; const float* qg; const float* kg;
    __device__ __forceinline__ void operator()(const f32x4 (&acc)[2][2][4][2], const Unit& u, int wr, int wc, int fr, int fq) const {
        const int row0 = u.pm * BM + wr * 64 + fr;
        if (u.pn >= 3 || (u.pn == 2 && wc >= 2)) {
            bf16_t* base; int pitch;
            if (u.pn >= 3) { base = U + (u.pn - 3) * 256 + wc * 64 + 8 * fq; pitch = 512; } else { base = V + (wc - 2) * 64 + 8 * fq; pitch = 128; }
#pragma unroll
            for (int ai = 0; ai < 2; ++ai)
#pragma unroll
                for (int m = 0; m < 4; ++m) { bf16_t* rowp = base + (size_t)(row0 + ai * HALF + m * 16) * pitch;
#pragma unroll
                    for (int bj = 0; bj < 2; ++bj) *(u32x4*)(rowp + bj * 32) = pack8(acc[ai][bj][m][0], acc[ai][bj][m][1]); }
        } else {
            const bool isq = u.pn < 2; const float* g = isq ? qg : kg; const float sc = isq ? QSCALE : 1.0f;
            bf16_t* base = isq ? Q + (4 * u.pn + wc) * 64 + 8 * fq : Kb + wc * 64 + 8 * fq; const int pitch = isq ? 512 : 128;
            f32x4 gv[2][2];
#pragma unroll
            for (int bj = 0; bj < 2; ++bj)
#pragma unroll
                for (int n = 0; n < 2; ++n) gv[bj][n] = *(const f32x4*)(g + 32 * bj + 8 * fq + 4 * n);
#pragma unroll
            for (int ai = 0; ai < 2; ++ai)
#pragma unroll
                for (int m = 0; m < 4; ++m) {
                    const int row = row0 + ai * HALF + m * 16;
                    f32x4 cs[2], sn[2];
#pragma unroll
                    for (int n = 0; n < 2; ++n) { cs[n] = *(const f32x4*)(rope + (size_t)row * 16 + 4 * n); sn[n] = *(const f32x4*)(rope + (size_t)row * 16 + 8 + 4 * n); }
                    float ss = 0.f;
#pragma unroll
                    for (int bj = 0; bj < 2; ++bj)
#pragma unroll
                        for (int n = 0; n < 2; ++n) { const f32x4 v = acc[ai][bj][m][n]; ss += (v[0] * v[0] + v[1] * v[1]) + (v[2] * v[2] + v[3] * v[3]); }
                    ss += __shfl_xor(ss, 16); ss += __shfl_xor(ss, 32);
                    const float r = rsqrtf(ss * (1.0f / 64.0f) + EPS_);
                    f32x4 y[2][2];
#pragma unroll
                    for (int bj = 0; bj < 2; ++bj)
#pragma unroll
                        for (int n = 0; n < 2; ++n) y[bj][n] = acc[ai][bj][m][n] * r * gv[bj][n];
#pragma unroll
                    for (int n = 0; n < 2; ++n)
#pragma unroll
                        for (int e = 0; e < 4; ++e) { const float mine = y[0][n][e]; const float other = __shfl_xor(mine, 16);
                            const float ro = (fq == 0) ? mine * cs[n][e] - other * sn[n][e] : mine * cs[n][e] + other * sn[n][e];
                            y[0][n][e] = (fq < 2) ? ro : mine; }
                    bf16_t* rowp = base + (size_t)row * pitch;
#pragma unroll
                    for (int bj = 0; bj < 2; ++bj) *(u32x4*)(rowp + bj * 32) = pack8(y[bj][0] * sc, y[bj][1] * sc);
                }
        }
    }
};

struct EpiWo {
    static constexpr bool PERM = true, AFTER_DRAIN = false;
    const float* x; float* x1; bf16_t* z; const float* mod; const float* a2; float* stats;
    __device__ __forceinline__ void operator()(const f32x4 (&acc)[2][2][4][2], const Unit& u, int wr, int wc, int fr, int fq) const {
        const int b = (u.pm * BM) / SEQ_; const int col0 = u.pn * BM + wc * 32 + 8 * fq; const int row0 = u.pm * BM + wr * 64 + fr;
        f32x4 gv[2][2], av[2][2];
#pragma unroll
        for (int bj = 0; bj < 2; ++bj)
#pragma unroll
            for (int n = 0; n < 2; ++n) { gv[bj][n] = *(const f32x4*)(mod + (size_t)b * NMOD_ * DM_ + 2 * DM_ + col0 + bj * HALF + 4 * n); av[bj][n] = *(const f32x4*)(a2 + (size_t)b * DM_ + col0 + bj * HALF + 4 * n); }
#pragma unroll
        for (int ai = 0; ai < 2; ++ai)
#pragma unroll
            for (int m = 0; m < 4; ++m) {
                const int row = row0 + ai * HALF + m * 16; const size_t off = (size_t)row * DM_ + col0; float ss = 0.f;
#pragma unroll
                for (int bj = 0; bj < 2; ++bj) {
                    const f32x4 xa = *(const f32x4*)(x + off + bj * HALF), xb = *(const f32x4*)(x + off + bj * HALF + 4);
                    const f32x4 v0 = xa + gv[bj][0] * acc[ai][bj][m][0], v1 = xb + gv[bj][1] * acc[ai][bj][m][1];
                    *(f32x4*)(x1 + off + bj * HALF) = v0; *(f32x4*)(x1 + off + bj * HALF + 4) = v1;
                    ss += (v0[0] * v0[0] + v0[1] * v0[1]) + (v0[2] * v0[2] + v0[3] * v0[3]) + (v1[0] * v1[0] + v1[1] * v1[1]) + (v1[2] * v1[2] + v1[3] * v1[3]);
                    *(u32x4*)(z + off + bj * HALF) = pack8(v0 * av[bj][0], v1 * av[bj][1]);
                }
                ss += __shfl_xor(ss, 16); ss += __shfl_xor(ss, 32);
                if (fq == 0) stats[(size_t)row * 16 + u.pn * 4 + wc] = ss;
            }
    }
};

struct EpiUp {
    static constexpr bool PERM = true, AFTER_DRAIN = false;
    bf16_t* H; const float* stats; const float* bias2; int ldc;
    __device__ __forceinline__ void operator()(const f32x4 (&acc)[2][2][4][2], const Unit& u, int wr, int wc, int fr, int fq) const {
        const int b = (u.pm * BM) / SEQ_; const int col0 = u.pn * BM + wc * 32 + 8 * fq; const int row0 = u.pm * BM + wr * 64 + fr;
        f32x4 bv[2][2];
#pragma unroll
        for (int bj = 0; bj < 2; ++bj)
#pragma unroll
            for (int n = 0; n < 2; ++n) bv[bj][n] = *(const f32x4*)(bias2 + (size_t)b * ldc + col0 + bj * HALF + 4 * n);
#pragma unroll
        for (int ai = 0; ai < 2; ++ai)
#pragma unroll
            for (int m = 0; m < 4; ++m) {
                const int row = row0 + ai * HALF + m * 16;
                const f32x4 st = *(const f32x4*)(stats + (size_t)row * 16 + 4 * fq);
                float s = (st[0] + st[1]) + (st[2] + st[3]); s += __shfl_xor(s, 16); s += __shfl_xor(s, 32);
                const float r = rsqrtf(s * (1.0f / DM_) + EPS_);
                bf16_t* rowp = H + (size_t)row * ldc + col0;
#pragma unroll
                for (int bj = 0; bj < 2; ++bj) {
                    f32x4 v0 = acc[ai][bj][m][0] * r + bv[bj][0], v1 = acc[ai][bj][m][1] * r + bv[bj][1];
#pragma unroll
                    for (int e = 0; e < 4; ++e) { const float t0 = fmaxf(v0[e], 0.f), t1 = fmaxf(v1[e], 0.f); v0[e] = t0 * t0; v1[e] = t1 * t1; }
                    *(u32x4*)(rowp + bj * HALF) = pack8(v0, v1);
                }
            }
    }
};

struct EpiDown {
    static constexpr bool PERM = true, AFTER_DRAIN = false;
    float* out; const float* mod;
    __device__ __forceinline__ void operator()(const f32x4 (&acc)[2][2][4][2], const Unit& u, int wr, int wc, int fr, int fq) const {
        const int b = (u.pm * BM) / SEQ_; const int col0 = u.pn * BM + wc * 32 + 8 * fq; const int row0 = u.pm * BM + wr * 64 + fr;
        f32x4 gv[2][2];
#pragma unroll
        for (int bj = 0; bj < 2; ++bj)
#pragma unroll
            for (int n = 0; n < 2; ++n) gv[bj][n] = *(const f32x4*)(mod + (size_t)b * NMOD_ * DM_ + 5 * DM_ + col0 + bj * HALF + 4 * n);
#pragma unroll
        for (int ai = 0; ai < 2; ++ai)
#pragma unroll
            for (int m = 0; m < 4; ++m) {
                const size_t off = (size_t)(row0 + ai * HALF + m * 16) * DM_ + col0;
#pragma unroll
                for (int bj = 0; bj < 2; ++bj) {
                    const f32x4 xa = *(const f32x4*)(out + off + bj * HALF), xb = *(const f32x4*)(out + off + bj * HALF + 4);
                    *(f32x4*)(out + off + bj * HALF) = xa + gv[bj][0] * acc[ai][bj][m][0]; *(f32x4*)(out + off + bj * HALF + 4) = xb + gv[bj][1] * acc[ai][bj][m][1];
                }
            }
    }
};

template <class Epi, class Sched, bool ALIGN_EPI = false, bool SP2 = false>
__device__ __forceinline__ void gemm_phase(PG8_LAS unsigned char* lds, const Gemm g, const Sched& S, const Epi& E) {
    const int tid = threadIdx.x, wid = __builtin_amdgcn_readfirstlane(tid >> 6), lane = tid & 63, wr = wid >> 2, wc = wid & 3, fr = lane & 15, fq = lane >> 4;
    const int K = g.K, nt = K / BK;
    unsigned voffA[2], voffB[2];
#pragma unroll
    for (int i = 0; i < 2; ++i) { int R, C; stage_rc(tid * 16 + i * 8192, R, C); const int Rb = Epi::PERM ? ((R & ~31) + perm32(R & 31)) : R;
        voffA[i] = (unsigned)(R * K + C) * 2u; voffB[i] = (unsigned)(Rb * K + C) * 2u; }
    const size_t kstep = (size_t)(BK * 2);
    const size_t hstep = (size_t)HALF * K * 2;
    const size_t tstep = 2 * hstep;
    const unsigned ldsw = (unsigned)wid * 1024u;
    const int aoff = lds_byte(wr * 64 + fr, fq * 8), boff = lds_byte(wc * 32 + fr, fq * 8);
#define PG8_SA(b, h) (((b) * 2 + (h)) * HTB)
#define PG8_SB(b, h) ((4 + (b) * 2 + (h)) * HTB)
#define PG8_STAGE(bufoff, gbase, voff) do { _Pragma("unroll") for (int _i = 0; _i < 2; ++_i) \
        __builtin_amdgcn_global_load_lds((const unsigned*)((const char*)(gbase) + (voff)[_i]), (PG8_LAS unsigned*)(lds + (bufoff) + ldsw + _i * 8192), 16, 0, 0); } while (0)
#define PG8_LDA(dst, b, h) do { _Pragma("unroll") for (int m = 0; m < 4; ++m) _Pragma("unroll") for (int k = 0; k < 2; ++k) dst[m][k] = *(const PG8_LAS bf16x8*)(lds + PG8_SA(b, h) + aoff + m * 2048 + k * 1024); } while (0)
#define PG8_LDB(dst, b, h) do { _Pragma("unroll") for (int n = 0; n < 2; ++n) _Pragma("unroll") for (int k = 0; k < 2; ++k) dst[n][k] = *(const PG8_LAS bf16x8*)(lds + PG8_SB(b, h) + boff + n * 2048 + k * 1024); } while (0)
#define PG8_MMA(ai, bj, At, Bt) do { __builtin_amdgcn_s_setprio(1); _Pragma("unroll") for (int m = 0; m < 4; ++m) _Pragma("unroll") for (int n = 0; n < 2; ++n) _Pragma("unroll") for (int k = 0; k < 2; ++k) \
        acc[ai][bj][m][n] = __builtin_amdgcn_mfma_f32_16x16x32_bf16(Bt[n][k], At[m][k], acc[ai][bj][m][n], 0, 0, 0); __builtin_amdgcn_s_setprio(0); } while (0)
#define PG8_WAIT_V(n) asm volatile("s_waitcnt vmcnt(" #n ")" ::: "memory")
#define PG8_WAIT_L(n) asm volatile("s_waitcnt lgkmcnt(" #n ")" ::: "memory")
#define PG8_BAR __builtin_amdgcn_s_barrier()
#define PG8_SCHED __builtin_amdgcn_sched_barrier(0)
    Unit cur, nxt; int ui = 0;
    if (!S.next(0, cur)) return;
    f32x4 acc[2][2][4][2];
#pragma unroll
    for (int a = 0; a < 2; ++a)
#pragma unroll
        for (int b = 0; b < 2; ++b)
#pragma unroll
            for (int m = 0; m < 4; ++m)
#pragma unroll
                for (int n = 0; n < 2; ++n) acc[a][b][m][n] = (f32x4){0.f, 0.f, 0.f, 0.f};
    bf16x8 At[4][2], B0[2][2], B1[2][2];
    const char* cA = (const char*)g.A + (size_t)cur.pm * tstep; const char* cB = (const char*)g.Bt + (size_t)cur.pn * tstep;
    S.a_ready(cur);
    if constexpr (SP2) {
        PG8_STAGE(PG8_SB(0, 0), cB, voffB); PG8_STAGE(PG8_SB(0, 1), cB + hstep, voffB); PG8_STAGE(PG8_SA(0, 0), cA, voffA); PG8_STAGE(PG8_SA(0, 1), cA + hstep, voffA);
        if (wr == 1) PG8_BAR;
        PG8_WAIT_V(2); PG8_BAR;
        PG8_STAGE(PG8_SB(1, 0), cB + kstep, voffB); PG8_STAGE(PG8_SA(1, 0), cA + kstep, voffA); PG8_STAGE(PG8_SB(1, 1), cB + hstep + kstep, voffB);
        PG8_WAIT_V(6); PG8_BAR;
    } else {
        PG8_STAGE(PG8_SB(0, 0), cB, voffB); PG8_STAGE(PG8_SA(0, 0), cA, voffA); PG8_STAGE(PG8_SB(0, 1), cB + hstep, voffB); PG8_STAGE(PG8_SA(0, 1), cA + hstep, voffA);
        if (wr == 1) PG8_BAR;
        PG8_WAIT_V(4); PG8_BAR;
        PG8_STAGE(PG8_SB(1, 0), cB + kstep, voffB); PG8_STAGE(PG8_SA(1, 0), cA + kstep, voffA); PG8_STAGE(PG8_SB(1, 1), cB + hstep + kstep, voffB);
        PG8_WAIT_V(6); PG8_BAR;
    }
    for (;;) {
        const bool has_next = S.next(ui + 1, nxt);
        const char* nA = has_next ? (const char*)g.A + (size_t)nxt.pm * tstep : cA; const char* nB = has_next ? (const char*)g.Bt + (size_t)nxt.pn * tstep : cB;
        for (int t = 0; t < nt; t += 2) {
            const bool last = (t == nt - 2);
            const char* a1 = cA + (size_t)(t + 1) * kstep;
            const char* a2 = last ? nA : cA + (size_t)(t + 2) * kstep; const char* b2 = last ? nB : cB + (size_t)(t + 2) * kstep;
            const char* a3 = a2 + kstep; const char* b3 = b2 + kstep;
            if (last && has_next) S.a_ready(nxt);
            if constexpr (SP2) {
            PG8_LDB(B0, 0, 0); PG8_LDB(B1, 0, 1); PG8_SCHED; PG8_LDA(At, 0, 0); PG8_STAGE(PG8_SA(1, 1), a1 + hstep, voffA);
            PG8_WAIT_V(8); PG8_WAIT_L(0); PG8_BAR; PG8_MMA(0, 0, At, B0); PG8_MMA(0, 1, At, B1); PG8_BAR; PG8_SCHED;
            PG8_LDA(At, 0, 1); PG8_STAGE(PG8_SB(0, 0), b2, voffB); PG8_STAGE(PG8_SB(0, 1), b2 + hstep, voffB); PG8_STAGE(PG8_SA(0, 0), a2, voffA);
            PG8_WAIT_V(8); PG8_WAIT_L(0); PG8_BAR; PG8_MMA(1, 0, At, B0); PG8_MMA(1, 1, At, B1); PG8_BAR; PG8_SCHED;
            PG8_LDB(B0, 1, 0); PG8_LDB(B1, 1, 1); PG8_SCHED; PG8_LDA(At, 1, 0); PG8_STAGE(PG8_SA(0, 1), a2 + hstep, voffA);
            PG8_WAIT_V(8); PG8_WAIT_L(0); PG8_BAR; PG8_MMA(0, 0, At, B0); PG8_MMA(0, 1, At, B1); PG8_BAR; PG8_SCHED;
            PG8_LDA(At, 1, 1); PG8_STAGE(PG8_SB(1, 0), b3, voffB); PG8_STAGE(PG8_SB(1, 1), b3 + hstep, voffB); PG8_STAGE(PG8_SA(1, 0), a3, voffA);
            PG8_WAIT_V(8); PG8_WAIT_L(0); PG8_BAR; PG8_MMA(1, 0, At, B0); PG8_MMA(1, 1, At, B1); PG8_BAR; PG8_SCHED;
            } else {
            PG8_LDB(B0, 0, 0); PG8_SCHED; PG8_LDA(At, 0, 0); PG8_STAGE(PG8_SA(1, 1), a1 + hstep, voffA);
            PG8_WAIT_L(8); PG8_BAR; PG8_WAIT_L(0); PG8_MMA(0, 0, At, B0); PG8_BAR; PG8_SCHED;
            PG8_LDB(B1, 0, 1); PG8_STAGE(PG8_SB(0, 0), b2, voffB);
            PG8_BAR; PG8_WAIT_L(0); PG8_MMA(0, 1, At, B1); PG8_BAR;
            PG8_LDA(At, 0, 1); PG8_STAGE(PG8_SA(0, 0), a2, voffA);
            PG8_BAR; PG8_WAIT_L(0); PG8_MMA(1, 0, At, B0); PG8_BAR; PG8_SCHED;
            PG8_STAGE(PG8_SB(0, 1), b2 + hstep, voffB);
            PG8_WAIT_V(6); PG8_BAR; PG8_MMA(1, 1, At, B1); PG8_BAR;
            PG8_LDB(B0, 1, 0); PG8_SCHED; PG8_LDA(At, 1, 0); PG8_STAGE(PG8_SA(0, 1), a2 + hstep, voffA);
            PG8_WAIT_L(8); PG8_BAR; PG8_WAIT_L(0); PG8_MMA(0, 0, At, B0); PG8_BAR; PG8_SCHED;
            PG8_LDB(B1, 1, 1); PG8_STAGE(PG8_SB(1, 0), b3, voffB);
            PG8_BAR; PG8_WAIT_L(0); PG8_MMA(0, 1, At, B1); PG8_BAR;
            PG8_LDA(At, 1, 1); PG8_STAGE(PG8_SA(1, 0), a3, voffA);
            PG8_BAR; PG8_WAIT_L(0); PG8_MMA(1, 0, At, B0); PG8_BAR; PG8_SCHED;
            PG8_STAGE(PG8_SB(1, 1), b3 + hstep, voffB);
            PG8_WAIT_V(6); PG8_BAR; PG8_MMA(1, 1, At, B1); PG8_BAR;
            }
        }
        if constexpr (ALIGN_EPI) { if (wr == 0) PG8_BAR; }
        if constexpr (!Epi::AFTER_DRAIN) { E(acc, cur, wr, wc, fr, fq); S.done(cur); }
        if (!has_next) break;
#pragma unroll
        for (int a = 0; a < 2; ++a)
#pragma unroll
            for (int b = 0; b < 2; ++b)
#pragma unroll
                for (int m = 0; m < 4; ++m)
#pragma unroll
                    for (int n = 0; n < 2; ++n) acc[a][b][m][n] = (f32x4){0.f, 0.f, 0.f, 0.f};
        cur = nxt; cA = nA; cB = nB; ++ui;
        if constexpr (ALIGN_EPI) { if (wr == 1) PG8_BAR; }
    }
    PG8_WAIT_V(0);
    if constexpr (!ALIGN_EPI) { if (wr == 0) PG8_BAR; }
    PG8_BAR;
    if constexpr (Epi::AFTER_DRAIN) { E.fused(acc, cur, wr, wc, fr, fq, lds, wid, lane); S.done(cur); }
#undef PG8_SA
#undef PG8_SB
#undef PG8_STAGE
#undef PG8_LDA
#undef PG8_LDB
#undef PG8_MMA
#undef PG8_WAIT_V
#undef PG8_WAIT_L
#undef PG8_BAR
#undef PG8_SCHED
}
}

constexpr int NWAVES = 8;
constexpr int BATCH = 8, SEQ = 4096, D = 1024, M = BATCH * SEQ;
constexpr int NH = 8, NKV = 2, HD = 64, AW = 512, KVW = 128, PW = 512, INW = 1280, FF = 4096, NMOD = 6;
constexpr float EPS = 1e-6f;
#ifndef MK_N_LAUNCHES
#define MK_N_LAUNCHES 1
#endif
#ifndef DUP_PHASE
#define DUP_PHASE -1
#endif
#ifndef EPI_PHASE
#define EPI_PHASE -1
#endif
#ifndef TAILCONV
#define TAILCONV 1
#endif
#ifndef OLDTR
#define OLDTR 0
#endif
#ifndef MODUNROLL
#define MODUNROLL 32
#endif
constexpr int N_PHASES = 7;
constexpr int N_LAUNCHES = MK_N_LAUNCHES;

constexpr size_t MiB = 1u << 20;
constexpr size_t WS_CTL = 0, CTL_ZERO_BYTES = 64 * 1024;
constexpr size_t WS_MOD = 1 * MiB;
constexpr size_t WS_BIAS2 = 1 * MiB + 256 * 1024;
constexpr size_t WS_A2 = 1 * MiB + 512 * 1024;
constexpr size_t WS_ROPE = 2 * MiB;
constexpr size_t WS_STATS = 4 * MiB;
constexpr size_t WS_WIN = 6 * MiB, WS_WO = 9 * MiB, WS_W1 = 12 * MiB, WS_W2 = 20 * MiB;
constexpr size_t WS_Z2 = 32 * MiB;
constexpr size_t WS_H = 96 * MiB;
constexpr size_t WS_XN = 96 * MiB, WS_Q = 160 * MiB, WS_K = 192 * MiB, WS_V = 200 * MiB, WS_U = 208 * MiB, WS_MIX = 240 * MiB;
constexpr size_t WS_END = 352 * MiB;
constexpr int CW_BAR = 1024;

constexpr int LDS_BYTES = 160 * 1024;
constexpr int MISC_OFF = LDS_BYTES - 256;
constexpr int ATT_K = 0, ATT_V = 24576, ATT_WS = 49152, ATT_OST = ATT_WS + NWAVES * 256, ATT_END = ATT_OST + NWAVES * 4096;

#define GAS __attribute__((address_space(1)))
#define LAS __attribute__((address_space(3)))
typedef unsigned short bf16;
typedef unsigned v4u __attribute__((ext_vector_type(4)));
typedef float f32x4 __attribute__((ext_vector_type(4)));
typedef short bf16x8 __attribute__((ext_vector_type(8)));
typedef GAS unsigned gu32;
typedef GAS unsigned long long gu64;
#define RLX_AGENT __ATOMIC_RELAXED, __HIP_MEMORY_SCOPE_AGENT
#define LDS_WAIT() asm volatile("s_waitcnt lgkmcnt(0)" ::: "memory")
#define VM_WAIT() asm volatile("s_waitcnt vmcnt(0)" ::: "memory")
__device__ __forceinline__ unsigned long long rt() { return __builtin_amdgcn_s_memrealtime(); }
__device__ __forceinline__ unsigned f2bf(float f) { unsigned u = __builtin_bit_cast(unsigned, f); return (u + 0x7fffu + ((u >> 16) & 1u)) >> 16; }
__device__ __forceinline__ unsigned pk2(float lo, float hi) { return f2bf(lo) | (f2bf(hi) << 16); }

#define XB_TMO      128
#define XB_XCNT(j)  (256  + 64 * (j))
#define XB_XSUB(j)  (1280 + 64 * (j))
#define XB_XGEN(j)  (2304 + 64 * (j))
#define XB_TOP      3328
#define XB_TOPGEN   3392
#define XCD_BAR_WORDS 3456
#define XB_SPIN_CAP (1u << 18)

__device__ __forceinline__ unsigned xb_ld(unsigned* p)              { return __hip_atomic_load(p, __ATOMIC_RELAXED, __HIP_MEMORY_SCOPE_AGENT); }
__device__ __forceinline__ unsigned xb_add(unsigned* p, unsigned v) { return __hip_atomic_fetch_add(p, v, __ATOMIC_RELAXED, __HIP_MEMORY_SCOPE_AGENT); }
__device__ __forceinline__ unsigned xb_xcc_id() { return (unsigned)__builtin_amdgcn_s_getreg((3 << 11) | 20) & 0xFu; }
#define XB_SPIN(cond, bar) do { unsigned _sp = 0; while (cond) { __builtin_amdgcn_s_sleep(1); \
    if ((++_sp & 255u) == 0u) { if (xb_ld(&(bar)[XB_TMO])) break; if (_sp > XB_SPIN_CAP) { atomicAdd(&(bar)[XB_TMO], 1u); break; } } } } while (0)

struct XcdBarrier {
    unsigned* bar; unsigned x;
    volatile LAS unsigned* st;
};

__device__ __forceinline__ XcdBarrier xcd_barrier_post(unsigned* bar, volatile LAS unsigned* st) {
    XcdBarrier b; b.bar = bar; b.x = xb_xcc_id(); b.st = st;
    if (threadIdx.x == 0) (void)xb_add(&bar[XB_XCNT(b.x)], 1u);
    return b;
}
__device__ __forceinline__ void xcd_barrier_complete(unsigned* bar, unsigned x, unsigned& nloc, unsigned& nx) {
    const unsigned G = gridDim.x * gridDim.y * gridDim.z;
    unsigned sum, cnt, mine, sp = 0u;
    for (;;) {
        sum = 0u; cnt = 0u; mine = 0u;
#pragma unroll
        for (unsigned j = 0; j < 16; ++j) { const unsigned c = xb_ld(&bar[XB_XCNT(j)]); sum += c; cnt += (c > 0u) ? 1u : 0u; mine = (j == x) ? c : mine; }
        if (sum == G) break;
        __builtin_amdgcn_s_sleep(1);
        if ((++sp & 255u) == 0u) { if (xb_ld(&bar[XB_TMO])) break; if (sp > XB_SPIN_CAP) { atomicAdd(&bar[XB_TMO], 1u); break; } }
    }
    nloc = mine > 0u ? mine : 1u; nx = cnt > 0u ? cnt : 1u;
}

__device__ __forceinline__ void xcd_barrier(const XcdBarrier& b) {
    asm volatile("s_waitcnt vmcnt(0)" ::: "memory");
    __syncthreads();
    if (threadIdx.x == 0) {
        unsigned* bar = b.bar;
        __builtin_amdgcn_s_waitcnt(0);
        unsigned nloc = b.st[0], nx = b.st[1];
        if (nloc == 0u) { xcd_barrier_complete(bar, b.x, nloc, nx); b.st[0] = nloc; b.st[1] = nx; }
        const unsigned old = xb_add(&bar[XB_XSUB(b.x)], 1u);
        const unsigned gen = old / nloc;
        if (old + 1u == (gen + 1u) * nloc) {
            __builtin_amdgcn_fence(__ATOMIC_RELEASE, "agent");
            asm volatile("s_waitcnt vmcnt(0)" ::: "memory");
            const unsigned og = xb_add(&bar[XB_TOP], 1u);
            const unsigned tg = og / nx;
            if (og + 1u == (tg + 1u) * nx) xb_add(&bar[XB_TOPGEN], 1u);
            else XB_SPIN(xb_ld(&bar[XB_TOPGEN]) == tg, bar);
            __builtin_amdgcn_fence(__ATOMIC_ACQUIRE, "agent");
            xb_add(&bar[XB_XGEN(b.x)], 1u);
            asm volatile("s_waitcnt vmcnt(0)" ::: "memory");
        } else {
            XB_SPIN(xb_ld(&bar[XB_XGEN(b.x)]) == gen, bar);
            __builtin_amdgcn_fence(__ATOMIC_ACQUIRE, "agent");
            asm volatile("s_waitcnt vmcnt(0)" ::: "memory");
        }
    }
    __syncthreads();
}

typedef float f32x16 __attribute__((ext_vector_type(16)));
typedef short s16x4 __attribute__((ext_vector_type(4)));
struct Frame {
    LAS unsigned char* lds;
    int tid, lane, wave, vcu, G;
};
__device__ __forceinline__ float wave_sum(float v) {
#pragma unroll
    for (int o = 1; o < 64; o <<= 1) v += __shfl_xor(v, o);
    return v;
}
__device__ __forceinline__ float bf2f(unsigned short h) { return __builtin_bit_cast(float, (unsigned)h << 16); }
__device__ __forceinline__ float bflo(unsigned w) { return __builtin_bit_cast(float, w << 16); }
__device__ __forceinline__ float bfhi(unsigned w) { return __builtin_bit_cast(float, w & 0xffff0000u); }

__device__ __forceinline__ void p0_transpose_item(const float* W, int N, bf16* WT, int Kd, int k0, int n0, int dst_row0, LAS float* scr, int lane) {
#if OLDTR
#pragma unroll 8
    for (int i = 0; i < 32; ++i) { const int kk = 2 * i + (lane >> 5); scr[kk * 33 + (lane & 31)] = W[(size_t)(k0 + kk) * N + n0 + (lane & 31)]; }
#else
    f32x4 v[8];
#pragma unroll
    for (int i = 0; i < 8; ++i) v[i] = *(const GAS f32x4*)(W + (size_t)(k0 + 8 * i + (lane >> 3)) * N + n0 + 4 * (lane & 7));
#pragma unroll
    for (int i = 0; i < 8; ++i) { LAS float* d = scr + (8 * i + (lane >> 3)) * 33 + 4 * (lane & 7); d[0] = v[i][0]; d[1] = v[i][1]; d[2] = v[i][2]; d[3] = v[i][3]; }
#endif
    LDS_WAIT(); asm volatile("" ::: "memory");
    const int c = lane & 7;
#pragma unroll
    for (int j = 0; j < 4; ++j) { const int n = (lane >> 3) + 8 * j; const LAS float* s = scr + (8 * c) * 33 + n;
        v4u o; o.x = pk2(s[0 * 33], s[1 * 33]); o.y = pk2(s[2 * 33], s[3 * 33]); o.z = pk2(s[4 * 33], s[5 * 33]); o.w = pk2(s[6 * 33], s[7 * 33]);
        *(GAS v4u*)(WT + (size_t)(dst_row0 + n) * Kd + k0 + 8 * c) = o; }
    LDS_WAIT(); asm volatile("" ::: "memory");
}
__device__ __forceinline__ int win_slot(int n) { const int pn = n >> 8, r = n & 255; return 256 * pn + 128 * ((r >> 5) & 1) + 32 * (r >> 6) + (r & 31); }

struct Ptrs {
    const float *x, *c, *w_ada, *b_ada, *norm1_g, *w_in, *q_norm_g, *k_norm_g, *sinks, *pool_w, *pool_scale, *w_o, *norm2_g, *w1, *w2; const int* positions;
    float *out, *mod, *bias2, *a2, *rope, *stats; bf16 *Win_t, *Wo_t, *W1_t, *W2_t, *XN, *Q, *K, *V, *U, *MIX, *Z2, *H;
};

__device__ __forceinline__ void p0_mod_task(Frame& F, const Ptrs& P, int t) {
    LAS float* cactT = (LAS float*)F.lds;
    LAS float* red = (LAS float*)(F.lds + 65536);
    { float cv[16];
#pragma unroll
      for (int i = 0; i < 16; ++i) cv[i] = P.c[F.tid + 512 * i];
#pragma unroll
      for (int i = 0; i < 16; ++i) { const int idx = F.tid + 512 * i, b = idx >> 10, k = idx & 1023; cactT[k * 16 + b] = cv[i] / (1.f + __expf(-cv[i])); cactT[k * 16 + 8 + b] = 0.f; } }
    __syncthreads();
    const int j0 = 64 * t, kb = 128 * F.wave, kq = F.lane >> 4, jl = F.lane & 15;
    f32x4 acc[4];
#pragma unroll
    for (int e = 0; e < 4; ++e) acc[e] = (f32x4){0.f, 0.f, 0.f, 0.f};
    const GAS float* wp = (const GAS float*)P.w_ada + (size_t)(kb + kq) * (NMOD * D) + j0 + 4 * jl;
#pragma unroll
    for (int s0 = 0; s0 < 32; s0 += 16) {
        f32x4 wv[16];
#pragma unroll
        for (int s = 0; s < 16; ++s) wv[s] = *(const GAS f32x4*)(wp + (size_t)(4 * (s0 + s)) * (NMOD * D));
#pragma unroll
        for (int s = 0; s < 16; ++s) { const float a = cactT[(kb + 4 * (s0 + s) + kq) * 16 + jl];
#pragma unroll
            for (int e = 0; e < 4; ++e) acc[e] = __builtin_amdgcn_mfma_f32_16x16x4f32(a, wv[s][e], acc[e], 0, 0, 0); }
    }
    if (F.lane < 32) {
#pragma unroll
        for (int e = 0; e < 4; ++e)
#pragma unroll
            for (int r = 0; r < 4; ++r) red[((F.wave * 4 + e) * 4 + r) * 32 + F.lane] = acc[e][r];
    }
    __syncthreads();
    { const int b = F.tid >> 6, col = F.tid & 63, e = col & 3, lane = (b >> 2) * 16 + (col >> 2), r = b & 3; float sum = 0.f;
#pragma unroll
      for (int w = 0; w < NWAVES; ++w) sum += red[((w * 4 + e) * 4 + r) * 32 + lane];
      P.mod[(size_t)b * NMOD * D + j0 + col] = sum + P.b_ada[j0 + col]; }
    __syncthreads();
}
__device__ __forceinline__ void p0_fold_task(Frame& F, const Ptrs& P, int t) {
    const int g = t >> 5, n0 = (t & 31) * 32;
    LAS float* Pm = (LAS float*)F.lds;
    LAS float* Wm = (LAS float*)(F.lds + 128 * 129 * 4);
    { float pv[32], wv[8];
#pragma unroll
      for (int i = 0; i < 32; ++i) pv[i] = P.pool_w[(size_t)g * 16384 + F.tid + 512 * i];
#pragma unroll
      for (int i = 0; i < 8; ++i) { const int idx = F.tid + 512 * i; wv[i] = P.w_o[(size_t)(512 + 128 * g + (idx >> 5)) * D + n0 + (idx & 31)]; }
      const float sc = P.pool_scale[128 * g + (F.tid & 127)];
#pragma unroll
      for (int i = 0; i < 32; ++i) { const int idx = F.tid + 512 * i; Pm[(idx >> 7) * 129 + (idx & 127)] = pv[i] * sc; }
#pragma unroll
      for (int i = 0; i < 8; ++i) { const int idx = F.tid + 512 * i; Wm[(idx >> 5) * 33 + (idx & 31)] = wv[i]; } }
    __syncthreads();
    const int c = F.tid & 127, q = F.tid >> 7;
    float acc[8];
#pragma unroll
    for (int i = 0; i < 8; ++i) acc[i] = 0.f;
#pragma unroll 4
    for (int d = 0; d < 128; ++d) { const float p = Pm[c * 129 + d];
#pragma unroll
        for (int i = 0; i < 8; ++i) acc[i] += p * Wm[d * 33 + q + 4 * i]; }
#pragma unroll
    for (int i = 0; i < 8; ++i) P.Wo_t[(size_t)(n0 + q + 4 * i) * D + 512 + 128 * g + c] = (bf16)f2bf(acc[i]);
    __syncthreads();
}
__device__ __forceinline__ void p0a_prologue(Frame& F, const Ptrs& P) {
    for (int t = F.vcu; t < 96 + 128; t += F.G) { if (t < 96) p0_mod_task(F, P, t); else p0_fold_task(F, P, t - 96); }
    LAS float* scr = (LAS float*)(F.lds + F.wave * 16384);
    const int gw = F.vcu * NWAVES + F.wave, NGW = F.G * NWAVES;
    constexpr int I_IN = (D / 64) * (INW / 32), I_O = (AW / 64) * (D / 32), I_1 = (D / 64) * (FF / 32), I_2 = (FF / 64) * (D / 32);
    for (int it = gw; it < I_IN + I_O + (TAILCONV ? 0 : I_1 + I_2); it += NGW) {
        int r = it;
        if (r < I_IN) { const int nblk = INW / 32, kb = r / nblk, nb = r % nblk; p0_transpose_item(P.w_in, INW, P.Win_t, D, 64 * kb, 32 * nb, win_slot(32 * nb), scr, F.lane); continue; } r -= I_IN;
        if (r < I_O) { const int nblk = D / 32, kb = r / nblk, nb = r % nblk; p0_transpose_item(P.w_o, D, P.Wo_t, D, 64 * kb, 32 * nb, 32 * nb, scr, F.lane); continue; } r -= I_O;
        if (r < I_1) { const int nblk = FF / 32, kb = r / nblk, nb = r % nblk; p0_transpose_item(P.w1, FF, P.W1_t, D, 64 * kb, 32 * nb, 32 * nb, scr, F.lane); continue; } r -= I_1;
        { const int nblk = D / 32, kb = r / nblk, nb = r % nblk; p0_transpose_item(P.w2, D, P.W2_t, FF, 64 * kb, 32 * nb, 32 * nb, scr, F.lane); }
    }
    for (int idx = (F.vcu * NWAVES * 64 + F.tid); idx < M * 8; idx += F.G * NWAVES * 64) {
        const int m = idx >> 3, i = idx & 7;
        const float inv_freq = (i == 0) ? 1.0f : (i == 1) ? 0.1939227432012558f : (i == 2) ? 0.03760603070259094f : (i == 3) ? 0.007292664609849453f : (i == 4) ? 0.0014142135623842478f : (i == 5) ? 0.00027424818836152554f : (i == 6) ? 5.3182957344688475e-05f : 1.0313385246263351e-05f;
        const float ang = (float)P.positions[m] * inv_freq;
        P.rope[(size_t)m * 16 + i] = (float)cos((double)ang); P.rope[(size_t)m * 16 + 8 + i] = (float)sin((double)ang);
    }
}

__device__ __forceinline__ void p1_tail_convert(Frame& F, const Ptrs& P, int ord, int cnt) {
    LAS float* scr = (LAS float*)(F.lds + F.wave * 16384);
    constexpr int I_1 = (D / 64) * (FF / 32), I_2 = (FF / 64) * (D / 32);
    for (int it = ord * NWAVES + F.wave; it < I_1 + I_2; it += cnt * NWAVES) {
        if (it < I_1) { const int nblk = FF / 32, kb = it / nblk, nb = it % nblk; p0_transpose_item(P.w1, FF, P.W1_t, D, 64 * kb, 32 * nb, 32 * nb, scr, F.lane); }
        else { const int r = it - I_1, nblk = D / 32, kb = r / nblk, nb = r % nblk; p0_transpose_item(P.w2, D, P.W2_t, FF, 64 * kb, 32 * nb, 32 * nb, scr, F.lane); }
    }
}

__device__ __forceinline__ void p0b_norm(Frame& F, const Ptrs& P) {
    const int gt = F.vcu * NWAVES * 64 + F.tid, NGT = F.G * NWAVES * 64;
    for (int i = gt; i < BATCH * D; i += NGT) { const int b = i >> 10, col = i & 1023; P.a2[i] = P.norm2_g[col] * (1.f + P.mod[(size_t)b * NMOD * D + 4 * D + col]); }
    const int gw = F.vcu * NWAVES + F.wave, NGW = F.G * NWAVES;
    for (int rb = gw; rb < M / 16; rb += NGW) {
        const int b = (rb * 16) / SEQ; const float* mb = P.mod + (size_t)b * NMOD * D;
        f32x4 av[4], sv[4];
#pragma unroll
        for (int j = 0; j < 4; ++j) { const int col = 256 * j + 4 * F.lane; const f32x4 g = *(const f32x4*)(P.norm1_g + col), sc = *(const f32x4*)(mb + D + col); av[j] = g * (sc + 1.0f); sv[j] = *(const f32x4*)(mb + col); }
        for (int rr = 0; rr < 16; rr += 4) {
            f32x4 v[4][4]; float s[4];
#pragma unroll
            for (int q = 0; q < 4; ++q) { const GAS f32x4* xr = (const GAS f32x4*)(P.x + (size_t)(rb * 16 + rr + q) * D) + F.lane;
#pragma unroll
                for (int j = 0; j < 4; ++j) v[q][j] = xr[64 * j]; }
#pragma unroll
            for (int q = 0; q < 4; ++q) { float t = 0.f;
#pragma unroll
                for (int j = 0; j < 4; ++j) t += (v[q][j][0] * v[q][j][0] + v[q][j][1] * v[q][j][1]) + (v[q][j][2] * v[q][j][2] + v[q][j][3] * v[q][j][3]);
                s[q] = t; }
#pragma unroll
            for (int o = 1; o < 64; o <<= 1) {
#pragma unroll
                for (int q = 0; q < 4; ++q) s[q] += __shfl_xor(s[q], o); }
#pragma unroll
            for (int q = 0; q < 4; ++q) { const float r = rsqrtf(s[q] * (1.f / D) + EPS);
                GAS unsigned long long* o8 = (GAS unsigned long long*)(P.XN + (size_t)(rb * 16 + rr + q) * D) + F.lane;
#pragma unroll
                for (int j = 0; j < 4; ++j) { const f32x4 y = v[q][j] * r * av[j] + sv[j]; o8[64 * j] = (unsigned long long)pk2(y[0], y[1]) | ((unsigned long long)pk2(y[2], y[3]) << 32); } }
        }
    }
}
__device__ __forceinline__ void bias2_tasks(Frame& F, const Ptrs& P) {
    const int gw = F.vcu * NWAVES + F.wave, NGW = F.G * NWAVES;
    for (int n = gw; n < FF; n += NGW) {
        const v4u w0 = *(const GAS v4u*)(P.W1_t + (size_t)n * D + F.lane * 16), w1v = *(const GAS v4u*)(P.W1_t + (size_t)n * D + F.lane * 16 + 8);
        float wf[16]; wf[0] = bflo(w0.x); wf[1] = bfhi(w0.x); wf[2] = bflo(w0.y); wf[3] = bfhi(w0.y); wf[4] = bflo(w0.z); wf[5] = bfhi(w0.z); wf[6] = bflo(w0.w); wf[7] = bfhi(w0.w);
        wf[8] = bflo(w1v.x); wf[9] = bfhi(w1v.x); wf[10] = bflo(w1v.y); wf[11] = bfhi(w1v.y); wf[12] = bflo(w1v.z); wf[13] = bfhi(w1v.z); wf[14] = bflo(w1v.w); wf[15] = bfhi(w1v.w);
        float sb[BATCH];
#pragma unroll
        for (int b = 0; b < BATCH; ++b) { const float* sh = P.mod + (size_t)b * NMOD * D + 3 * D + F.lane * 16; float t = 0.f;
#pragma unroll
            for (int j = 0; j < 4; ++j) { const f32x4 q = *(const f32x4*)(sh + 4 * j); t += (q[0] * wf[4 * j] + q[1] * wf[4 * j + 1]) + (q[2] * wf[4 * j + 2] + q[3] * wf[4 * j + 3]); }
            sb[b] = t; }
#pragma unroll
        for (int o = 1; o < 64; o <<= 1) {
#pragma unroll
            for (int b = 0; b < BATCH; ++b) sb[b] += __shfl_xor(sb[b], o); }
        if (F.lane < BATCH) { float r = sb[0];
#pragma unroll
            for (int b = 1; b < BATCH; ++b) r = (F.lane == b) ? sb[b] : r;
            P.bias2[(size_t)F.lane * FF + n] = r; }
    }
}

__device__ __forceinline__ int crow(int r, int hi) { return (r & 3) + 8 * (r >> 2) + 4 * hi; }
__device__ __forceinline__ unsigned cvtpk(float lo, float hi) { unsigned r; asm volatile("v_cvt_pk_bf16_f32 %0, %1, %2" : "=v"(r) : "v"(lo), "v"(hi)); return r; }
typedef short v4i16_t __attribute__((ext_vector_type(4)));
__device__ __forceinline__ s16x4 vtr(LAS const unsigned char* p) { return __builtin_bit_cast(s16x4, __builtin_amdgcn_ds_read_tr16_b64_v4i16((LAS v4i16_t*)p)); }

struct AttnRegs { v4u k[3], v[3]; bf16x8 q[4]; };
__device__ __forceinline__ void attn_load(Frame& F, const Ptrs& P, int unit, AttnRegs& R) {
    const int lane = F.lane, wid = F.wave, r32 = lane & 31, hi = lane >> 5;
    const int bk = unit >> 6, qb = unit & 63, b = bk >> 1, kvh = bk & 1, wh = wid & 1, hq = kvh * 4 + (wid >> 1);
    const long rowbase = (long)b * SEQ; const int q0 = qb * 64, kv0 = q0 - 128, qw0 = q0 + 32 * wh;
#pragma unroll
    for (int i = 0; i < 3; ++i) { const int kvr = kv0 + 64 * i + lane; R.k[i] = (v4u){0u, 0u, 0u, 0u}; if (kvr >= 0) R.k[i] = *(const GAS v4u*)(P.K + (rowbase + kvr) * KVW + kvh * 64 + wid * 8); }
#pragma unroll
    for (int i = 0; i < 3; ++i) { const int kvr = kv0 + 64 * i + 16 * (wid & 3) + (lane >> 2); R.v[i] = (v4u){0u, 0u, 0u, 0u}; if (kvr >= 0) R.v[i] = *(const GAS v4u*)(P.V + (rowbase + kvr) * KVW + kvh * 64 + (wid >> 2) * 32 + (lane & 3) * 8); }
    const bf16* Qw = P.Q + (rowbase + qw0 + r32) * AW + hq * 64 + hi * 8;
#pragma unroll
    for (int d0 = 0; d0 < 4; ++d0) R.q[d0] = *(const GAS bf16x8*)(Qw + d0 * 16);
}
__device__ __forceinline__ void attn_compute(Frame& F, const Ptrs& P, int unit, const bf16x8 (&qr)[4]) {
    const int lane = F.lane, wid = F.wave, r32 = lane & 31, hi = lane >> 5;
    const int bk = unit >> 6, qb = unit & 63, b = bk >> 1, kvh = bk & 1, wh = wid & 1, hq = kvh * 4 + (wid >> 1);
    const long rowbase = (long)b * SEQ; const int q0 = qb * 64, qw0 = q0 + 32 * wh;
    LAS unsigned char* lds = F.lds;
    f32x16 p[5];
#pragma unroll
    for (int j = 0; j < 5; ++j) {
        const int hb = wh + j; const LAS unsigned char* kp = lds + ATT_K + (hb >> 1) * 8192 + hi * 1024 + ((hb & 1) * 32 + r32) * 16;
        f32x16 a = {0.f, 0.f, 0.f, 0.f, 0.f, 0.f, 0.f, 0.f, 0.f, 0.f, 0.f, 0.f, 0.f, 0.f, 0.f, 0.f};
#pragma unroll
        for (int d0 = 0; d0 < 4; ++d0) { const bf16x8 kf = *(const LAS bf16x8*)(kp + d0 * 2048); a = __builtin_amdgcn_mfma_f32_32x32x16_bf16(kf, qr[d0], a, 0, 0, 0); }
        p[j] = a;
    }
    const float NEG = -INFINITY;
#pragma unroll
    for (int j = 0; j < 5; ++j) {
        const bool valid = (qw0 - 128 + 32 * j) >= 0;
#pragma unroll
        for (int r = 0; r < 16; ++r) { bool keep = valid; if (j == 0) keep = keep && (crow(r, hi) > r32); if (j == 4) keep = keep && (crow(r, hi) <= r32); if (!keep) p[j][r] = NEG; }
    }
    const float sinkl2 = P.sinks[hq] * 1.4426950408889634f;
    float mx = sinkl2;
#pragma unroll
    for (int j = 0; j < 5; ++j)
#pragma unroll
        for (int r = 0; r < 16; ++r) mx = fmaxf(mx, p[j][r]);
    { auto rr = __builtin_amdgcn_permlane32_swap(__float_as_uint(mx), __float_as_uint(mx), false, false); mx = fmaxf(__uint_as_float(rr[0]), __uint_as_float(rr[1])); }
    float l = 0.f;
#pragma unroll
    for (int j = 0; j < 5; ++j)
#pragma unroll
        for (int r = 0; r < 16; ++r) { const float e = __builtin_amdgcn_exp2f(p[j][r] - mx); p[j][r] = e; l += e; }
    { auto rr = __builtin_amdgcn_permlane32_swap(__float_as_uint(l), __float_as_uint(l), false, false); l = __uint_as_float(rr[0]) + __uint_as_float(rr[1]); }
    l += __builtin_amdgcn_exp2f(sinkl2 - mx);
    f32x16 o[2];
    o[0] = (f32x16){0.f, 0.f, 0.f, 0.f, 0.f, 0.f, 0.f, 0.f, 0.f, 0.f, 0.f, 0.f, 0.f, 0.f, 0.f, 0.f}; o[1] = o[0];
    const LAS unsigned char* vb = lds + ATT_V + ((lane >> 4) & 1) * 32 + (lane & 3) * 8 + (4 * hi + ((lane & 15) >> 2)) * 64;
#pragma unroll
    for (int j = 0; j < 5; ++j) {
        const int hb = wh + j; const LAS unsigned char* vt = vb + (hb >> 1) * 8192 + (hb & 1) * 2048;
#pragma unroll
        for (int s = 0; s < 2; ++s) {
            v4u pw; pw.x = cvtpk(p[j][8 * s + 0], p[j][8 * s + 1]); pw.y = cvtpk(p[j][8 * s + 2], p[j][8 * s + 3]); pw.z = cvtpk(p[j][8 * s + 4], p[j][8 * s + 5]); pw.w = cvtpk(p[j][8 * s + 6], p[j][8 * s + 7]);
            const bf16x8 pf = __builtin_bit_cast(bf16x8, pw);
#pragma unroll
            for (int d0 = 0; d0 < 2; ++d0) {
                const s16x4 lo = vtr(vt + d0 * 4096 + s * 1024), hh = vtr(vt + d0 * 4096 + s * 1024 + 512);
                const bf16x8 vf = (bf16x8){lo[0], lo[1], lo[2], lo[3], hh[0], hh[1], hh[2], hh[3]};
                o[d0] = __builtin_amdgcn_mfma_f32_32x32x16_bf16(pf, vf, o[d0], 0, 0, 0);
            }
        }
    }
    LAS float* wsf = (LAS float*)(lds + ATT_WS) + wid * 64;
    if (hi == 0) wsf[r32] = l;
    LDS_WAIT(); asm volatile("" ::: "memory");
    float rli[16];
#pragma unroll
    for (int r = 0; r < 16; ++r) rli[r] = __builtin_amdgcn_rcpf(wsf[crow(r, hi)]);
    LAS bf16* stg = (LAS bf16*)(lds + ATT_OST) + wid * 2048;
#pragma unroll
    for (int r = 0; r < 16; ++r) { const int orow = crow(r, hi);
#pragma unroll
        for (int d0 = 0; d0 < 2; ++d0) stg[orow * 64 + d0 * 32 + r32] = (bf16)f2bf(o[d0][r] * rli[r]); }
    LDS_WAIT(); asm volatile("" ::: "memory");
    bf16* Ow = P.MIX + (rowbase + qw0) * D + hq * 64;
#pragma unroll
    for (int i = 0; i < 4; ++i) { const int row = i * 8 + (lane >> 3), ch = lane & 7; const v4u v = *(const LAS v4u*)(stg + row * 64 + ch * 8); *(GAS v4u*)(Ow + (size_t)row * D + ch * 8) = v; }
}
__device__ __forceinline__ void unpack8(const v4u w, float (&f)[8]) { f[0] = bflo(w.x); f[1] = bfhi(w.x); f[2] = bflo(w.y); f[3] = bfhi(w.y); f[4] = bflo(w.z); f[5] = bfhi(w.z); f[6] = bflo(w.w); f[7] = bfhi(w.w); }
__device__ __forceinline__ void pool_task(Frame& F, const Ptrs& P, int task) {
    const int g = task & 3, rb = task >> 2, w = 2 << g;
    const int ch = F.lane & 15, run = F.lane >> 4;
    const int t0 = (rb * 64 + run * 16) & (SEQ - 1);
    const GAS char* ub = (const GAS char*)(P.U + (size_t)(rb * 64) * PW + g * 128);
    GAS char* ob = (GAS char*)(P.MIX + (size_t)(rb * 64) * D + AW + g * 128);
    const unsigned loff = (unsigned)((run * 16 * PW + ch * 8) * 2), ooff = (unsigned)((run * 16 * D + ch * 8) * 2);
    const v4u zero = (v4u){0u, 0u, 0u, 0u};
    v4u cur[16], prev[16];
#pragma unroll
    for (int i = 0; i < 16; ++i) cur[i] = *(const GAS v4u*)(ub + (size_t)i * (PW * 2) + loff);
#pragma unroll
    for (int j = 1; j <= 16; ++j) { prev[j - 1] = zero; if (j <= w && t0 - j >= 0) prev[j - 1] = *(const GAS v4u*)(ub - (size_t)j * (PW * 2) + loff); }
    float S[8];
#pragma unroll
    for (int e = 0; e < 8; ++e) S[e] = 0.f;
#pragma unroll
    for (int j = 1; j <= 16; ++j) { float f[8]; unpack8(prev[j - 1], f);
#pragma unroll
        for (int e = 0; e < 8; ++e) S[e] += f[e]; }
#pragma unroll
    for (int i = 0; i < 16; ++i) {
        const int t = t0 + i; float u[8]; unpack8(cur[i], u);
#pragma unroll
        for (int e = 0; e < 8; ++e) S[e] += u[e];
        { float f[8];
          if (w == 2) { unpack8(i < 2 ? prev[1 - i >= 0 ? 1 - i : 0] : cur[i >= 2 ? i - 2 : 0], f); }
          else if (w == 4) { unpack8(i < 4 ? prev[3 - i >= 0 ? 3 - i : 0] : cur[i >= 4 ? i - 4 : 0], f); }
          else if (w == 8) { unpack8(i < 8 ? prev[7 - i >= 0 ? 7 - i : 0] : cur[i >= 8 ? i - 8 : 0], f); }
          else { unpack8(prev[15 - i], f); }
#pragma unroll
          for (int e = 0; e < 8; ++e) S[e] -= f[e]; }
        const float inv = 1.0f / (float)((t + 1) < w ? (t + 1) : w);
        v4u o; o.x = pk2(S[0] * inv - u[0], S[1] * inv - u[1]); o.y = pk2(S[2] * inv - u[2], S[3] * inv - u[3]); o.z = pk2(S[4] * inv - u[4], S[5] * inv - u[5]); o.w = pk2(S[6] * inv - u[6], S[7] * inv - u[7]);
        *(GAS v4u*)(ob + (size_t)i * (D * 2) + ooff) = o;
    }
}
__device__ __forceinline__ void p2_attn_pool(Frame& F, const Ptrs& P) {
    constexpr int NUNITS = BATCH * NKV * (SEQ / 64);
    const int upw = (NUNITS + F.G - 1) / F.G, first = F.vcu * upw;
    int n = NUNITS - first; n = n < 0 ? 0 : (n > upw ? upw : n);
    AttnRegs R;
    if (n > 0) attn_load(F, P, first, R);
    for (int i = 0; i < n; ++i) {
        bf16x8 qr[4];
#pragma unroll
        for (int d0 = 0; d0 < 4; ++d0) qr[d0] = R.q[d0];
#pragma unroll
        for (int t = 0; t < 3; ++t) { *(LAS v4u*)(F.lds + ATT_K + t * 8192 + F.wave * 1024 + F.lane * 16) = R.k[t]; *(LAS v4u*)(F.lds + ATT_V + t * 8192 + F.wave * 1024 + F.lane * 16) = R.v[t]; }
        __syncthreads();
        if (i + 1 < n) attn_load(F, P, first + i + 1, R);
        attn_compute(F, P, first + i, qr);
        __syncthreads();
    }
    const int gw = F.vcu * NWAVES + F.wave, NGW = F.G * NWAVES;
    for (int t = gw; t < 4 * (M / 64); t += NGW) pool_task(F, P, t);
    bias2_tasks(F, P);
}

struct Args { const void* in[16]; float* out; unsigned char* ws; int ph_lo, ph_hi; };
__global__ void __launch_bounds__(NWAVES * 64, 2) fwd_megakernel(Args args) {
    extern __shared__ __attribute__((aligned(16))) unsigned char lds[];
    Frame F;
    F.lds = (LAS unsigned char*)lds;
    F.tid = threadIdx.x; F.lane = F.tid & 63; F.wave = __builtin_amdgcn_readfirstlane(F.tid >> 6);
    F.G = gridDim.x; { const int bx = blockIdx.x; F.vcu = (F.G % 8 == 0) ? (bx % 8) * (F.G / 8) + bx / 8 : bx; }
    unsigned char* ws = args.ws;
    Ptrs P;
    P.x = (const float*)args.in[0]; P.c = (const float*)args.in[1]; P.positions = (const int*)args.in[2]; P.w_ada = (const float*)args.in[3]; P.b_ada = (const float*)args.in[4];
    P.norm1_g = (const float*)args.in[5]; P.w_in = (const float*)args.in[6]; P.q_norm_g = (const float*)args.in[7]; P.k_norm_g = (const float*)args.in[8]; P.sinks = (const float*)args.in[9];
    P.pool_w = (const float*)args.in[10]; P.pool_scale = (const float*)args.in[11]; P.w_o = (const float*)args.in[12]; P.norm2_g = (const float*)args.in[13]; P.w1 = (const float*)args.in[14]; P.w2 = (const float*)args.in[15];
    P.out = args.out; P.mod = (float*)(ws + WS_MOD); P.bias2 = (float*)(ws + WS_BIAS2); P.a2 = (float*)(ws + WS_A2); P.rope = (float*)(ws + WS_ROPE); P.stats = (float*)(ws + WS_STATS);
    P.Win_t = (bf16*)(ws + WS_WIN); P.Wo_t = (bf16*)(ws + WS_WO); P.W1_t = (bf16*)(ws + WS_W1); P.W2_t = (bf16*)(ws + WS_W2);
    P.XN = (bf16*)(ws + WS_XN); P.Q = (bf16*)(ws + WS_Q); P.K = (bf16*)(ws + WS_K); P.V = (bf16*)(ws + WS_V); P.U = (bf16*)(ws + WS_U); P.MIX = (bf16*)(ws + WS_MIX); P.Z2 = (bf16*)(ws + WS_Z2); P.H = (bf16*)(ws + WS_H);
    volatile LAS unsigned* MISC = (volatile LAS unsigned*)(F.lds + MISC_OFF);
    if (F.tid < 64) MISC[F.tid] = 0u;
    __syncthreads();
    XcdBarrier bar; bar.bar = (unsigned*)(ws + WS_CTL) + CW_BAR; bar.x = 0; bar.st = nullptr;
    if (N_LAUNCHES == 1) bar = xcd_barrier_post((unsigned*)(ws + WS_CTL) + CW_BAR, MISC + 8);
    const int lo = args.ph_lo, hi = args.ph_hi;
#define IN(k) (lo <= (k) && (k) < hi)
#define SEAM(k) do { if (IN(k) && IN((k) + 1)) xcd_barrier(bar); } while (0)

    if (IN(0)) { p0a_prologue(F, P); SEAM(0); }
    if (IN(1)) { p0b_norm(F, P); SEAM(1); }
    if (IN(2)) {
        pg8::Gemm g{P.XN, P.Win_t, M, INW, D}; pg8::StaticOrder S; S.init(M, INW, F.G, (int)blockIdx.x);
        pg8::EpiProj E{P.Q, P.K, P.V, P.U, P.rope, P.q_norm_g, P.k_norm_g};
        pg8::gemm_phase<pg8::EpiProj, pg8::StaticOrder, true, true>(F.lds, g, S, E);
        if (TAILCONV) { const int nwg = (M / 256) * (INW / 256), rem = nwg % F.G;
          if (rem == 0) p1_tail_convert(F, P, (int)blockIdx.x, F.G); else if ((int)blockIdx.x >= rem) p1_tail_convert(F, P, (int)blockIdx.x - rem, F.G - rem); }
        SEAM(2);
    }
    if (IN(3)) { p2_attn_pool(F, P); SEAM(3); }
    if (IN(4)) {
        pg8::Gemm g{P.MIX, P.Wo_t, M, D, D}; pg8::StaticOrder S; S.init(M, D, F.G, (int)blockIdx.x);
        pg8::EpiWo E{P.x, P.out, P.Z2, P.mod, P.a2, P.stats};
        pg8::gemm_phase<pg8::EpiWo, pg8::StaticOrder, true, true>(F.lds, g, S, E);
        SEAM(4);
    }
    if (IN(5)) {
        pg8::Gemm g{P.Z2, P.W1_t, M, FF, D}; pg8::StaticOrder S; S.init(M, FF, F.G, (int)blockIdx.x);
        pg8::EpiUp E{P.H, P.stats, P.bias2, FF};
        pg8::gemm_phase<pg8::EpiUp, pg8::StaticOrder, true, true>(F.lds, g, S, E);
        SEAM(5);
    }
    if (IN(6)) {
        pg8::Gemm g{P.H, P.W2_t, M, D, FF}; pg8::StaticOrder S; S.init(M, D, F.G, (int)blockIdx.x);
        pg8::EpiDown E{P.out, P.mod};
        pg8::gemm_phase<pg8::EpiDown, pg8::StaticOrder, true, true>(F.lds, g, S, E);
    }
#undef IN
#undef SEAM
}

#ifndef HYB
extern "C" void kernel_launch(void* const* d_in, const int* in_sizes, int n_in, void* d_out, int out_size, void* d_ws, size_t ws_size, hipStream_t stream) {
    static int grid = 0;
    if (grid == 0) {
        if (n_in != 16 || out_size != M * D || ws_size < WS_END) { fprintf(stderr, "kernel_launch: unexpected shapes (n_in %d out %d ws %zu)\n", n_in, out_size, ws_size); grid = -1; return; }
        int dev = 0, cus = 0, per_cu = 0;
        if (hipGetDevice(&dev) != hipSuccess || hipDeviceGetAttribute(&cus, hipDeviceAttributeMultiprocessorCount, dev) != hipSuccess) { grid = -1; return; }
        if (hipFuncSetAttribute((const void*)fwd_megakernel, hipFuncAttributeMaxDynamicSharedMemorySize, LDS_BYTES) != hipSuccess) { fprintf(stderr, "kernel_launch: hipFuncSetAttribute failed\n"); grid = -1; return; }
        if (hipOccupancyMaxActiveBlocksPerMultiprocessor(&per_cu, (const void*)fwd_megakernel, NWAVES * 64, LDS_BYTES) != hipSuccess || per_cu < 1) { fprintf(stderr, "kernel_launch: occupancy query says %d\n", per_cu); per_cu = 1; }
        (void)hipGetLastError();
        if (per_cu > 1) per_cu = 1;
        grid = cus * per_cu;
    }
    if (grid < 0) return;
    (void)hipMemsetAsync((char*)d_ws + WS_CTL, 0, CTL_ZERO_BYTES, stream);
    Args a{};
    for (int i = 0; i < 16; ++i) a.in[i] = d_in[i];
    a.out = (float*)d_out; a.ws = (unsigned char*)d_ws;
    if (N_LAUNCHES == 1 && DUP_PHASE == 6) {
        a.ph_lo = 0; a.ph_hi = N_PHASES; hipLaunchKernelGGL(fwd_megakernel, dim3(grid), dim3(NWAVES * 64), LDS_BYTES, stream, a);
        (void)hipMemsetAsync((char*)d_ws + WS_CTL, 0, CTL_ZERO_BYTES, stream);
        a.out = (float*)((char*)d_ws + WS_END); a.ph_lo = 6; a.ph_hi = 7; hipLaunchKernelGGL(fwd_megakernel, dim3(grid), dim3(NWAVES * 64), LDS_BYTES, stream, a);
    } else if (N_LAUNCHES == 1 && DUP_PHASE >= 0) {
        a.ph_lo = 0; a.ph_hi = DUP_PHASE + 1; hipLaunchKernelGGL(fwd_megakernel, dim3(grid), dim3(NWAVES * 64), LDS_BYTES, stream, a);
        (void)hipMemsetAsync((char*)d_ws + WS_CTL, 0, CTL_ZERO_BYTES, stream);
        a.ph_lo = DUP_PHASE; a.ph_hi = DUP_PHASE + 1; hipLaunchKernelGGL(fwd_megakernel, dim3(grid), dim3(NWAVES * 64), LDS_BYTES, stream, a);
        (void)hipMemsetAsync((char*)d_ws + WS_CTL, 0, CTL_ZERO_BYTES, stream);
        a.ph_lo = DUP_PHASE + 1; a.ph_hi = N_PHASES; hipLaunchKernelGGL(fwd_megakernel, dim3(grid), dim3(NWAVES * 64), LDS_BYTES, stream, a);
    } else if (N_LAUNCHES == 1) { a.ph_lo = 0; a.ph_hi = N_PHASES; hipLaunchKernelGGL(fwd_megakernel, dim3(grid), dim3(NWAVES * 64), LDS_BYTES, stream, a); }
    else for (int li = 0; li < N_PHASES; ++li) { a.ph_lo = li; a.ph_hi = li + 1; hipLaunchKernelGGL(fwd_megakernel, dim3(grid), dim3(NWAVES * 64), LDS_BYTES, stream, a); }
}
#endif

#ifdef HYB
__global__ void dbg_norm(const float* __restrict__ x, const float* __restrict__ g, const float* __restrict__ mod, int sh_off, int sc_off, bf16* __restrict__ out) {
    const int wave = (blockIdx.x * blockDim.x + threadIdx.x) >> 6, lane = threadIdx.x & 63;
    if (wave >= M) return;
    const int b = wave / SEQ; const float* xr = x + (size_t)wave * D;
    float v[16]; float s = 0.f;
#pragma unroll
    for (int j = 0; j < 4; ++j) { const f32x4 t = *(const f32x4*)(xr + j * 256 + lane * 4); v[4 * j] = t[0]; v[4 * j + 1] = t[1]; v[4 * j + 2] = t[2]; v[4 * j + 3] = t[3]; s += t[0] * t[0] + t[1] * t[1] + t[2] * t[2] + t[3] * t[3]; }
    s = wave_sum(s);
    const float r = rsqrtf(s * (1.f / D) + EPS); const float* mb = mod + (size_t)b * NMOD * D;
#pragma unroll
    for (int j = 0; j < 4; ++j)
#pragma unroll
        for (int i = 0; i < 4; ++i) { const int col = j * 256 + lane * 4 + i; const float y = v[4 * j + i] * r * g[col] * (1.f + mb[sc_off + col]) + mb[sh_off + col]; out[(size_t)wave * D + col] = (bf16)f2bf(y); }
}
template <int MODE>
__global__ __launch_bounds__(256) void dbg_gemm(const bf16* __restrict__ A, const float* __restrict__ B, int N, int K, void* Cout, const float* X, const float* __restrict__ mod, int gate_off) {
    __shared__ __attribute__((aligned(16))) bf16 sA[128][40];
    __shared__ __attribute__((aligned(16))) bf16 sB[128][40];
    const int tid = threadIdx.x, lane = tid & 63, w = tid >> 6, wr = w >> 1, wc = w & 1;
    const int m0 = blockIdx.y * 128, n0 = blockIdx.x * 128;
    f32x4 acc[4][4];
#pragma unroll
    for (int i = 0; i < 4; ++i)
#pragma unroll
        for (int j = 0; j < 4; ++j) acc[i][j] = (f32x4){0.f, 0.f, 0.f, 0.f};
    for (int k0 = 0; k0 < K; k0 += 32) {
        { const int r = tid >> 1, cc = (tid & 1) * 16; const bf16x8* src = (const bf16x8*)(A + (size_t)(m0 + r) * K + k0 + cc); *(bf16x8*)&sA[r][cc] = src[0]; *(bf16x8*)&sA[r][cc + 8] = src[1]; }
        { const int kk = tid >> 3, nn = (tid & 7) * 16; const float* src = B + (size_t)(k0 + kk) * N + n0 + nn;
#pragma unroll
          for (int i = 0; i < 16; ++i) sB[nn + i][kk] = (bf16)f2bf(src[i]); }
        __syncthreads();
        bf16x8 a[4], b[4];
#pragma unroll
        for (int i = 0; i < 4; ++i) a[i] = *(const bf16x8*)&sA[wr * 64 + i * 16 + (lane & 15)][8 * (lane >> 4)];
#pragma unroll
        for (int j = 0; j < 4; ++j) b[j] = *(const bf16x8*)&sB[wc * 64 + j * 16 + (lane & 15)][8 * (lane >> 4)];
#pragma unroll
        for (int i = 0; i < 4; ++i)
#pragma unroll
            for (int j = 0; j < 4; ++j) acc[i][j] = __builtin_amdgcn_mfma_f32_16x16x32_bf16(a[i], b[j], acc[i][j], 0, 0, 0);
        __syncthreads();
    }
#pragma unroll
    for (int i = 0; i < 4; ++i)
#pragma unroll
        for (int j = 0; j < 4; ++j)
#pragma unroll
            for (int r = 0; r < 4; ++r) {
                const int row = m0 + wr * 64 + i * 16 + (lane >> 4) * 4 + r, col = n0 + wc * 64 + j * 16 + (lane & 15);
                const float v = acc[i][j][r]; const size_t o = (size_t)row * N + col;
                if (MODE == 0) ((bf16*)Cout)[o] = (bf16)f2bf(v);
                else if (MODE == 2) { const float t = v > 0.f ? v : 0.f; ((bf16*)Cout)[o] = (bf16)f2bf(t * t); }
                else { const int b_ = row / SEQ; const float gt = mod[(size_t)b_ * NMOD * D + gate_off + col]; const float base = (MODE == 1) ? X[o] : ((float*)Cout)[o]; ((float*)Cout)[o] = base + gt * v; }
            }
}
__global__ __launch_bounds__(64) void dbg_attn(const bf16* __restrict__ Q, const bf16* __restrict__ Kb, const bf16* __restrict__ Vb, const float* __restrict__ sinks, bf16* __restrict__ MIX) {
    const int id = blockIdx.x * blockDim.x + threadIdx.x;
    if (id >= M * NH) return;
    const int m = id / NH, hq = id % NH, kvh = hq / 4, b = m / SEQ, t = m % SEQ;
    float q[64], acc[64];
#pragma unroll
    for (int d = 0; d < 64; ++d) { q[d] = bf2f(Q[(size_t)m * AW + hq * 64 + d]); acc[d] = 0.f; }
    float mx = -1e30f, l = 0.f;
    const int j0 = t - 127 < 0 ? 0 : t - 127;
    for (int j = j0; j <= t; ++j) {
        const size_t kr = (size_t)(b * SEQ + j); float s = 0.f;
#pragma unroll
        for (int d = 0; d < 64; ++d) s += q[d] * bf2f(Kb[kr * KVW + kvh * 64 + d]);
        s *= 0.6931471805599453f;
        const float mn = fmaxf(mx, s); const float f = __expf(mx - mn), p = __expf(s - mn);
        l = l * f + p;
#pragma unroll
        for (int d = 0; d < 64; ++d) acc[d] = acc[d] * f + p * bf2f(Vb[kr * KVW + kvh * 64 + d]);
        mx = mn;
    }
    const float sk = sinks[hq]; const float mn = fmaxf(mx, sk); const float f = __expf(mx - mn);
    l = l * f + __expf(sk - mn);
    const float inv = f / l;
#pragma unroll
    for (int d = 0; d < 64; ++d) MIX[(size_t)m * D + hq * 64 + d] = (bf16)f2bf(acc[d] * inv);
}
__global__ void dbg_pool(const bf16* __restrict__ U, bf16* __restrict__ POOLED) {
    const int id = blockIdx.x * blockDim.x + threadIdx.x;
    if (id >= M * PW) return;
    const int m = id / PW, c = id % PW, g = c / 128, w = 2 << g, t = m % SEQ;
    const int cnt = (t + 1) < w ? (t + 1) : w; float s = 0.f;
    for (int j = 0; j < cnt; ++j) s += bf2f(U[(size_t)(m - j) * PW + c]);
    POOLED[(size_t)m * PW + c] = (bf16)f2bf(s / (float)cnt - bf2f(U[(size_t)m * PW + c]));
}
__global__ void dbg_copy_pooled(const bf16* __restrict__ MIX, bf16* __restrict__ POOLED) {
    const int id = blockIdx.x * blockDim.x + threadIdx.x;
    if (id >= M * PW) return;
    POOLED[id] = MIX[(size_t)(id / PW) * D + AW + (id % PW)];
}
__global__ void dbg_poolmm(const bf16* __restrict__ POOLED, const float* __restrict__ pool_w, const float* __restrict__ pool_scale, bf16* __restrict__ MIX) {
    const int id = blockIdx.x * blockDim.x + threadIdx.x;
    if (id >= M * PW) return;
    const int m = id / PW, c = id % PW, g = c / 128, d = c % 128; float s = 0.f;
    for (int k = 0; k < 128; ++k) s += bf2f(POOLED[(size_t)m * PW + g * 128 + k]) * pool_w[(size_t)(g * 128 + k) * 128 + d];
    MIX[(size_t)m * D + AW + c] = (bf16)f2bf(s * pool_scale[c]);
}
extern "C" void kernel_launch(void* const* d_in, const int* in_sizes, int n_in, void* d_out, int out_size, void* d_ws, size_t ws_size, hipStream_t stream) {
    static int grid = 0;
    if (grid == 0) {
        hipFuncSetAttribute((const void*)fwd_megakernel, hipFuncAttributeMaxDynamicSharedMemorySize, LDS_BYTES);
        grid = 256;
    }
    (void)hipMemsetAsync((char*)d_ws + WS_CTL, 0, CTL_ZERO_BYTES, stream);
    Args a{};
    for (int i = 0; i < 16; ++i) a.in[i] = d_in[i];
    a.out = (float*)d_out; a.ws = (unsigned char*)d_ws;
    unsigned char* ws = (unsigned char*)d_ws;
    const float* x = (const float*)d_in[0]; const float* sinks = (const float*)d_in[9]; const float* pool_w = (const float*)d_in[10]; const float* pool_scale = (const float*)d_in[11];
    const float* w_o = (const float*)d_in[12]; const float* norm2_g = (const float*)d_in[13]; const float* w1 = (const float*)d_in[14]; const float* w2 = (const float*)d_in[15];
    float* out = (float*)d_out; float* mod = (float*)(ws + WS_MOD);
    bf16 *Q = (bf16*)(ws + WS_Q), *Kb = (bf16*)(ws + WS_K), *Vb = (bf16*)(ws + WS_V), *U = (bf16*)(ws + WS_U), *MIX = (bf16*)(ws + WS_MIX), *Z2 = (bf16*)(ws + WS_Z2), *H = (bf16*)(ws + WS_H);
#define PH(lo_, hi_) do { a.ph_lo = lo_; a.ph_hi = hi_; for (int li = lo_; li < hi_; ++li) { a.ph_lo = li; a.ph_hi = li + 1; hipLaunchKernelGGL(fwd_megakernel, dim3(grid), dim3(NWAVES * 64), LDS_BYTES, stream, a); } } while (0)
    PH(0, 3);
#if HYB == 1
    dbg_attn<<<M * NH / 64, 64, 0, stream>>>(Q, Kb, Vb, sinks, MIX);
    dbg_pool<<<M * PW / 256, 256, 0, stream>>>(U, Z2);
#else
    PH(3, 4);
    dbg_copy_pooled<<<M * PW / 256, 256, 0, stream>>>(MIX, Z2);
#endif
    dbg_poolmm<<<M * PW / 256, 256, 0, stream>>>(Z2, pool_w, pool_scale, MIX);
    dbg_gemm<1><<<dim3(D / 128, M / 128), 256, 0, stream>>>(MIX, w_o, D, D, out, x, mod, 2 * D);
    dbg_norm<<<M / 4, 256, 0, stream>>>(out, norm2_g, mod, 3 * D, 4 * D, Z2);
    dbg_gemm<2><<<dim3(FF / 128, M / 128), 256, 0, stream>>>(Z2, w1, FF, D, H, nullptr, mod, 0);
    dbg_gemm<3><<<dim3(D / 128, M / 128), 256, 0, stream>>>(H, w2, D, FF, out, nullptr, mod, 5 * D);
}
#endif
```

```cpp
#define MK_N_LAUNCHES 1
#include <hip/hip_runtime.h>
#include <cstdio>
#include <cstdint>
#include <cmath>
#define MODUNROLL 8
#define PERBATCH 0
#define P4ORDER StaticOrder
namespace pg8 {
#define PG8_LAS __attribute__((address_space(3)))
typedef unsigned short bf16_t;
typedef short bf16x8 __attribute__((ext_vector_type(8)));
typedef float f32x4 __attribute__((ext_vector_type(4)));
typedef unsigned u32x4 __attribute__((ext_vector_type(4)));
constexpr int BM = 256, BK = 64, HALF = 128, HTB = HALF * BK * 2  , STAGE_BYTES = 8 * HTB, NXCD = 8, WGM = 8;

__host__ __device__ __forceinline__ int lds_byte(int r, int c) { const int st = (r >> 4) * 2 + (c >> 5), rr = r & 15, cc = c & 31, ob = rr * 64 + cc * 2; return st * 1024 + (ob ^ (((ob >> 9) & 1) << 5)); }
__host__ __device__ __forceinline__ void stage_rc(int b, int& R, int& C) { const int st = b / 1024, sb = b % 1024, swz = sb ^ (((sb >> 9) & 1) << 5); R = (st >> 1) * 16 + swz / 64; C = (st & 1) * 32 + (swz % 64) / 2; }
__host__ __device__ __forceinline__ int perm32(int rho) { const int n = rho >> 4, i = rho & 15; return 8 * (i >> 2) + 4 * n + (i & 3); }

struct Unit { int pm, pn; };
struct Gemm { const bf16_t* A; const bf16_t* Bt; int M, N, K; int bshift; size_t bstride; };

struct StaticOrder {
    int nM, nN, nwg, G, c;
    __host__ __device__ void init(int M, int N, int G_, int c_) { nM = M / BM; nN = N / BM; nwg = nM * nN; G = G_; c = c_; }
    __host__ __device__ bool next(int i, Unit& u) const {
        const long L = (long)i * G + c; if (L >= nwg) return false;
        int wgid = (int)L; { const int q = nwg / NXCD, r = nwg % NXCD, xcd = wgid % NXCD, off = wgid / NXCD; wgid = (xcd < r ? xcd * (q + 1) : r * (q + 1) + (xcd - r) * q) + off; }
        const int nig = WGM * nN, gid = wgid / nig, fm = gid * WGM, gsz = (nM - fm) < WGM ? (nM - fm) : WGM;
        u.pm = fm + ((wgid % nig) % gsz); u.pn = (wgid % nig) / gsz; return true;
    }
    __device__ __forceinline__ void a_ready(const Unit&) const {}
    __device__ __forceinline__ void done(const Unit&) const {}
};

struct BatchOrder : StaticOrder {
    __host__ __device__ bool next(int i, Unit& u) const {
        if (G != 256 || nM != 128 || nN != 16) return StaticOrder::next(i, u);
        if (i >= 8) return false;
        const int x = c & 7, j = c >> 3;
        u.pm = 16 * i + 4 * (x >> 1) + (j & 3); u.pn = 8 * (x & 1) + (j >> 2); return true;
    }
};

__device__ __forceinline__ unsigned cvt_pk_bf16(float lo, float hi) { unsigned r; asm volatile("v_cvt_pk_bf16_f32 %0, %1, %2" : "=v"(r) : "v"(lo), "v"(hi)); return r; }
typedef float f32x2 __attribute__((ext_vector_type(2)));
constexpr int SEQ_ = 4096, DM_ = 1024, NMOD_ = 6;
constexpr float EPS_ = 1e-6f;
constexpr float QSCALE = 0.125f * 1.4426950408889634f;

__device__ __forceinline__ u32x4 pack8(const f32x4 a, const f32x4 b) { u32x4 w; w.x = cvt_pk_bf16(a[0], a[1]); w.y = cvt_pk_bf16(a[2], a[3]); w.z = cvt_pk_bf16(b[0], b[1]); w.w = cvt_pk_bf16(b[2], b[3]); return w; }

struct EpiProj {
    static constexpr bool PERM = true, AFTER_DRAIN = false;
    bf16_t *Q, *Kb, *V, *U; const float* rope; const float* qg; const float* kg;
    __device__ __forceinline__ void operator()(const f32x4 (&acc)[2][2][4][2], const Unit& u, int wr, int wc, int fr, int fq) const {
        const int row0 = u.pm * BM + wr * 64 + fr;
        if (u.pn >= 3 || (u.pn == 2 && wc >= 2)) {
            bf16_t* base; int pitch;
            if (u.pn >= 3) { base = U + (u.pn - 3) * 256 + wc * 64 + 8 * fq; pitch = 512; } else { base = V + (wc - 2) * 64 + 8 * fq; pitch = 128; }
#pragma unroll
            for (int ai = 0; ai < 2; ++ai)
#pragma unroll
                for (int m = 0; m < 4; ++m) { bf16_t* rowp = base + (size_t)(row0 + ai * HALF + m * 16) * pitch;
#pragma unroll
                    for (int bj = 0; bj < 2; ++bj) *(u32x4*)(rowp + bj * 32) = pack8(acc[ai][bj][m][0], acc[ai][bj][m][1]); }
        } else {
            const bool isq = u.pn < 2; const float* g = isq ? qg : kg; const float sc = isq ? QSCALE : 1.0f;
            bf16_t* base = isq ? Q + (4 * u.pn + wc) * 64 + 8 * fq : Kb + wc * 64 + 8 * fq; const int pitch = isq ? 512 : 128;
            f32x4 gv[2][2];
#pragma unroll
            for (int bj = 0; bj < 2; ++bj)
#pragma unroll
                for (int n = 0; n < 2; ++n) gv[bj][n] = *(const f32x4*)(g + 32 * bj + 8 * fq + 4 * n);
#pragma unroll
            for (int ai = 0; ai < 2; ++ai)
#pragma unroll
                for (int m = 0; m < 4; ++m) {
                    const int row = row0 + ai * HALF + m * 16;
                    f32x4 cs[2], sn[2];
#pragma unroll
                    for (int n = 0; n < 2; ++n) { cs[n] = *(const f32x4*)(rope + (size_t)row * 16 + 4 * n); sn[n] = *(const f32x4*)(rope + (size_t)row * 16 + 8 + 4 * n); }
                    float ss = 0.f;
#pragma unroll
                    for (int bj = 0; bj < 2; ++bj)
#pragma unroll
                        for (int n = 0; n < 2; ++n) { const f32x4 v = acc[ai][bj][m][n]; ss += (v[0] * v[0] + v[1] * v[1]) + (v[2] * v[2] + v[3] * v[3]); }
                    ss += __shfl_xor(ss, 16); ss += __shfl_xor(ss, 32);
                    const float r = rsqrtf(ss * (1.0f / 64.0f) + EPS_);
                    f32x4 y[2][2];
#pragma unroll
                    for (int bj = 0; bj < 2; ++bj)
#pragma unroll
                        for (int n = 0; n < 2; ++n) y[bj][n] = acc[ai][bj][m][n] * r * gv[bj][n];
#pragma unroll
                    for (int n = 0; n < 2; ++n)
#pragma unroll
                        for (int e = 0; e < 4; ++e) { const float mine = y[0][n][e]; const float other = __shfl_xor(mine, 16);
                            const float ro = (fq == 0) ? mine * cs[n][e] - other * sn[n][e] : mine * cs[n][e] + other * sn[n][e];
                            y[0][n][e] = (fq < 2) ? ro : mine; }
                    bf16_t* rowp = base + (size_t)row * pitch;
#pragma unroll
                    for (int bj = 0; bj < 2; ++bj) *(u32x4*)(rowp + bj * 32) = pack8(y[bj][0] * sc, y[bj][1] * sc);
                }
        }
    }
};

struct EpiWo {
    static constexpr bool PERM = true, AFTER_DRAIN = false;
    const float* x; bf16_t* xb1; const float* mod; float* stats; bf16_t* z; const float* a2;
    __device__ __forceinline__ void operator()(const f32x4 (&acc)[2][2][4][2], const Unit& u, int wr, int wc, int fr, int fq) const {
        const int b = (u.pm * BM) / SEQ_; const int col0 = u.pn * BM + wc * 32 + 8 * fq; const int row0 = u.pm * BM + wr * 64 + fr;
        f32x4 gv[2][2], av[2][2];
#pragma unroll
        for (int bj = 0; bj < 2; ++bj)
#pragma unroll
            for (int n = 0; n < 2; ++n) { gv[bj][n] = *(const f32x4*)(mod + (size_t)b * NMOD_ * DM_ + 2 * DM_ + col0 + bj * HALF + 4 * n); av[bj][n] = z ? *(const f32x4*)(a2 + (size_t)b * DM_ + col0 + bj * HALF + 4 * n) : (f32x4){1.f, 1.f, 1.f, 1.f}; }
#pragma unroll
        for (int ai = 0; ai < 2; ++ai)
#pragma unroll
            for (int m = 0; m < 4; ++m) {
                const int row = row0 + ai * HALF + m * 16; const size_t off = (size_t)row * DM_ + col0; float ss = 0.f;
#pragma unroll
                for (int bj = 0; bj < 2; ++bj) {
                    const f32x4 xa = *(const f32x4*)(x + off + bj * HALF), xb = *(const f32x4*)(x + off + bj * HALF + 4);
                    const f32x4 v0 = xa + gv[bj][0] * acc[ai][bj][m][0], v1 = xb + gv[bj][1] * acc[ai][bj][m][1];
                    ss += (v0[0] * v0[0] + v0[1] * v0[1]) + (v0[2] * v0[2] + v0[3] * v0[3]) + (v1[0] * v1[0] + v1[1] * v1[1]) + (v1[2] * v1[2] + v1[3] * v1[3]);
                    *(u32x4*)(xb1 + off + bj * HALF) = pack8(v0, v1);
                    if (z) *(u32x4*)(z + off + bj * HALF) = pack8(v0 * av[bj][0], v1 * av[bj][1]);
                }
                ss += __shfl_xor(ss, 16); ss += __shfl_xor(ss, 32);
                if (fq == 0) stats[(size_t)row * 16 + u.pn * 4 + wc] = ss;
            }
    }
};

struct EpiUp {
    static constexpr bool PERM = true, AFTER_DRAIN = false;
    bf16_t* H; const float* stats; const float* bias2; int ldc;
    __device__ __forceinline__ void operator()(const f32x4 (&acc)[2][2][4][2], const Unit& u, int wr, int wc, int fr, int fq) const {
        const int b = (u.pm * BM) / SEQ_; const int col0 = u.pn * BM + wc * 32 + 8 * fq; const int row0 = u.pm * BM + wr * 64 + fr;
        f32x4 bv[2][2];
#pragma unroll
        for (int bj = 0; bj < 2; ++bj)
#pragma unroll
            for (int n = 0; n < 2; ++n) bv[bj][n] = *(const f32x4*)(bias2 + (size_t)b * ldc + col0 + bj * HALF + 4 * n);
#pragma unroll
        for (int ai = 0; ai < 2; ++ai)
#pragma unroll
            for (int m = 0; m < 4; ++m) {
                const int row = row0 + ai * HALF + m * 16;
                const f32x4 st = *(const f32x4*)(stats + (size_t)row * 16 + 4 * fq);
                float s = (st[0] + st[1]) + (st[2] + st[3]); s += __shfl_xor(s, 16); s += __shfl_xor(s, 32);
                const float r = rsqrtf(s * (1.0f / DM_) + EPS_);
                bf16_t* rowp = H + (size_t)row * ldc + col0;
#pragma unroll
                for (int bj = 0; bj < 2; ++bj) {
                    f32x4 v0 = acc[ai][bj][m][0] * r + bv[bj][0], v1 = acc[ai][bj][m][1] * r + bv[bj][1];
#pragma unroll
                    for (int e = 0; e < 4; ++e) { const float t0 = fmaxf(v0[e], 0.f), t1 = fmaxf(v1[e], 0.f); v0[e] = t0 * t0; v1[e] = t1 * t1; }
                    *(u32x4*)(rowp + bj * HALF) = pack8(v0, v1);
                }
            }
    }
};

struct EpiDown {
    static constexpr bool PERM = true, AFTER_DRAIN = false;
    float* out; const bf16_t* xb1; const float* mod;
    __device__ __forceinline__ void operator()(const f32x4 (&acc)[2][2][4][2], const Unit& u, int wr, int wc, int fr, int fq) const {
        const int b = (u.pm * BM) / SEQ_; const int col0 = u.pn * BM + wc * 32 + 8 * fq; const int row0 = u.pm * BM + wr * 64 + fr;
        f32x4 gv[2][2];
#pragma unroll
        for (int bj = 0; bj < 2; ++bj)
#pragma unroll
            for (int n = 0; n < 2; ++n) gv[bj][n] = *(const f32x4*)(mod + (size_t)b * NMOD_ * DM_ + 5 * DM_ + col0 + bj * HALF + 4 * n);
#pragma unroll
        for (int ai = 0; ai < 2; ++ai)
#pragma unroll
            for (int m = 0; m < 4; ++m) {
                const size_t off = (size_t)(row0 + ai * HALF + m * 16) * DM_ + col0;
#pragma unroll
                for (int bj = 0; bj < 2; ++bj) {
                    const u32x4 w = *(const u32x4*)(xb1 + off + bj * HALF);
                    const f32x4 xa = (f32x4){__builtin_bit_cast(float, w.x << 16), __builtin_bit_cast(float, w.x & 0xffff0000u), __builtin_bit_cast(float, w.y << 16), __builtin_bit_cast(float, w.y & 0xffff0000u)};
                    const f32x4 xb = (f32x4){__builtin_bit_cast(float, w.z << 16), __builtin_bit_cast(float, w.z & 0xffff0000u), __builtin_bit_cast(float, w.w << 16), __builtin_bit_cast(float, w.w & 0xffff0000u)};
                    *(f32x4*)(out + off + bj * HALF) = xa + gv[bj][0] * acc[ai][bj][m][0]; *(f32x4*)(out + off + bj * HALF + 4) = xb + gv[bj][1] * acc[ai][bj][m][1];
                }
            }
    }
};

template <class Epi, class Sched, bool ALIGN_EPI = false, bool SP2 = false>
__device__ __forceinline__ void gemm_phase(PG8_LAS unsigned char* lds, const Gemm g, const Sched& S, const Epi& E) {
    const int tid = threadIdx.x, wid = __builtin_amdgcn_readfirstlane(tid >> 6), lane = tid & 63, wr = wid >> 2, wc = wid & 3, fr = lane & 15, fq = lane >> 4;
    const int K = g.K, nt = K / BK;
    unsigned voffA[2], voffB[2];
#pragma unroll
    for (int i = 0; i < 2; ++i) { int R, C; stage_rc(tid * 16 + i * 8192, R, C); const int Rb = Epi::PERM ? ((R & ~31) + perm32(R & 31)) : R;
        voffA[i] = (unsigned)(R * K + C) * 2u; voffB[i] = (unsigned)(Rb * K + C) * 2u; }
    const size_t kstep = (size_t)(BK * 2);
    const size_t hstep = (size_t)HALF * K * 2;
    const size_t tstep = 2 * hstep;
    const unsigned ldsw = (unsigned)wid * 1024u;
    const int aoff = lds_byte(wr * 64 + fr, fq * 8), boff = lds_byte(wc * 32 + fr, fq * 8);
#define PG8_SA(b, h) (((b) * 2 + (h)) * HTB)
#define PG8_SB(b, h) ((4 + (b) * 2 + (h)) * HTB)
#define PG8_STAGE(bufoff, gbase, voff) do { _Pragma("unroll") for (int _i = 0; _i < 2; ++_i) \
        __builtin_amdgcn_global_load_lds((const unsigned*)((const char*)(gbase) + (voff)[_i]), (PG8_LAS unsigned*)(lds + (bufoff) + ldsw + _i * 8192), 16, 0, 0); } while (0)
#define PG8_LDA(dst, b, h) do { _Pragma("unroll") for (int m = 0; m < 4; ++m) _Pragma("unroll") for (int k = 0; k < 2; ++k) dst[m][k] = *(const PG8_LAS bf16x8*)(lds + PG8_SA(b, h) + aoff + m * 2048 + k * 1024); } while (0)
#define PG8_LDB(dst, b, h) do { _Pragma("unroll") for (int n = 0; n < 2; ++n) _Pragma("unroll") for (int k = 0; k < 2; ++k) dst[n][k] = *(const PG8_LAS bf16x8*)(lds + PG8_SB(b, h) + boff + n * 2048 + k * 1024); } while (0)
#define PG8_MMA(ai, bj, At, Bt) do { __builtin_amdgcn_s_setprio(1); _Pragma("unroll") for (int m = 0; m < 4; ++m) _Pragma("unroll") for (int n = 0; n < 2; ++n) _Pragma("unroll") for (int k = 0; k < 2; ++k) \
        acc[ai][bj][m][n] = __builtin_amdgcn_mfma_f32_16x16x32_bf16(Bt[n][k], At[m][k], acc[ai][bj][m][n], 0, 0, 0); __builtin_amdgcn_s_setprio(0); } while (0)
#define PG8_WAIT_V(n) asm volatile("s_waitcnt vmcnt(" #n ")" ::: "memory")
#define PG8_WAIT_L(n) asm volatile("s_waitcnt lgkmcnt(" #n ")" ::: "memory")
#define PG8_BAR __builtin_amdgcn_s_barrier()
#define PG8_SCHED __builtin_amdgcn_sched_barrier(0)
    Unit cur, nxt; int ui = 0;
    if (!S.next(0, cur)) return;
    f32x4 acc[2][2][4][2];
#pragma unroll
    for (int a = 0; a < 2; ++a)
#pragma unroll
        for (int b = 0; b < 2; ++b)
#pragma unroll
            for (int m = 0; m < 4; ++m)
#pragma unroll
                for (int n = 0; n < 2; ++n) acc[a][b][m][n] = (f32x4){0.f, 0.f, 0.f, 0.f};
    bf16x8 At[4][2], B0[2][2], B1[2][2];
    const char* cA = (const char*)g.A + (size_t)cur.pm * tstep; const char* cB = (const char*)(g.Bt + (size_t)(cur.pm >> g.bshift) * g.bstride) + (size_t)cur.pn * tstep;
    S.a_ready(cur);
    if constexpr (SP2) {
        PG8_STAGE(PG8_SB(0, 0), cB, voffB); PG8_STAGE(PG8_SB(0, 1), cB + hstep, voffB); PG8_STAGE(PG8_SA(0, 0), cA, voffA); PG8_STAGE(PG8_SA(0, 1), cA + hstep, voffA);
        if (wr == 1) PG8_BAR;
        PG8_WAIT_V(2); PG8_BAR;
        PG8_STAGE(PG8_SB(1, 0), cB + kstep, voffB); PG8_STAGE(PG8_SA(1, 0), cA + kstep, voffA); PG8_STAGE(PG8_SB(1, 1), cB + hstep + kstep, voffB);
        PG8_WAIT_V(6); PG8_BAR;
    } else {
        PG8_STAGE(PG8_SB(0, 0), cB, voffB); PG8_STAGE(PG8_SA(0, 0), cA, voffA); PG8_STAGE(PG8_SB(0, 1), cB + hstep, voffB); PG8_STAGE(PG8_SA(0, 1), cA + hstep, voffA);
        if (wr == 1) PG8_BAR;
        PG8_WAIT_V(4); PG8_BAR;
        PG8_STAGE(PG8_SB(1, 0), cB + kstep, voffB); PG8_STAGE(PG8_SA(1, 0), cA + kstep, voffA); PG8_STAGE(PG8_SB(1, 1), cB + hstep + kstep, voffB);
        PG8_WAIT_V(6); PG8_BAR;
    }
    for (;;) {
        const bool has_next = S.next(ui + 1, nxt);
        const char* nA = has_next ? (const char*)g.A + (size_t)nxt.pm * tstep : cA; const char* nB = has_next ? (const char*)(g.Bt + (size_t)(nxt.pm >> g.bshift) * g.bstride) + (size_t)nxt.pn * tstep : cB;
        for (int t = 0; t < nt; t += 2) {
            const bool last = (t == nt - 2);
            const char* a1 = cA + (size_t)(t + 1) * kstep;
            const char* a2 = last ? nA : cA + (size_t)(t + 2) * kstep; const char* b2 = last ? nB : cB + (size_t)(t + 2) * kstep;
            const char* a3 = a2 + kstep; const char* b3 = b2 + kstep;
            if (last && has_next) S.a_ready(nxt);
            if constexpr (SP2) {
            PG8_LDB(B0, 0, 0); PG8_LDB(B1, 0, 1); PG8_SCHED; PG8_LDA(At, 0, 0); PG8_STAGE(PG8_SA(1, 1), a1 + hstep, voffA);
            PG8_WAIT_V(8); PG8_WAIT_L(0); PG8_BAR; PG8_MMA(0, 0, At, B0); PG8_MMA(0, 1, At, B1); PG8_BAR; PG8_SCHED;
            PG8_LDA(At, 0, 1); PG8_STAGE(PG8_SB(0, 0), b2, voffB); PG8_STAGE(PG8_SB(0, 1), b2 + hstep, voffB); PG8_STAGE(PG8_SA(0, 0), a2, voffA);
            PG8_WAIT_V(8); PG8_WAIT_L(0); PG8_BAR; PG8_MMA(1, 0, At, B0); PG8_MMA(1, 1, At, B1); PG8_BAR; PG8_SCHED;
            PG8_LDB(B0, 1, 0); PG8_LDB(B1, 1, 1); PG8_SCHED; PG8_LDA(At, 1, 0); PG8_STAGE(PG8_SA(0, 1), a2 + hstep, voffA);
            PG8_WAIT_V(8); PG8_WAIT_L(0); PG8_BAR; PG8_MMA(0, 0, At, B0); PG8_MMA(0, 1, At, B1); PG8_BAR; PG8_SCHED;
            PG8_LDA(At, 1, 1); PG8_STAGE(PG8_SB(1, 0), b3, voffB); PG8_STAGE(PG8_SB(1, 1), b3 + hstep, voffB); PG8_STAGE(PG8_SA(1, 0), a3, voffA);
            PG8_WAIT_V(8); PG8_WAIT_L(0); PG8_BAR; PG8_MMA(1, 0, At, B0); PG8_MMA(1, 1, At, B1); PG8_BAR; PG8_SCHED;
            } else {
            PG8_LDB(B0, 0, 0); PG8_SCHED; PG8_LDA(At, 0, 0); PG8_STAGE(PG8_SA(1, 1), a1 + hstep, voffA);
            PG8_WAIT_L(8); PG8_BAR; PG8_WAIT_L(0); PG8_MMA(0, 0, At, B0); PG8_BAR; PG8_SCHED;
            PG8_LDB(B1, 0, 1); PG8_STAGE(PG8_SB(0, 0), b2, voffB);
            PG8_BAR; PG8_WAIT_L(0); PG8_MMA(0, 1, At, B1); PG8_BAR;
            PG8_LDA(At, 0, 1); PG8_STAGE(PG8_SA(0, 0), a2, voffA);
            PG8_BAR; PG8_WAIT_L(0); PG8_MMA(1, 0, At, B0); PG8_BAR; PG8_SCHED;
            PG8_STAGE(PG8_SB(0, 1), b2 + hstep, voffB);
            PG8_WAIT_V(6); PG8_BAR; PG8_MMA(1, 1, At, B1); PG8_BAR;
            PG8_LDB(B0, 1, 0); PG8_SCHED; PG8_LDA(At, 1, 0); PG8_STAGE(PG8_SA(0, 1), a2 + hstep, voffA);
            PG8_WAIT_L(8); PG8_BAR; PG8_WAIT_L(0); PG8_MMA(0, 0, At, B0); PG8_BAR; PG8_SCHED;
            PG8_LDB(B1, 1, 1); PG8_STAGE(PG8_SB(1, 0), b3, voffB);
            PG8_BAR; PG8_WAIT_L(0); PG8_MMA(0, 1, At, B1); PG8_BAR;
            PG8_LDA(At, 1, 1); PG8_STAGE(PG8_SA(1, 0), a3, voffA);
            PG8_BAR; PG8_WAIT_L(0); PG8_MMA(1, 0, At, B0); PG8_BAR; PG8_SCHED;
            PG8_STAGE(PG8_SB(1, 1), b3 + hstep, voffB);
            PG8_WAIT_V(6); PG8_BAR; PG8_MMA(1, 1, At, B1); PG8_BAR;
            }
        }
        if constexpr (ALIGN_EPI) { if (wr == 0) PG8_BAR; }
        if constexpr (!Epi::AFTER_DRAIN) { E(acc, cur, wr, wc, fr, fq); S.done(cur); }
        if (!has_next) break;
#pragma unroll
        for (int a = 0; a < 2; ++a)
#pragma unroll
            for (int b = 0; b < 2; ++b)
#pragma unroll
                for (int m = 0; m < 4; ++m)
#pragma unroll
                    for (int n = 0; n < 2; ++n) acc[a][b][m][n] = (f32x4){0.f, 0.f, 0.f, 0.f};
        cur = nxt; cA = nA; cB = nB; ++ui;
        if constexpr (ALIGN_EPI) { if (wr == 1) PG8_BAR; }
    }
    PG8_WAIT_V(0);
    if constexpr (!ALIGN_EPI) { if (wr == 0) PG8_BAR; }
    PG8_BAR;
    if constexpr (Epi::AFTER_DRAIN) { E.fused(acc, cur, wr, wc, fr, fq, lds, wid, lane); S.done(cur); }
#undef PG8_SA
#undef PG8_SB
#undef PG8_STAGE
#undef PG8_LDA
#undef PG8_LDB
#undef PG8_MMA
#undef PG8_WAIT_V
#undef PG8_WAIT_L
#undef PG8_BAR
#undef PG8_SCHED
}
}

constexpr int NWAVES = 8;
constexpr int BATCH = 8, SEQ = 4096, D = 1024, M = BATCH * SEQ;
constexpr int NH = 8, NKV = 2, HD = 64, AW = 512, KVW = 128, PW = 512, INW = 1280, FF = 4096, NMOD = 6;
constexpr float EPS = 1e-6f;
#ifndef MK_N_LAUNCHES
#define MK_N_LAUNCHES 1
#endif
#ifndef DUP_PHASE
#define DUP_PHASE -1
#endif
#ifndef EPI_PHASE
#define EPI_PHASE -1
#endif
#ifndef TAILCONV
#define TAILCONV 1
#endif
#ifndef OLDTR
#define OLDTR 0
#endif
#ifndef MODUNROLL
#define MODUNROLL 32
#endif
#ifndef DUP_SUB
#define DUP_SUB 7
#endif
#ifndef PERBATCH
#define PERBATCH 0
#endif
#ifndef P4ORDER
#define P4ORDER BatchOrder
#endif
constexpr int N_PHASES = 7;
constexpr int N_LAUNCHES = MK_N_LAUNCHES;

constexpr size_t MiB = 1u << 20;
constexpr size_t WS_CTL = 0, CTL_ZERO_BYTES = 64 * 1024;
constexpr size_t WS_MOD = 1 * MiB;
constexpr size_t WS_BIAS2 = 1 * MiB + 256 * 1024;
constexpr size_t WS_A2 = 1 * MiB + 512 * 1024;
constexpr size_t WS_ROPE = 2 * MiB;
constexpr size_t WS_STATS = 4 * MiB;
constexpr size_t WS_WIN = 6 * MiB, WS_WO = 9 * MiB, WS_W1 = 12 * MiB, WS_W2 = 20 * MiB;
constexpr size_t WS_XB1 = 32 * MiB;
constexpr size_t WS_H = 96 * MiB;
constexpr size_t WS_XN = 96 * MiB, WS_Q = 160 * MiB, WS_K = 192 * MiB, WS_V = 200 * MiB, WS_U = 208 * MiB, WS_MIX = 240 * MiB;
constexpr size_t WS_W1B = 352 * MiB;
constexpr size_t WS_Z2 = 416 * MiB;
constexpr size_t WS_END = 480 * MiB;
constexpr int CW_BAR = 1024;

constexpr int LDS_BYTES = 160 * 1024;
constexpr int MISC_OFF = LDS_BYTES - 256;
constexpr int ATT_K = 0, ATT_V = 24576, ATT_WS = 49152, ATT_OST = ATT_WS + NWAVES * 256, ATT_END = ATT_OST + NWAVES * 4096;

#define GAS __attribute__((address_space(1)))
#define LAS __attribute__((address_space(3)))
typedef unsigned short bf16;
typedef unsigned v4u __attribute__((ext_vector_type(4)));
typedef float f32x4 __attribute__((ext_vector_type(4)));
typedef short bf16x8 __attribute__((ext_vector_type(8)));
typedef GAS unsigned gu32;
typedef GAS unsigned long long gu64;
#define RLX_AGENT __ATOMIC_RELAXED, __HIP_MEMORY_SCOPE_AGENT
#define LDS_WAIT() asm volatile("s_waitcnt lgkmcnt(0)" ::: "memory")
#define VM_WAIT() asm volatile("s_waitcnt vmcnt(0)" ::: "memory")
__device__ __forceinline__ unsigned long long rt() { return __builtin_amdgcn_s_memrealtime(); }
__device__ __forceinline__ unsigned f2bf(float f) { unsigned u = __builtin_bit_cast(unsigned, f); return (u + 0x7fffu + ((u >> 16) & 1u)) >> 16; }
__device__ __forceinline__ unsigned pk2(float lo, float hi) { return f2bf(lo) | (f2bf(hi) << 16); }

#define XB_TMO      128
#define XB_XCNT(j)  (256  + 64 * (j))
#define XB_XSUB(j)  (1280 + 64 * (j))
#define XB_XGEN(j)  (2304 + 64 * (j))
#define XB_TOP      3328
#define XB_TOPGEN   3392
#define XCD_BAR_WORDS 3456
#define XB_SPIN_CAP (1u << 18)

__device__ __forceinline__ unsigned xb_ld(unsigned* p)              { return __hip_atomic_load(p, __ATOMIC_RELAXED, __HIP_MEMORY_SCOPE_AGENT); }
__device__ __forceinline__ unsigned xb_add(unsigned* p, unsigned v) { return __hip_atomic_fetch_add(p, v, __ATOMIC_RELAXED, __HIP_MEMORY_SCOPE_AGENT); }
__device__ __forceinline__ unsigned xb_xcc_id() { return (unsigned)__builtin_amdgcn_s_getreg((3 << 11) | 20) & 0xFu; }
#define XB_SPIN(cond, bar) do { unsigned _sp = 0; while (cond) { __builtin_amdgcn_s_sleep(1); \
    if ((++_sp & 255u) == 0u) { if (xb_ld(&(bar)[XB_TMO])) break; if (_sp > XB_SPIN_CAP) { atomicAdd(&(bar)[XB_TMO], 1u); break; } } } } while (0)

struct XcdBarrier {
    unsigned* bar; unsigned x;
    volatile LAS unsigned* st;
};

__device__ __forceinline__ XcdBarrier xcd_barrier_post(unsigned* bar, volatile LAS unsigned* st) {
    XcdBarrier b; b.bar = bar; b.x = xb_xcc_id(); b.st = st;
    if (threadIdx.x == 0) (void)xb_add(&bar[XB_XCNT(b.x)], 1u);
    return b;
}
__device__ __forceinline__ void xcd_barrier_complete(unsigned* bar, unsigned x, unsigned& nloc, unsigned& nx) {
    const unsigned G = gridDim.x * gridDim.y * gridDim.z;
    unsigned sum, cnt, mine, sp = 0u;
    for (;;) {
        sum = 0u; cnt = 0u; mine = 0u;
#pragma unroll
        for (unsigned j = 0; j < 16; ++j) { const unsigned c = xb_ld(&bar[XB_XCNT(j)]); sum += c; cnt += (c > 0u) ? 1u : 0u; mine = (j == x) ? c : mine; }
        if (sum == G) break;
        __builtin_amdgcn_s_sleep(1);
        if ((++sp & 255u) == 0u) { if (xb_ld(&bar[XB_TMO])) break; if (sp > XB_SPIN_CAP) { atomicAdd(&bar[XB_TMO], 1u); break; } }
    }
    nloc = mine > 0u ? mine : 1u; nx = cnt > 0u ? cnt : 1u;
}

__device__ __forceinline__ void xcd_barrier(const XcdBarrier& b) {
    asm volatile("s_waitcnt vmcnt(0)" ::: "memory");
    __syncthreads();
    if (threadIdx.x == 0) {
        unsigned* bar = b.bar;
        __builtin_amdgcn_s_waitcnt(0);
        unsigned nloc = b.st[0], nx = b.st[1];
        if (nloc == 0u) { xcd_barrier_complete(bar, b.x, nloc, nx); b.st[0] = nloc; b.st[1] = nx; }
        const unsigned old = xb_add(&bar[XB_XSUB(b.x)], 1u);
        const unsigned gen = old / nloc;
        if (old + 1u == (gen + 1u) * nloc) {
            __builtin_amdgcn_fence(__ATOMIC_RELEASE, "agent");
            asm volatile("s_waitcnt vmcnt(0)" ::: "memory");
            const unsigned og = xb_add(&bar[XB_TOP], 1u);
            const unsigned tg = og / nx;
            if (og + 1u == (tg + 1u) * nx) xb_add(&bar[XB_TOPGEN], 1u);
            else XB_SPIN(xb_ld(&bar[XB_TOPGEN]) == tg, bar);
            __builtin_amdgcn_fence(__ATOMIC_ACQUIRE, "agent");
            xb_add(&bar[XB_XGEN(b.x)], 1u);
            asm volatile("s_waitcnt vmcnt(0)" ::: "memory");
        } else {
            XB_SPIN(xb_ld(&bar[XB_XGEN(b.x)]) == gen, bar);
            __builtin_amdgcn_fence(__ATOMIC_ACQUIRE, "agent");
            asm volatile("s_waitcnt vmcnt(0)" ::: "memory");
        }
    }
    __syncthreads();
}

typedef float f32x16 __attribute__((ext_vector_type(16)));
typedef short s16x4 __attribute__((ext_vector_type(4)));
struct Frame {
    LAS unsigned char* lds;
    int tid, lane, wave, vcu, G;
};
__device__ __forceinline__ float wave_sum(float v) {
#pragma unroll
    for (int o = 1; o < 64; o <<= 1) v += __shfl_xor(v, o);
    return v;
}
__device__ __forceinline__ float bf2f(unsigned short h) { return __builtin_bit_cast(float, (unsigned)h << 16); }
__device__ __forceinline__ float bflo(unsigned w) { return __builtin_bit_cast(float, w << 16); }
__device__ __forceinline__ float bfhi(unsigned w) { return __builtin_bit_cast(float, w & 0xffff0000u); }

__device__ __forceinline__ void p0_transpose_item(const float* W, int N, bf16* WT, int Kd, int k0, int n0, int dst_row0, LAS float* scr, int lane) {
#if OLDTR
#pragma unroll 8
    for (int i = 0; i < 32; ++i) { const int kk = 2 * i + (lane >> 5); scr[kk * 33 + (lane & 31)] = W[(size_t)(k0 + kk) * N + n0 + (lane & 31)]; }
#else
    f32x4 v[8];
#pragma unroll
    for (int i = 0; i < 8; ++i) v[i] = *(const GAS f32x4*)(W + (size_t)(k0 + 8 * i + (lane >> 3)) * N + n0 + 4 * (lane & 7));
#pragma unroll
    for (int i = 0; i < 8; ++i) { LAS float* d = scr + (8 * i + (lane >> 3)) * 33 + 4 * (lane & 7); d[0] = v[i][0]; d[1] = v[i][1]; d[2] = v[i][2]; d[3] = v[i][3]; }
#endif
    LDS_WAIT(); asm volatile("" ::: "memory");
    const int c = lane & 7;
#pragma unroll
    for (int j = 0; j < 4; ++j) { const int n = (lane >> 3) + 8 * j; const LAS float* s = scr + (8 * c) * 33 + n;
        v4u o; o.x = pk2(s[0 * 33], s[1 * 33]); o.y = pk2(s[2 * 33], s[3 * 33]); o.z = pk2(s[4 * 33], s[5 * 33]); o.w = pk2(s[6 * 33], s[7 * 33]);
        *(GAS v4u*)(WT + (size_t)(dst_row0 + n) * Kd + k0 + 8 * c) = o; }
    LDS_WAIT(); asm volatile("" ::: "memory");
}
__device__ __forceinline__ int win_slot(int n) { const int pn = n >> 8, r = n & 255; return 256 * pn + 128 * ((r >> 5) & 1) + 32 * (r >> 6) + (r & 31); }

struct Ptrs {
    const float *x, *c, *w_ada, *b_ada, *norm1_g, *w_in, *q_norm_g, *k_norm_g, *sinks, *pool_w, *pool_scale, *w_o, *norm2_g, *w1, *w2; const int* positions;
    float *out, *mod, *bias2, *a2, *rope, *stats; bf16 *Win_t, *Wo_t, *W1b, *W2_t, *XN, *Q, *K, *V, *U, *MIX, *XB1, *H, *Z2;
};

template <bool SILU> __device__ __forceinline__ void skinny_task(Frame& F, const float* src, int spitch, const float* W, int wpitch, const float* bias, float* out, int opitch, int t) {
    LAS float* vT = (LAS float*)F.lds;
    LAS float* red = (LAS float*)(F.lds + 65536);
    { float cv[16];
#pragma unroll
      for (int i = 0; i < 16; ++i) { const int idx = F.tid + 512 * i; cv[i] = src[(size_t)(idx >> 10) * spitch + (idx & 1023)]; }
#pragma unroll
      for (int i = 0; i < 16; ++i) { const int idx = F.tid + 512 * i, b = idx >> 10, k = idx & 1023; vT[k * 16 + b] = SILU ? cv[i] / (1.f + __expf(-cv[i])) : cv[i]; vT[k * 16 + 8 + b] = 0.f; } }
    __syncthreads();
    const int j0 = 64 * t, kb = 128 * F.wave, kq = F.lane >> 4, jl = F.lane & 15;
    f32x4 acc[4];
#pragma unroll
    for (int e = 0; e < 4; ++e) acc[e] = (f32x4){0.f, 0.f, 0.f, 0.f};
    const GAS float* wp = (const GAS float*)W + (size_t)(kb + kq) * wpitch + j0 + 4 * jl;
#pragma unroll
    for (int s0 = 0; s0 < 32; s0 += 16) {
        f32x4 wv[16];
#pragma unroll
        for (int s = 0; s < 16; ++s) wv[s] = *(const GAS f32x4*)(wp + (size_t)(4 * (s0 + s)) * wpitch);
#pragma unroll
        for (int s = 0; s < 16; ++s) { const float a = vT[(kb + 4 * (s0 + s) + kq) * 16 + jl];
#pragma unroll
            for (int e = 0; e < 4; ++e) acc[e] = __builtin_amdgcn_mfma_f32_16x16x4f32(a, wv[s][e], acc[e], 0, 0, 0); }
    }
    if (F.lane < 32) {
#pragma unroll
        for (int e = 0; e < 4; ++e)
#pragma unroll
            for (int r = 0; r < 4; ++r) red[((F.wave * 4 + e) * 4 + r) * 32 + F.lane] = acc[e][r];
    }
    __syncthreads();
    { const int b = F.tid >> 6, col = F.tid & 63, e = col & 3, lane = (b >> 2) * 16 + (col >> 2), r = b & 3; float sum = 0.f;
#pragma unroll
      for (int w = 0; w < NWAVES; ++w) sum += red[((w * 4 + e) * 4 + r) * 32 + lane];
      out[(size_t)b * opitch + j0 + col] = sum + (bias ? bias[j0 + col] : 0.f); }
    __syncthreads();
}
__device__ __forceinline__ void p0_fold_task(Frame& F, const Ptrs& P, int t) {
    const int g = t >> 5, n0 = (t & 31) * 32;
    LAS float* Pm = (LAS float*)F.lds;
    LAS float* Wm = (LAS float*)(F.lds + 128 * 129 * 4);
    { float pv[32], wv[8];
#pragma unroll
      for (int i = 0; i < 32; ++i) pv[i] = P.pool_w[(size_t)g * 16384 + F.tid + 512 * i];
#pragma unroll
      for (int i = 0; i < 8; ++i) { const int idx = F.tid + 512 * i; wv[i] = P.w_o[(size_t)(512 + 128 * g + (idx >> 5)) * D + n0 + (idx & 31)]; }
      const float sc = P.pool_scale[128 * g + (F.tid & 127)];
#pragma unroll
      for (int i = 0; i < 32; ++i) { const int idx = F.tid + 512 * i; Pm[(idx >> 7) * 129 + (idx & 127)] = pv[i] * sc; }
#pragma unroll
      for (int i = 0; i < 8; ++i) { const int idx = F.tid + 512 * i; Wm[(idx >> 5) * 33 + (idx & 31)] = wv[i]; } }
    __syncthreads();
    const int c = F.tid & 127, q = F.tid >> 7;
    float acc[8];
#pragma unroll
    for (int i = 0; i < 8; ++i) acc[i] = 0.f;
#pragma unroll 4
    for (int d = 0; d < 128; ++d) { const float p = Pm[c * 129 + d];
#pragma unroll
        for (int i = 0; i < 8; ++i) acc[i] += p * Wm[d * 33 + q + 4 * i]; }
#pragma unroll
    for (int i = 0; i < 8; ++i) P.Wo_t[(size_t)(n0 + q + 4 * i) * D + 512 + 128 * g + c] = (bf16)f2bf(acc[i]);
    __syncthreads();
}
__device__ __forceinline__ void p0a_prologue(Frame& F, const Ptrs& P) {
    for (int t = F.vcu; t < 96 + 128; t += F.G) { if (t < 96) skinny_task<true>(F, P.c, D, P.w_ada, NMOD * D, P.b_ada, P.mod, NMOD * D, t); else p0_fold_task(F, P, t - 96); }
    LAS float* scr = (LAS float*)(F.lds + F.wave * 16384);
    const int gw = F.vcu * NWAVES + F.wave, NGW = F.G * NWAVES;
    constexpr int I_IN = (D / 64) * (INW / 32), I_O = (AW / 64) * (D / 32), I_2 = (FF / 64) * (D / 32);
    for (int it = gw; it < I_IN + I_O + I_2; it += NGW) {
        int r = it;
        if (r < I_IN) { const int nblk = INW / 32, kb = r / nblk, nb = r % nblk; p0_transpose_item(P.w_in, INW, P.Win_t, D, 64 * kb, 32 * nb, win_slot(32 * nb), scr, F.lane); continue; } r -= I_IN;
        if (r < I_O) { const int nblk = D / 32, kb = r / nblk, nb = r % nblk; p0_transpose_item(P.w_o, D, P.Wo_t, D, 64 * kb, 32 * nb, 32 * nb, scr, F.lane); continue; } r -= I_O;
        { const int nblk = D / 32, kb = r / nblk, nb = r % nblk; p0_transpose_item(P.w2, D, P.W2_t, FF, 64 * kb, 32 * nb, 32 * nb, scr, F.lane); }
    }
    for (int idx = (F.vcu * NWAVES * 64 + F.tid); idx < M * 8; idx += F.G * NWAVES * 64) {
        const int m = idx >> 3, i = idx & 7;
        const float inv_freq = (i == 0) ? 1.0f : (i == 1) ? 0.1939227432012558f : (i == 2) ? 0.03760603070259094f : (i == 3) ? 0.007292664609849453f : (i == 4) ? 0.0014142135623842478f : (i == 5) ? 0.00027424818836152554f : (i == 6) ? 5.3182957344688475e-05f : 1.0313385246263351e-05f;
        const float ang = (float)P.positions[m] * inv_freq;
        P.rope[(size_t)m * 16 + i] = (float)cos((double)ang); P.rope[(size_t)m * 16 + 8 + i] = (float)sin((double)ang);
    }
}

__device__ __forceinline__ void p1_w1_item(const float* W, bf16* W1b, const float* a2, int k0, int n0, LAS float* scr, int lane) {
    f32x4 v[8];
#pragma unroll
    for (int i = 0; i < 8; ++i) v[i] = *(const GAS f32x4*)(W + (size_t)(k0 + 8 * i + (lane >> 3)) * FF + n0 + 4 * (lane & 7));
#pragma unroll
    for (int i = 0; i < 8; ++i) { LAS float* d = scr + (8 * i + (lane >> 3)) * 33 + 4 * (lane & 7); d[0] = v[i][0]; d[1] = v[i][1]; d[2] = v[i][2]; d[3] = v[i][3]; }
    LDS_WAIT(); asm volatile("" ::: "memory");
    const int c = lane & 7;
    float w[4][8];
#pragma unroll
    for (int j = 0; j < 4; ++j) { const LAS float* s = scr + (8 * c) * 33 + (lane >> 3) + 8 * j;
#pragma unroll
        for (int q = 0; q < 8; ++q) w[j][q] = s[q * 33]; }
#pragma unroll
    for (int b = 0; b < BATCH; ++b) {
        const f32x4 a0 = *(const f32x4*)(a2 + (size_t)b * D + k0 + 8 * c), a1 = *(const f32x4*)(a2 + (size_t)b * D + k0 + 8 * c + 4);
#pragma unroll
        for (int j = 0; j < 4; ++j) { const int n = (lane >> 3) + 8 * j;
            v4u o; o.x = pk2(w[j][0] * a0[0], w[j][1] * a0[1]); o.y = pk2(w[j][2] * a0[2], w[j][3] * a0[3]); o.z = pk2(w[j][4] * a1[0], w[j][5] * a1[1]); o.w = pk2(w[j][6] * a1[2], w[j][7] * a1[3]);
            *(GAS v4u*)(W1b + (size_t)b * FF * D + (size_t)(n0 + n) * D + k0 + 8 * c) = o; }
    }
    LDS_WAIT(); asm volatile("" ::: "memory");
}
__device__ __forceinline__ void p1_tail_convert(Frame& F, const Ptrs& P, int ord, int cnt) {
    LAS float* scr = (LAS float*)(F.lds + F.wave * 16384);
    constexpr int I_1 = (D / 64) * (FF / 32);
    for (int it = ord * NWAVES + F.wave; it < I_1; it += cnt * NWAVES) { const int nblk = FF / 32, kb = it / nblk, nb = it % nblk;
        if (PERBATCH) p1_w1_item(P.w1, P.W1b, P.a2, 64 * kb, 32 * nb, scr, F.lane); else p0_transpose_item(P.w1, FF, P.W1b, D, 64 * kb, 32 * nb, 32 * nb, scr, F.lane); }
}

__device__ __forceinline__ void p0b_norm(Frame& F, const Ptrs& P) {
    const int gt = F.vcu * NWAVES * 64 + F.tid, NGT = F.G * NWAVES * 64;
    for (int i = gt; i < BATCH * D; i += NGT) { const int b = i >> 10, col = i & 1023; P.a2[i] = P.norm2_g[col] * (1.f + P.mod[(size_t)b * NMOD * D + 4 * D + col]); }
    for (int t = F.G - 1 - F.vcu; t < FF / 64; t += F.G) skinny_task<false>(F, P.mod + 3 * D, NMOD * D, P.w1, FF, nullptr, P.bias2, FF, t);
    const int gw = F.vcu * NWAVES + F.wave, NGW = F.G * NWAVES;
    for (int rb = gw; rb < M / 16; rb += NGW) {
        const int b = (rb * 16) / SEQ; const float* mb = P.mod + (size_t)b * NMOD * D;
        f32x4 av[4], sv[4];
#pragma unroll
        for (int j = 0; j < 4; ++j) { const int col = 256 * j + 4 * F.lane; const f32x4 g = *(const f32x4*)(P.norm1_g + col), sc = *(const f32x4*)(mb + D + col); av[j] = g * (sc + 1.0f); sv[j] = *(const f32x4*)(mb + col); }
        for (int rr = 0; rr < 16; rr += 4) {
            f32x4 v[4][4]; float s[4];
#pragma unroll
            for (int q = 0; q < 4; ++q) { const GAS f32x4* xr = (const GAS f32x4*)(P.x + (size_t)(rb * 16 + rr + q) * D) + F.lane;
#pragma unroll
                for (int j = 0; j < 4; ++j) v[q][j] = xr[64 * j]; }
#pragma unroll
            for (int q = 0; q < 4; ++q) { float t = 0.f;
#pragma unroll
                for (int j = 0; j < 4; ++j) t += (v[q][j][0] * v[q][j][0] + v[q][j][1] * v[q][j][1]) + (v[q][j][2] * v[q][j][2] + v[q][j][3] * v[q][j][3]);
                s[q] = t; }
#pragma unroll
            for (int o = 1; o < 64; o <<= 1) {
#pragma unroll
                for (int q = 0; q < 4; ++q) s[q] += __shfl_xor(s[q], o); }
#pragma unroll
            for (int q = 0; q < 4; ++q) { const float r = rsqrtf(s[q] * (1.f / D) + EPS);
                GAS unsigned long long* o8 = (GAS unsigned long long*)(P.XN + (size_t)(rb * 16 + rr + q) * D) + F.lane;
#pragma unroll
                for (int j = 0; j < 4; ++j) { const f32x4 y = v[q][j] * r * av[j] + sv[j]; o8[64 * j] = (unsigned long long)pk2(y[0], y[1]) | ((unsigned long long)pk2(y[2], y[3]) << 32); } }
        }
    }
}
__device__ __forceinline__ int crow(int r, int hi) { return (r & 3) + 8 * (r >> 2) + 4 * hi; }
__device__ __forceinline__ unsigned cvtpk(float lo, float hi) { unsigned r; asm volatile("v_cvt_pk_bf16_f32 %0, %1, %2" : "=v"(r) : "v"(lo), "v"(hi)); return r; }
typedef short v4i16_t __attribute__((ext_vector_type(4)));
__device__ __forceinline__ s16x4 vtr(LAS const unsigned char* p) { return __builtin_bit_cast(s16x4, __builtin_amdgcn_ds_read_tr16_b64_v4i16((LAS v4i16_t*)p)); }

struct AttnRegs { v4u k[3], v[3]; bf16x8 q[4]; };
__device__ __forceinline__ void attn_load(Frame& F, const Ptrs& P, int unit, AttnRegs& R) {
    const int lane = F.lane, wid = F.wave, r32 = lane & 31, hi = lane >> 5;
    const int bk = unit >> 6, qb = unit & 63, b = bk >> 1, kvh = bk & 1, wh = wid & 1, hq = kvh * 4 + (wid >> 1);
    const long rowbase = (long)b * SEQ; const int q0 = qb * 64, kv0 = q0 - 128, qw0 = q0 + 32 * wh;
#pragma unroll
    for (int i = 0; i < 3; ++i) { const int kvr = kv0 + 64 * i + lane, kc = kvr < 0 ? 0 : kvr; const v4u t = *(const GAS v4u*)(P.K + (rowbase + kc) * KVW + kvh * 64 + wid * 8); const unsigned mk = kvr < 0 ? 0u : 0xffffffffu; R.k[i] = (v4u){t.x & mk, t.y & mk, t.z & mk, t.w & mk}; }
#pragma unroll
    for (int i = 0; i < 3; ++i) { const int kvr = kv0 + 64 * i + 16 * (wid & 3) + (lane >> 2), kc = kvr < 0 ? 0 : kvr; const v4u t = *(const GAS v4u*)(P.V + (rowbase + kc) * KVW + kvh * 64 + (wid >> 2) * 32 + (lane & 3) * 8); const unsigned mk = kvr < 0 ? 0u : 0xffffffffu; R.v[i] = (v4u){t.x & mk, t.y & mk, t.z & mk, t.w & mk}; }
    const bf16* Qw = P.Q + (rowbase + qw0 + r32) * AW + hq * 64 + hi * 8;
#pragma unroll
    for (int d0 = 0; d0 < 4; ++d0) R.q[d0] = *(const GAS bf16x8*)(Qw + d0 * 16);
}
__device__ __forceinline__ void attn_compute(Frame& F, const Ptrs& P, int unit, const bf16x8 (&qr)[4]) {
    const int lane = F.lane, wid = F.wave, r32 = lane & 31, hi = lane >> 5;
    const int bk = unit >> 6, qb = unit & 63, b = bk >> 1, kvh = bk & 1, wh = wid & 1, hq = kvh * 4 + (wid >> 1);
    const long rowbase = (long)b * SEQ; const int q0 = qb * 64, qw0 = q0 + 32 * wh;
    LAS unsigned char* lds = F.lds;
    f32x16 p[5];
#pragma unroll
    for (int j = 0; j < 5; ++j) {
        const int hb = wh + j; const LAS unsigned char* kp = lds + ATT_K + (hb >> 1) * 8192 + hi * 1024 + ((hb & 1) * 32 + r32) * 16;
        f32x16 a = {0.f, 0.f, 0.f, 0.f, 0.f, 0.f, 0.f, 0.f, 0.f, 0.f, 0.f, 0.f, 0.f, 0.f, 0.f, 0.f};
#pragma unroll
        for (int d0 = 0; d0 < 4; ++d0) { const bf16x8 kf = *(const LAS bf16x8*)(kp + d0 * 2048); a = __builtin_amdgcn_mfma_f32_32x32x16_bf16(kf, qr[d0], a, 0, 0, 0); }
        p[j] = a;
    }
    const float NEG = -INFINITY;
#pragma unroll
    for (int j = 0; j < 5; ++j) {
        const bool valid = (qw0 - 128 + 32 * j) >= 0;
#pragma unroll
        for (int r = 0; r < 16; ++r) { bool keep = valid; if (j == 0) keep = keep && (crow(r, hi) > r32); if (j == 4) keep = keep && (crow(r, hi) <= r32); if (!keep) p[j][r] = NEG; }
    }
    const float sinkl2 = P.sinks[hq] * 1.4426950408889634f;
    float mx = sinkl2;
#pragma unroll
    for (int j = 0; j < 5; ++j)
#pragma unroll
        for (int r = 0; r < 16; ++r) mx = fmaxf(mx, p[j][r]);
    { auto rr = __builtin_amdgcn_permlane32_swap(__float_as_uint(mx), __float_as_uint(mx), false, false); mx = fmaxf(__uint_as_float(rr[0]), __uint_as_float(rr[1])); }
    float l = 0.f;
#pragma unroll
    for (int j = 0; j < 5; ++j)
#pragma unroll
        for (int r = 0; r < 16; ++r) { const float e = __builtin_amdgcn_exp2f(p[j][r] - mx); p[j][r] = e; l += e; }
    { auto rr = __builtin_amdgcn_permlane32_swap(__float_as_uint(l), __float_as_uint(l), false, false); l = __uint_as_float(rr[0]) + __uint_as_float(rr[1]); }
    l += __builtin_amdgcn_exp2f(sinkl2 - mx);
    f32x16 o[2];
    o[0] = (f32x16){0.f, 0.f, 0.f, 0.f, 0.f, 0.f, 0.f, 0.f, 0.f, 0.f, 0.f, 0.f, 0.f, 0.f, 0.f, 0.f}; o[1] = o[0];
    const LAS unsigned char* vb = lds + ATT_V + ((lane >> 4) & 1) * 32 + (lane & 3) * 8 + (4 * hi + ((lane & 15) >> 2)) * 64;
#pragma unroll
    for (int j = 0; j < 5; ++j) {
        const int hb = wh + j; const LAS unsigned char* vt = vb + (hb >> 1) * 8192 + (hb & 1) * 2048;
#pragma unroll
        for (int s = 0; s < 2; ++s) {
            v4u pw; pw.x = cvtpk(p[j][8 * s + 0], p[j][8 * s + 1]); pw.y = cvtpk(p[j][8 * s + 2], p[j][8 * s + 3]); pw.z = cvtpk(p[j][8 * s + 4], p[j][8 * s + 5]); pw.w = cvtpk(p[j][8 * s + 6], p[j][8 * s + 7]);
            const bf16x8 pf = __builtin_bit_cast(bf16x8, pw);
#pragma unroll
            for (int d0 = 0; d0 < 2; ++d0) {
                const s16x4 lo = vtr(vt + d0 * 4096 + s * 1024), hh = vtr(vt + d0 * 4096 + s * 1024 + 512);
                const bf16x8 vf = (bf16x8){lo[0], lo[1], lo[2], lo[3], hh[0], hh[1], hh[2], hh[3]};
                o[d0] = __builtin_amdgcn_mfma_f32_32x32x16_bf16(pf, vf, o[d0], 0, 0, 0);
            }
        }
    }
    LAS float* wsf = (LAS float*)(lds + ATT_WS) + wid * 64;
    if (hi == 0) wsf[r32] = l;
    LDS_WAIT(); asm volatile("" ::: "memory");
    float rli[16];
#pragma unroll
    for (int r = 0; r < 16; ++r) rli[r] = __builtin_amdgcn_rcpf(wsf[crow(r, hi)]);
    LAS bf16* stg = (LAS bf16*)(lds + ATT_OST) + wid * 2048;
#pragma unroll
    for (int r = 0; r < 16; ++r) { const int orow = crow(r, hi);
#pragma unroll
        for (int d0 = 0; d0 < 2; ++d0) stg[orow * 64 + d0 * 32 + r32] = (bf16)f2bf(o[d0][r] * rli[r]); }
    LDS_WAIT(); asm volatile("" ::: "memory");
    bf16* Ow = P.MIX + (rowbase + qw0) * D + hq * 64;
#pragma unroll
    for (int i = 0; i < 4; ++i) { const int row = i * 8 + (lane >> 3), ch = lane & 7; const v4u v = *(const LAS v4u*)(stg + row * 64 + ch * 8); *(GAS v4u*)(Ow + (size_t)row * D + ch * 8) = v; }
}
__device__ __forceinline__ void unpack8(const v4u w, float (&f)[8]) { f[0] = bflo(w.x); f[1] = bfhi(w.x); f[2] = bflo(w.y); f[3] = bfhi(w.y); f[4] = bflo(w.z); f[5] = bfhi(w.z); f[6] = bflo(w.w); f[7] = bfhi(w.w); }
template <int W> __device__ __forceinline__ void pool_task_w(Frame& F, const Ptrs& P, int g, int rb) {
    const int ch = F.lane & 15, run = F.lane >> 4;
    const int t0 = (rb * 64 + run * 16) & (SEQ - 1);
    const GAS char* ub = (const GAS char*)(P.U + (size_t)(rb * 64) * PW + g * 128);
    GAS char* ob = (GAS char*)(P.MIX + (size_t)(rb * 64) * D + AW + g * 128);
    const unsigned loff = (unsigned)((run * 16 * PW + ch * 8) * 2), ooff = (unsigned)((run * 16 * D + ch * 8) * 2);
    v4u cur[16], prev[W];
#pragma unroll
    for (int i = 0; i < 16; ++i) cur[i] = *(const GAS v4u*)(ub + (size_t)i * (PW * 2) + loff);
#pragma unroll
    for (int j = 1; j <= W; ++j) { const bool ok = (t0 - j) >= 0; const v4u t = *(const GAS v4u*)(ub + loff - (ok ? (size_t)j * (PW * 2) : (size_t)0)); const unsigned mk = ok ? 0xffffffffu : 0u; prev[j - 1] = (v4u){t.x & mk, t.y & mk, t.z & mk, t.w & mk}; }
    float S[8];
#pragma unroll
    for (int e = 0; e < 8; ++e) S[e] = 0.f;
#pragma unroll
    for (int j = 1; j <= W; ++j) { float f[8]; unpack8(prev[j - 1], f);
#pragma unroll
        for (int e = 0; e < 8; ++e) S[e] += f[e]; }
#pragma unroll
    for (int i = 0; i < 16; ++i) {
        const int t = t0 + i; float u[8]; unpack8(cur[i], u);
        float f[8]; unpack8(i < W ? prev[(W - 1 - i) >= 0 ? (W - 1 - i) : 0] : cur[(i - W) >= 0 ? (i - W) : 0], f);
#pragma unroll
        for (int e = 0; e < 8; ++e) S[e] += u[e] - f[e];
        const float inv = 1.0f / (float)((t + 1) < W ? (t + 1) : W);
        v4u o; o.x = pk2(S[0] * inv - u[0], S[1] * inv - u[1]); o.y = pk2(S[2] * inv - u[2], S[3] * inv - u[3]); o.z = pk2(S[4] * inv - u[4], S[5] * inv - u[5]); o.w = pk2(S[6] * inv - u[6], S[7] * inv - u[7]);
        *(GAS v4u*)(ob + (size_t)i * (D * 2) + ooff) = o;
    }
}
__device__ __forceinline__ void pool_task(Frame& F, const Ptrs& P, int task) {
    const int g = task & 3, rb = task >> 2;
    if (g == 0) pool_task_w<2>(F, P, 0, rb); else if (g == 1) pool_task_w<4>(F, P, 1, rb); else if (g == 2) pool_task_w<8>(F, P, 2, rb); else pool_task_w<16>(F, P, 3, rb);
}
__device__ __forceinline__ void p2_attn_pool(Frame& F, const Ptrs& P, int sub) {
    constexpr int NUNITS = BATCH * NKV * (SEQ / 64);
    const int upw = (NUNITS + F.G - 1) / F.G, first = F.vcu * upw;
    int n = NUNITS - first; n = n < 0 ? 0 : (n > upw ? upw : n);
    if (!(sub & 1)) n = 0;
    AttnRegs R;
    if (n > 0) attn_load(F, P, first, R);
    for (int i = 0; i < n; ++i) {
        bf16x8 qr[4];
#pragma unroll
        for (int d0 = 0; d0 < 4; ++d0) qr[d0] = R.q[d0];
#pragma unroll
        for (int t = 0; t < 3; ++t) { *(LAS v4u*)(F.lds + ATT_K + t * 8192 + F.wave * 1024 + F.lane * 16) = R.k[t]; *(LAS v4u*)(F.lds + ATT_V + t * 8192 + F.wave * 1024 + F.lane * 16) = R.v[t]; }
        __syncthreads();
        if (i + 1 < n) attn_load(F, P, first + i + 1, R);
        attn_compute(F, P, first + i, qr);
        __syncthreads();
    }
    const int gw = F.vcu * NWAVES + F.wave, NGW = F.G * NWAVES;
    if (sub & 2) for (int t = gw; t < 4 * (M / 64); t += NGW) pool_task(F, P, t);
}

struct Args { const void* in[16]; float* out; unsigned char* ws; int ph_lo, ph_hi, sub, pad; };
__global__ void __launch_bounds__(NWAVES * 64, 2) fwd_megakernel(Args args) {
    extern __shared__ __attribute__((aligned(16))) unsigned char lds[];
    Frame F;
    F.lds = (LAS unsigned char*)lds;
    F.tid = threadIdx.x; F.lane = F.tid & 63; F.wave = __builtin_amdgcn_readfirstlane(F.tid >> 6);
    F.G = gridDim.x; { const int bx = blockIdx.x; F.vcu = (F.G % 8 == 0) ? (bx % 8) * (F.G / 8) + bx / 8 : bx; }
    unsigned char* ws = args.ws;
    Ptrs P;
    P.x = (const float*)args.in[0]; P.c = (const float*)args.in[1]; P.positions = (const int*)args.in[2]; P.w_ada = (const float*)args.in[3]; P.b_ada = (const float*)args.in[4];
    P.norm1_g = (const float*)args.in[5]; P.w_in = (const float*)args.in[6]; P.q_norm_g = (const float*)args.in[7]; P.k_norm_g = (const float*)args.in[8]; P.sinks = (const float*)args.in[9];
    P.pool_w = (const float*)args.in[10]; P.pool_scale = (const float*)args.in[11]; P.w_o = (const float*)args.in[12]; P.norm2_g = (const float*)args.in[13]; P.w1 = (const float*)args.in[14]; P.w2 = (const float*)args.in[15];
    P.out = args.out; P.mod = (float*)(ws + WS_MOD); P.bias2 = (float*)(ws + WS_BIAS2); P.a2 = (float*)(ws + WS_A2); P.rope = (float*)(ws + WS_ROPE); P.stats = (float*)(ws + WS_STATS);
    P.Win_t = (bf16*)(ws + WS_WIN); P.Wo_t = (bf16*)(ws + WS_WO); P.W1b = (bf16*)(ws + WS_W1B); P.W2_t = (bf16*)(ws + WS_W2);
    P.XN = (bf16*)(ws + WS_XN); P.Q = (bf16*)(ws + WS_Q); P.K = (bf16*)(ws + WS_K); P.V = (bf16*)(ws + WS_V); P.U = (bf16*)(ws + WS_U); P.MIX = (bf16*)(ws + WS_MIX); P.XB1 = (bf16*)(ws + WS_XB1); P.Z2 = (bf16*)(ws + WS_Z2); P.H = (bf16*)(ws + WS_H);
    volatile LAS unsigned* MISC = (volatile LAS unsigned*)(F.lds + MISC_OFF);
    if (F.tid < 64) MISC[F.tid] = 0u;
    __syncthreads();
    XcdBarrier bar; bar.bar = (unsigned*)(ws + WS_CTL) + CW_BAR; bar.x = 0; bar.st = nullptr;
    if (N_LAUNCHES == 1) bar = xcd_barrier_post((unsigned*)(ws + WS_CTL) + CW_BAR, MISC + 8);
    const int lo = args.ph_lo, hi = args.ph_hi;
#define IN(k) (lo <= (k) && (k) < hi)
#define SEAM(k) do { if (IN(k) && IN((k) + 1)) xcd_barrier(bar); } while (0)

    if (IN(0)) { p0a_prologue(F, P); SEAM(0); }
    if (IN(1)) { p0b_norm(F, P); SEAM(1); }
    if (IN(2)) {
        pg8::Gemm g{P.XN, P.Win_t, M, INW, D, 0, 0}; pg8::StaticOrder S; S.init(M, INW, F.G, (int)blockIdx.x);
        pg8::EpiProj E{P.Q, P.K, P.V, P.U, P.rope, P.q_norm_g, P.k_norm_g};
        pg8::gemm_phase<pg8::EpiProj, pg8::StaticOrder, true, true>(F.lds, g, S, E);
        { const int nwg = (M / 256) * (INW / 256), rem = nwg % F.G;
          if (rem == 0) p1_tail_convert(F, P, (int)blockIdx.x, F.G); else if ((int)blockIdx.x >= rem) p1_tail_convert(F, P, (int)blockIdx.x - rem, F.G - rem); }
        SEAM(2);
    }
    if (IN(3)) { p2_attn_pool(F, P, args.sub); SEAM(3); }
    if (IN(4)) {
        pg8::Gemm g{P.MIX, P.Wo_t, M, D, D, 0, 0}; pg8::StaticOrder S; S.init(M, D, F.G, (int)blockIdx.x);
        pg8::EpiWo E{P.x, P.XB1, P.mod, P.stats, PERBATCH ? nullptr : P.Z2, P.a2};
        pg8::gemm_phase<pg8::EpiWo, pg8::StaticOrder, true, true>(F.lds, g, S, E);
        SEAM(4);
    }
    if (IN(5)) {
        pg8::Gemm g{PERBATCH ? P.XB1 : P.Z2, P.W1b, M, FF, D, 4, PERBATCH ? (size_t)FF * D : (size_t)0};   pg8::P4ORDER S; S.init(M, FF, F.G, (int)blockIdx.x);
        pg8::EpiUp E{P.H, P.stats, P.bias2, FF};
        pg8::gemm_phase<pg8::EpiUp, pg8::P4ORDER, true, true>(F.lds, g, S, E);
        SEAM(5);
    }
    if (IN(6)) {
        pg8::Gemm g{P.H, P.W2_t, M, D, FF, 0, 0}; pg8::StaticOrder S; S.init(M, D, F.G, (int)blockIdx.x);
        pg8::EpiDown E{P.out, P.XB1, P.mod};
        pg8::gemm_phase<pg8::EpiDown, pg8::StaticOrder, true, true>(F.lds, g, S, E);
    }
#undef IN
#undef SEAM
}

#ifndef HYB
extern "C" void kernel_launch(void* const* d_in, const int* in_sizes, int n_in, void* d_out, int out_size, void* d_ws, size_t ws_size, hipStream_t stream) {
    static int grid = 0;
    if (grid == 0) {
        if (n_in != 16 || out_size != M * D || ws_size < WS_END) { fprintf(stderr, "kernel_launch: unexpected shapes (n_in %d out %d ws %zu)\n", n_in, out_size, ws_size); grid = -1; return; }
        int dev = 0, cus = 0, per_cu = 0;
        if (hipGetDevice(&dev) != hipSuccess || hipDeviceGetAttribute(&cus, hipDeviceAttributeMultiprocessorCount, dev) != hipSuccess) { grid = -1; return; }
        if (hipFuncSetAttribute((const void*)fwd_megakernel, hipFuncAttributeMaxDynamicSharedMemorySize, LDS_BYTES) != hipSuccess) { fprintf(stderr, "kernel_launch: hipFuncSetAttribute failed\n"); grid = -1; return; }
        if (hipOccupancyMaxActiveBlocksPerMultiprocessor(&per_cu, (const void*)fwd_megakernel, NWAVES * 64, LDS_BYTES) != hipSuccess || per_cu < 1) { fprintf(stderr, "kernel_launch: occupancy query says %d\n", per_cu); per_cu = 1; }
        (void)hipGetLastError();
        if (per_cu > 1) per_cu = 1;
        grid = cus * per_cu;
    }
    if (grid < 0) return;
    (void)hipMemsetAsync((char*)d_ws + WS_CTL, 0, CTL_ZERO_BYTES, stream);
    Args a{};
    for (int i = 0; i < 16; ++i) a.in[i] = d_in[i];
    a.out = (float*)d_out; a.ws = (unsigned char*)d_ws; a.sub = 7;
    if (N_LAUNCHES == 1 && DUP_PHASE == 6) {
        a.ph_lo = 0; a.ph_hi = N_PHASES; hipLaunchKernelGGL(fwd_megakernel, dim3(grid), dim3(NWAVES * 64), LDS_BYTES, stream, a);
        (void)hipMemsetAsync((char*)d_ws + WS_CTL, 0, CTL_ZERO_BYTES, stream);
        a.out = (float*)((char*)d_ws + WS_W1B); a.ph_lo = 6; a.ph_hi = 7; hipLaunchKernelGGL(fwd_megakernel, dim3(grid), dim3(NWAVES * 64), LDS_BYTES, stream, a);
    } else if (N_LAUNCHES == 1 && DUP_PHASE >= 0) {
        a.ph_lo = 0; a.ph_hi = DUP_PHASE + 1; hipLaunchKernelGGL(fwd_megakernel, dim3(grid), dim3(NWAVES * 64), LDS_BYTES, stream, a);
        (void)hipMemsetAsync((char*)d_ws + WS_CTL, 0, CTL_ZERO_BYTES, stream);
        a.sub = DUP_SUB; a.ph_lo = DUP_PHASE; a.ph_hi = DUP_PHASE + 1; hipLaunchKernelGGL(fwd_megakernel, dim3(grid), dim3(NWAVES * 64), LDS_BYTES, stream, a);
        (void)hipMemsetAsync((char*)d_ws + WS_CTL, 0, CTL_ZERO_BYTES, stream);
        a.sub = 7; a.ph_lo = DUP_PHASE + 1; a.ph_hi = N_PHASES; hipLaunchKernelGGL(fwd_megakernel, dim3(grid), dim3(NWAVES * 64), LDS_BYTES, stream, a);
    } else if (N_LAUNCHES == 1) { a.ph_lo = 0; a.ph_hi = N_PHASES; hipLaunchKernelGGL(fwd_megakernel, dim3(grid), dim3(NWAVES * 64), LDS_BYTES, stream, a); }
    else for (int li = 0; li < N_PHASES; ++li) { a.ph_lo = li; a.ph_hi = li + 1; hipLaunchKernelGGL(fwd_megakernel, dim3(grid), dim3(NWAVES * 64), LDS_BYTES, stream, a); }
}
#endif

#ifdef HYB
__global__ void dbg_norm(const float* __restrict__ x, const float* __restrict__ g, const float* __restrict__ mod, int sh_off, int sc_off, bf16* __restrict__ out) {
    const int wave = (blockIdx.x * blockDim.x + threadIdx.x) >> 6, lane = threadIdx.x & 63;
    if (wave >= M) return;
    const int b = wave / SEQ; const float* xr = x + (size_t)wave * D;
    float v[16]; float s = 0.f;
#pragma unroll
    for (int j = 0; j < 4; ++j) { const f32x4 t = *(const f32x4*)(xr + j * 256 + lane * 4); v[4 * j] = t[0]; v[4 * j + 1] = t[1]; v[4 * j + 2] = t[2]; v[4 * j + 3] = t[3]; s += t[0] * t[0] + t[1] * t[1] + t[2] * t[2] + t[3] * t[3]; }
    s = wave_sum(s);
    const float r = rsqrtf(s * (1.f / D) + EPS); const float* mb = mod + (size_t)b * NMOD * D;
#pragma unroll
    for (int j = 0; j < 4; ++j)
#pragma unroll
        for (int i = 0; i < 4; ++i) { const int col = j * 256 + lane * 4 + i; const float y = v[4 * j + i] * r * g[col] * (1.f + mb[sc_off + col]) + mb[sh_off + col]; out[(size_t)wave * D + col] = (bf16)f2bf(y); }
}
template <int MODE>
__global__ __launch_bounds__(256) void dbg_gemm(const bf16* __restrict__ A, const float* __restrict__ B, int N, int K, void* Cout, const float* X, const float* __restrict__ mod, int gate_off) {
    __shared__ __attribute__((aligned(16))) bf16 sA[128][40];
    __shared__ __attribute__((aligned(16))) bf16 sB[128][40];
    const int tid = threadIdx.x, lane = tid & 63, w = tid >> 6, wr = w >> 1, wc = w & 1;
    const int m0 = blockIdx.y * 128, n0 = blockIdx.x * 128;
    f32x4 acc[4][4];
#pragma unroll
    for (int i = 0; i < 4; ++i)
#pragma unroll
        for (int j = 0; j < 4; ++j) acc[i][j] = (f32x4){0.f, 0.f, 0.f, 0.f};
    for (int k0 = 0; k0 < K; k0 += 32) {
        { const int r = tid >> 1, cc = (tid & 1) * 16; const bf16x8* src = (const bf16x8*)(A + (size_t)(m0 + r) * K + k0 + cc); *(bf16x8*)&sA[r][cc] = src[0]; *(bf16x8*)&sA[r][cc + 8] = src[1]; }
        { const int kk = tid >> 3, nn = (tid & 7) * 16; const float* src = B + (size_t)(k0 + kk) * N + n0 + nn;
#pragma unroll
          for (int i = 0; i < 16; ++i) sB[nn + i][kk] = (bf16)f2bf(src[i]); }
        __syncthreads();
        bf16x8 a[4], b[4];
#pragma unroll
        for (int i = 0; i < 4; ++i) a[i] = *(const bf16x8*)&sA[wr * 64 + i * 16 + (lane & 15)][8 * (lane >> 4)];
#pragma unroll
        for (int j = 0; j < 4; ++j) b[j] = *(const bf16x8*)&sB[wc * 64 + j * 16 + (lane & 15)][8 * (lane >> 4)];
#pragma unroll
        for (int i = 0; i < 4; ++i)
#pragma unroll
            for (int j = 0; j < 4; ++j) acc[i][j] = __builtin_amdgcn_mfma_f32_16x16x32_bf16(a[i], b[j], acc[i][j], 0, 0, 0);
        __syncthreads();
    }
#pragma unroll
    for (int i = 0; i < 4; ++i)
#pragma unroll
        for (int j = 0; j < 4; ++j)
#pragma unroll
            for (int r = 0; r < 4; ++r) {
                const int row = m0 + wr * 64 + i * 16 + (lane >> 4) * 4 + r, col = n0 + wc * 64 + j * 16 + (lane & 15);
                const float v = acc[i][j][r]; const size_t o = (size_t)row * N + col;
                if (MODE == 0) ((bf16*)Cout)[o] = (bf16)f2bf(v);
                else if (MODE == 2) { const float t = v > 0.f ? v : 0.f; ((bf16*)Cout)[o] = (bf16)f2bf(t * t); }
                else { const int b_ = row / SEQ; const float gt = mod[(size_t)b_ * NMOD * D + gate_off + col]; const float base = (MODE == 1) ? X[o] : ((float*)Cout)[o]; ((float*)Cout)[o] = base + gt * v; }
            }
}
__global__ __launch_bounds__(64) void dbg_attn(const bf16* __restrict__ Q, const bf16* __restrict__ Kb, const bf16* __restrict__ Vb, const float* __restrict__ sinks, bf16* __restrict__ MIX) {
    const int id = blockIdx.x * blockDim.x + threadIdx.x;
    if (id >= M * NH) return;
    const int m = id / NH, hq = id % NH, kvh = hq / 4, b = m / SEQ, t = m % SEQ;
    float q[64], acc[64];
#pragma unroll
    for (int d = 0; d < 64; ++d) { q[d] = bf2f(Q[(size_t)m * AW + hq * 64 + d]); acc[d] = 0.f; }
    float mx = -1e30f, l = 0.f;
    const int j0 = t - 127 < 0 ? 0 : t - 127;
    for (int j = j0; j <= t; ++j) {
        const size_t kr = (size_t)(b * SEQ + j); float s = 0.f;
#pragma unroll
        for (int d = 0; d < 64; ++d) s += q[d] * bf2f(Kb[kr * KVW + kvh * 64 + d]);
        s *= 0.6931471805599453f;
        const float mn = fmaxf(mx, s); const float f = __expf(mx - mn), p = __expf(s - mn);
        l = l * f + p;
#pragma unroll
        for (int d = 0; d < 64; ++d) acc[d] = acc[d] * f + p * bf2f(Vb[kr * KVW + kvh * 64 + d]);
        mx = mn;
    }
    const float sk = sinks[hq]; const float mn = fmaxf(mx, sk); const float f = __expf(mx - mn);
    l = l * f + __expf(sk - mn);
    const float inv = f / l;
#pragma unroll
    for (int d = 0; d < 64; ++d) MIX[(size_t)m * D + hq * 64 + d] = (bf16)f2bf(acc[d] * inv);
}
__global__ void dbg_pool(const bf16* __restrict__ U, bf16* __restrict__ POOLED) {
    const int id = blockIdx.x * blockDim.x + threadIdx.x;
    if (id >= M * PW) return;
    const int m = id / PW, c = id % PW, g = c / 128, w = 2 << g, t = m % SEQ;
    const int cnt = (t + 1) < w ? (t + 1) : w; float s = 0.f;
    for (int j = 0; j < cnt; ++j) s += bf2f(U[(size_t)(m - j) * PW + c]);
    POOLED[(size_t)m * PW + c] = (bf16)f2bf(s / (float)cnt - bf2f(U[(size_t)m * PW + c]));
}
__global__ void dbg_copy_pooled(const bf16* __restrict__ MIX, bf16* __restrict__ POOLED) {
    const int id = blockIdx.x * blockDim.x + threadIdx.x;
    if (id >= M * PW) return;
    POOLED[id] = MIX[(size_t)(id / PW) * D + AW + (id % PW)];
}
__global__ void dbg_poolmm(const bf16* __restrict__ POOLED, const float* __restrict__ pool_w, const float* __restrict__ pool_scale, bf16* __restrict__ MIX) {
    const int id = blockIdx.x * blockDim.x + threadIdx.x;
    if (id >= M * PW) return;
    const int m = id / PW, c = id % PW, g = c / 128, d = c % 128; float s = 0.f;
    for (int k = 0; k < 128; ++k) s += bf2f(POOLED[(size_t)m * PW + g * 128 + k]) * pool_w[(size_t)(g * 128 + k) * 128 + d];
    MIX[(size_t)m * D + AW + c] = (bf16)f2bf(s * pool_scale[c]);
}
extern "C" void kernel_launch(void* const* d_in, const int* in_sizes, int n_in, void* d_out, int out_size, void* d_ws, size_t ws_size, hipStream_t stream) {
    static int grid = 0;
    if (grid == 0) {
        hipFuncSetAttribute((const void*)fwd_megakernel, hipFuncAttributeMaxDynamicSharedMemorySize, LDS_BYTES);
        grid = 256;
    }
    (void)hipMemsetAsync((char*)d_ws + WS_CTL, 0, CTL_ZERO_BYTES, stream);
    Args a{};
    for (int i = 0; i < 16; ++i) a.in[i] = d_in[i];
    a.out = (float*)d_out; a.ws = (unsigned char*)d_ws;
    unsigned char* ws = (unsigned char*)d_ws;
    const float* x = (const float*)d_in[0]; const float* sinks = (const float*)d_in[9]; const float* pool_w = (const float*)d_in[10]; const float* pool_scale = (const float*)d_in[11];
    const float* w_o = (const float*)d_in[12]; const float* norm2_g = (const float*)d_in[13]; const float* w1 = (const float*)d_in[14]; const float* w2 = (const float*)d_in[15];
    float* out = (float*)d_out; float* mod = (float*)(ws + WS_MOD);
    bf16 *Q = (bf16*)(ws + WS_Q), *Kb = (bf16*)(ws + WS_K), *Vb = (bf16*)(ws + WS_V), *U = (bf16*)(ws + WS_U), *MIX = (bf16*)(ws + WS_MIX), *Z2 = (bf16*)(ws + WS_XB1), *H = (bf16*)(ws + WS_H);
#define PH(lo_, hi_) do { a.ph_lo = lo_; a.ph_hi = hi_; for (int li = lo_; li < hi_; ++li) { a.ph_lo = li; a.ph_hi = li + 1; hipLaunchKernelGGL(fwd_megakernel, dim3(grid), dim3(NWAVES * 64), LDS_BYTES, stream, a); } } while (0)
    PH(0, 3);
#if HYB == 1
    dbg_attn<<<M * NH / 64, 64, 0, stream>>>(Q, Kb, Vb, sinks, MIX);
    dbg_pool<<<M * PW / 256, 256, 0, stream>>>(U, Z2);
#else
    PH(3, 4);
    dbg_copy_pooled<<<M * PW / 256, 256, 0, stream>>>(MIX, Z2);
#endif
    dbg_poolmm<<<M * PW / 256, 256, 0, stream>>>(Z2, pool_w, pool_scale, MIX);
    dbg_gemm<1><<<dim3(D / 128, M / 128), 256, 0, stream>>>(MIX, w_o, D, D, out, x, mod, 2 * D);
    dbg_norm<<<M / 4, 256, 0, stream>>>(out, norm2_g, mod, 3 * D, 4 * D, Z2);
    dbg_gemm<2><<<dim3(FF / 128, M / 128), 256, 0, stream>>>(Z2, w1, FF, D, H, nullptr, mod, 0);
    dbg_gemm<3><<<dim3(D / 128, M / 128), 256, 0, stream>>>(H, w2, D, FF, out, nullptr, mod, 5 * D);
}
#endif
```

```cpp
#define MK_N_LAUNCHES 1
#include <hip/hip_runtime.h>
#include <cstdio>
#include <cstdint>
#include <cmath>
#define MODUNROLL 8
namespace pg8 {
#define PG8_LAS __attribute__((address_space(3)))
typedef unsigned short bf16_t;
typedef short bf16x8 __attribute__((ext_vector_type(8)));
typedef float f32x4 __attribute__((ext_vector_type(4)));
typedef unsigned u32x4 __attribute__((ext_vector_type(4)));
constexpr int BM = 256, BK = 64, HALF = 128, HTB = HALF * BK * 2  , STAGE_BYTES = 8 * HTB, NXCD = 8, WGM = 8;

__host__ __device__ __forceinline__ int lds_byte(int r, int c) { const int st = (r >> 4) * 2 + (c >> 5), rr = r & 15, cc = c & 31, ob = rr * 64 + cc * 2; return st * 1024 + (ob ^ (((ob >> 9) & 1) << 5)); }
__host__ __device__ __forceinline__ void stage_rc(int b, int& R, int& C) { const int st = b / 1024, sb = b % 1024, swz = sb ^ (((sb >> 9) & 1) << 5); R = (st >> 1) * 16 + swz / 64; C = (st & 1) * 32 + (swz % 64) / 2; }
__host__ __device__ __forceinline__ int perm32(int rho) { const int n = rho >> 4, i = rho & 15; return 8 * (i >> 2) + 4 * n + (i & 3); }

struct Unit { int pm, pn; };
struct Gemm { const bf16_t* A; const bf16_t* Bt; int M, N, K; int bshift; size_t bstride; };

struct StaticOrder {
    int nM, nN, nwg, G, c;
    __host__ __device__ void init(int M, int N, int G_, int c_) { nM = M / BM; nN = N / BM; nwg = nM * nN; G = G_; c = c_; }
    __host__ __device__ bool next(int i, Unit& u) const {
        const long L = (long)i * G + c; if (L >= nwg) return false;
        int wgid = (int)L; { const int q = nwg / NXCD, r = nwg % NXCD, xcd = wgid % NXCD, off = wgid / NXCD; wgid = (xcd < r ? xcd * (q + 1) : r * (q + 1) + (xcd - r) * q) + off; }
        const int nig = WGM * nN, gid = wgid / nig, fm = gid * WGM, gsz = (nM - fm) < WGM ? (nM - fm) : WGM;
        u.pm = fm + ((wgid % nig) % gsz); u.pn = (wgid % nig) / gsz; return true;
    }
    __device__ __forceinline__ void a_ready(const Unit&) const {}
    __device__ __forceinline__ void done(const Unit&) const {}
};

struct BatchOrder : StaticOrder {
    __host__ __device__ bool next(int i, Unit& u) const {
        if (G != 256 || nM != 128 || nN != 16) return StaticOrder::next(i, u);
        if (i >= 8) return false;
        const int x = c & 7, j = c >> 3;
        u.pm = 16 * i + 4 * (x >> 1) + (j & 3); u.pn = 8 * (x & 1) + (j >> 2); return true;
    }
};

__device__ __forceinline__ unsigned cvt_pk_bf16(float lo, float hi) { unsigned r; asm volatile("v_cvt_pk_bf16_f32 %0, %1, %2" : "=v"(r) : "v"(lo), "v"(hi)); return r; }
typedef float f32x2 __attribute__((ext_vector_type(2)));
constexpr int SEQ_ = 4096, DM_ = 1024, NMOD_ = 6;
#ifndef USE_NT
#define USE_NT 1
#endif
#if USE_NT
#define PG8_NTLOAD(p) __builtin_nontemporal_load(p)
#else
#define PG8_NTLOAD(p) (*(p))
#endif
constexpr float EPS_ = 1e-6f;
constexpr float QSCALE = 0.125f * 1.4426950408889634f;

__device__ __forceinline__ u32x4 pack8(const f32x4 a, const f32x4 b) { u32x4 w; w.x = cvt_pk_bf16(a[0], a[1]); w.y = cvt_pk_bf16(a[2], a[3]); w.z = cvt_pk_bf16(b[0], b[1]); w.w = cvt_pk_bf16(b[2], b[3]); return w; }

struct EpiProj {
    static constexpr bool PERM = true, AFTER_DRAIN = false;
    bf16_t *Q, *Kb, *V, *U; const float* rope; const float* qg; const float* kg;
    __device__ __forceinline__ void operator()(const f32x4 (&acc)[2][2][4][2], const Unit& u, int wr, int wc, int fr, int fq) const {
        const int row0 = u.pm * BM + wr * 64 + fr;
        if (u.pn >= 3 || (u.pn == 2 && wc >= 2)) {
            bf16_t* base; int pitch;
            if (u.pn >= 3) { base = U + (u.pn - 3) * 256 + wc * 64 + 8 * fq; pitch = 512; } else { base = V + (wc - 2) * 64 + 8 * fq; pitch = 128; }
#pragma unroll
            for (int ai = 0; ai < 2; ++ai)
#pragma unroll
                for (int m = 0; m < 4; ++m) { bf16_t* rowp = base + (size_t)(row0 + ai * HALF + m * 16) * pitch;
#pragma unroll
                    for (int bj = 0; bj < 2; ++bj) *(u32x4*)(rowp + bj * 32) = pack8(acc[ai][bj][m][0], acc[ai][bj][m][1]); }
        } else {
            const bool isq = u.pn < 2; const float* g = isq ? qg : kg; const float sc = isq ? QSCALE : 1.0f;
            bf16_t* base = isq ? Q + (4 * u.pn + wc) * 64 + 8 * fq : Kb + wc * 64 + 8 * fq; const int pitch = isq ? 512 : 128;
            f32x4 gv[2][2];
#pragma unroll
            for (int bj = 0; bj < 2; ++bj)
#pragma unroll
                for (int n = 0; n < 2; ++n) gv[bj][n] = *(const f32x4*)(g + 32 * bj + 8 * fq + 4 * n);
#pragma unroll
            for (int ai = 0; ai < 2; ++ai)
#pragma unroll
                for (int m = 0; m < 4; ++m) {
                    const int row = row0 + ai * HALF + m * 16;
                    f32x4 cs[2], sn[2];
#pragma unroll
                    for (int n = 0; n < 2; ++n) { cs[n] = *(const f32x4*)(rope + (size_t)row * 16 + 4 * n); sn[n] = *(const f32x4*)(rope + (size_t)row * 16 + 8 + 4 * n); }
                    float ss = 0.f;
#pragma unroll
                    for (int bj = 0; bj < 2; ++bj)
#pragma unroll
                        for (int n = 0; n < 2; ++n) { const f32x4 v = acc[ai][bj][m][n]; ss += (v[0] * v[0] + v[1] * v[1]) + (v[2] * v[2] + v[3] * v[3]); }
                    ss += __shfl_xor(ss, 16); ss += __shfl_xor(ss, 32);
                    const float r = rsqrtf(ss * (1.0f / 64.0f) + EPS_);
                    f32x4 y[2][2];
#pragma unroll
                    for (int bj = 0; bj < 2; ++bj)
#pragma unroll
                        for (int n = 0; n < 2; ++n) y[bj][n] = acc[ai][bj][m][n] * r * gv[bj][n];
#pragma unroll
                    for (int n = 0; n < 2; ++n)
#pragma unroll
                        for (int e = 0; e < 4; ++e) { const float mine = y[0][n][e]; const float other = __shfl_xor(mine, 16);
                            const float ro = (fq == 0) ? mine * cs[n][e] - other * sn[n][e] : mine * cs[n][e] + other * sn[n][e];
                            y[0][n][e] = (fq < 2) ? ro : mine; }
                    bf16_t* rowp = base + (size_t)row * pitch;
#pragma unroll
                    for (int bj = 0; bj < 2; ++bj) *(u32x4*)(rowp + bj * 32) = pack8(y[bj][0] * sc, y[bj][1] * sc);
                }
        }
    }
};

struct EpiWo {
    static constexpr bool PERM = true, AFTER_DRAIN = false;
    const float* x; bf16_t* xb1; const float* mod; float* stats; bf16_t* z; const float* a2;
    __device__ __forceinline__ void operator()(const f32x4 (&acc)[2][2][4][2], const Unit& u, int wr, int wc, int fr, int fq) const {
        const int b = (u.pm * BM) / SEQ_; const int col0 = u.pn * BM + wc * 32 + 8 * fq; const int row0 = u.pm * BM + wr * 64 + fr;
        f32x4 gv[2][2], av[2][2];
#pragma unroll
        for (int bj = 0; bj < 2; ++bj)
#pragma unroll
            for (int n = 0; n < 2; ++n) { gv[bj][n] = *(const f32x4*)(mod + (size_t)b * NMOD_ * DM_ + 2 * DM_ + col0 + bj * HALF + 4 * n); av[bj][n] = z ? *(const f32x4*)(a2 + (size_t)b * DM_ + col0 + bj * HALF + 4 * n) : (f32x4){1.f, 1.f, 1.f, 1.f}; }
#pragma unroll
        for (int ai = 0; ai < 2; ++ai)
#pragma unroll
            for (int m = 0; m < 4; ++m) {
                const int row = row0 + ai * HALF + m * 16; const size_t off = (size_t)row * DM_ + col0; float ss = 0.f;
#pragma unroll
                for (int bj = 0; bj < 2; ++bj) {
                    const f32x4 xa = PG8_NTLOAD((const f32x4*)(x + off + bj * HALF)), xb = PG8_NTLOAD((const f32x4*)(x + off + bj * HALF + 4));
                    const f32x4 v0 = xa + gv[bj][0] * acc[ai][bj][m][0], v1 = xb + gv[bj][1] * acc[ai][bj][m][1];
                    ss += (v0[0] * v0[0] + v0[1] * v0[1]) + (v0[2] * v0[2] + v0[3] * v0[3]) + (v1[0] * v1[0] + v1[1] * v1[1]) + (v1[2] * v1[2] + v1[3] * v1[3]);
                    *(u32x4*)(xb1 + off + bj * HALF) = pack8(v0, v1);
                    if (z) *(u32x4*)(z + off + bj * HALF) = pack8(v0 * av[bj][0], v1 * av[bj][1]);
                }
                ss += __shfl_xor(ss, 16); ss += __shfl_xor(ss, 32);
                if (fq == 0) stats[(size_t)row * 16 + u.pn * 4 + wc] = ss;
            }
    }
};

struct EpiUp {
    static constexpr bool PERM = true, AFTER_DRAIN = false;
    bf16_t* H; const float* stats; const float* bias2; int ldc;
    __device__ __forceinline__ void operator()(const f32x4 (&acc)[2][2][4][2], const Unit& u, int wr, int wc, int fr, int fq) const {
        const int b = (u.pm * BM) / SEQ_; const int col0 = u.pn * BM + wc * 32 + 8 * fq; const int row0 = u.pm * BM + wr * 64 + fr;
        f32x4 bv[2][2];
#pragma unroll
        for (int bj = 0; bj < 2; ++bj)
#pragma unroll
            for (int n = 0; n < 2; ++n) bv[bj][n] = *(const f32x4*)(bias2 + (size_t)b * ldc + col0 + bj * HALF + 4 * n);
#pragma unroll
        for (int ai = 0; ai < 2; ++ai)
#pragma unroll
            for (int m = 0; m < 4; ++m) {
                const int row = row0 + ai * HALF + m * 16;
                const f32x4 st = *(const f32x4*)(stats + (size_t)row * 16 + 4 * fq);
                float s = (st[0] + st[1]) + (st[2] + st[3]); s += __shfl_xor(s, 16); s += __shfl_xor(s, 32);
                const float r = rsqrtf(s * (1.0f / DM_) + EPS_);
                bf16_t* rowp = H + (size_t)row * ldc + col0;
#pragma unroll
                for (int bj = 0; bj < 2; ++bj) {
                    f32x4 v0 = acc[ai][bj][m][0] * r + bv[bj][0], v1 = acc[ai][bj][m][1] * r + bv[bj][1];
#pragma unroll
                    for (int e = 0; e < 4; ++e) { const float t0 = fmaxf(v0[e], 0.f), t1 = fmaxf(v1[e], 0.f); v0[e] = t0 * t0; v1[e] = t1 * t1; }
                    *(u32x4*)(rowp + bj * HALF) = pack8(v0, v1);
                }
            }
    }
};

struct EpiDown {
    static constexpr bool PERM = true, AFTER_DRAIN = false;
    float* out; const bf16_t* xb1; const float* mod;
    __device__ __forceinline__ void operator()(const f32x4 (&acc)[2][2][4][2], const Unit& u, int wr, int wc, int fr, int fq) const {
        const int b = (u.pm * BM) / SEQ_; const int col0 = u.pn * BM + wc * 32 + 8 * fq; const int row0 = u.pm * BM + wr * 64 + fr;
        f32x4 gv[2][2];
#pragma unroll
        for (int bj = 0; bj < 2; ++bj)
#pragma unroll
            for (int n = 0; n < 2; ++n) gv[bj][n] = *(const f32x4*)(mod + (size_t)b * NMOD_ * DM_ + 5 * DM_ + col0 + bj * HALF + 4 * n);
#pragma unroll
        for (int ai = 0; ai < 2; ++ai)
#pragma unroll
            for (int m = 0; m < 4; ++m) {
                const size_t off = (size_t)(row0 + ai * HALF + m * 16) * DM_ + col0;
#pragma unroll
                for (int bj = 0; bj < 2; ++bj) {
                    const u32x4 w = *(const u32x4*)(xb1 + off + bj * HALF);
                    const f32x4 xa = (f32x4){__builtin_bit_cast(float, w.x << 16), __builtin_bit_cast(float, w.x & 0xffff0000u), __builtin_bit_cast(float, w.y << 16), __builtin_bit_cast(float, w.y & 0xffff0000u)};
                    const f32x4 xb = (f32x4){__builtin_bit_cast(float, w.z << 16), __builtin_bit_cast(float, w.z & 0xffff0000u), __builtin_bit_cast(float, w.w << 16), __builtin_bit_cast(float, w.w & 0xffff0000u)};
                    *(f32x4*)(out + off + bj * HALF) = xa + gv[bj][0] * acc[ai][bj][m][0]; *(f32x4*)(out + off + bj * HALF + 4) = xb + gv[bj][1] * acc[ai][bj][m][1];
                }
            }
    }
};

template <class Epi, class Sched, bool ALIGN_EPI = false, bool SP2 = false>
__device__ __forceinline__ void gemm_phase(PG8_LAS unsigned char* lds, const Gemm g, const Sched& S, const Epi& E) {
    const int tid = threadIdx.x, wid = __builtin_amdgcn_readfirstlane(tid >> 6), lane = tid & 63, wr = wid >> 2, wc = wid & 3, fr = lane & 15, fq = lane >> 4;
    const int K = g.K, nt = K / BK;
    unsigned voffA[2], voffB[2];
#pragma unroll
    for (int i = 0; i < 2; ++i) { int R, C; stage_rc(tid * 16 + i * 8192, R, C); const int Rb = Epi::PERM ? ((R & ~31) + perm32(R & 31)) : R;
        voffA[i] = (unsigned)(R * K + C) * 2u; voffB[i] = (unsigned)(Rb * K + C) * 2u; }
    const size_t kstep = (size_t)(BK * 2);
    const size_t hstep = (size_t)HALF * K * 2;
    const size_t tstep = 2 * hstep;
    const unsigned ldsw = (unsigned)wid * 1024u;
    const int aoff = lds_byte(wr * 64 + fr, fq * 8), boff = lds_byte(wc * 32 + fr, fq * 8);
#define PG8_SA(b, h) (((b) * 2 + (h)) * HTB)
#define PG8_SB(b, h) ((4 + (b) * 2 + (h)) * HTB)
#define PG8_STAGE(bufoff, gbase, voff) do { _Pragma("unroll") for (int _i = 0; _i < 2; ++_i) \
        __builtin_amdgcn_global_load_lds((const unsigned*)((const char*)(gbase) + (voff)[_i]), (PG8_LAS unsigned*)(lds + (bufoff) + ldsw + _i * 8192), 16, 0, 0); } while (0)
#define PG8_LDA(dst, b, h) do { _Pragma("unroll") for (int m = 0; m < 4; ++m) _Pragma("unroll") for (int k = 0; k < 2; ++k) dst[m][k] = *(const PG8_LAS bf16x8*)(lds + PG8_SA(b, h) + aoff + m * 2048 + k * 1024); } while (0)
#define PG8_LDB(dst, b, h) do { _Pragma("unroll") for (int n = 0; n < 2; ++n) _Pragma("unroll") for (int k = 0; k < 2; ++k) dst[n][k] = *(const PG8_LAS bf16x8*)(lds + PG8_SB(b, h) + boff + n * 2048 + k * 1024); } while (0)
#define PG8_MMA(ai, bj, At, Bt) do { __builtin_amdgcn_s_setprio(1); _Pragma("unroll") for (int m = 0; m < 4; ++m) _Pragma("unroll") for (int n = 0; n < 2; ++n) _Pragma("unroll") for (int k = 0; k < 2; ++k) \
        acc[ai][bj][m][n] = __builtin_amdgcn_mfma_f32_16x16x32_bf16(Bt[n][k], At[m][k], acc[ai][bj][m][n], 0, 0, 0); __builtin_amdgcn_s_setprio(0); } while (0)
#define PG8_WAIT_V(n) asm volatile("s_waitcnt vmcnt(" #n ")" ::: "memory")
#define PG8_WAIT_L(n) asm volatile("s_waitcnt lgkmcnt(" #n ")" ::: "memory")
#define PG8_BAR __builtin_amdgcn_s_barrier()
#define PG8_SCHED __builtin_amdgcn_sched_barrier(0)
    Unit cur, nxt; int ui = 0;
    if (!S.next(0, cur)) return;
    f32x4 acc[2][2][4][2];
#pragma unroll
    for (int a = 0; a < 2; ++a)
#pragma unroll
        for (int b = 0; b < 2; ++b)
#pragma unroll
            for (int m = 0; m < 4; ++m)
#pragma unroll
                for (int n = 0; n < 2; ++n) acc[a][b][m][n] = (f32x4){0.f, 0.f, 0.f, 0.f};
    bf16x8 At[4][2], B0[2][2], B1[2][2];
    const char* cA = (const char*)g.A + (size_t)cur.pm * tstep; const char* cB = (const char*)(g.Bt + (size_t)(cur.pm >> g.bshift) * g.bstride) + (size_t)cur.pn * tstep;
    S.a_ready(cur);
    if constexpr (SP2) {
        PG8_STAGE(PG8_SB(0, 0), cB, voffB); PG8_STAGE(PG8_SB(0, 1), cB + hstep, voffB); PG8_STAGE(PG8_SA(0, 0), cA, voffA); PG8_STAGE(PG8_SA(0, 1), cA + hstep, voffA);
        if (wr == 1) PG8_BAR;
        PG8_WAIT_V(2); PG8_BAR;
        PG8_STAGE(PG8_SB(1, 0), cB + kstep, voffB); PG8_STAGE(PG8_SA(1, 0), cA + kstep, voffA); PG8_STAGE(PG8_SB(1, 1), cB + hstep + kstep, voffB);
        PG8_WAIT_V(6); PG8_BAR;
    } else {
        PG8_STAGE(PG8_SB(0, 0), cB, voffB); PG8_STAGE(PG8_SA(0, 0), cA, voffA); PG8_STAGE(PG8_SB(0, 1), cB + hstep, voffB); PG8_STAGE(PG8_SA(0, 1), cA + hstep, voffA);
        if (wr == 1) PG8_BAR;
        PG8_WAIT_V(4); PG8_BAR;
        PG8_STAGE(PG8_SB(1, 0), cB + kstep, voffB); PG8_STAGE(PG8_SA(1, 0), cA + kstep, voffA); PG8_STAGE(PG8_SB(1, 1), cB + hstep + kstep, voffB);
        PG8_WAIT_V(6); PG8_BAR;
    }
    for (;;) {
        const bool has_next = S.next(ui + 1, nxt);
        const char* nA = has_next ? (const char*)g.A + (size_t)nxt.pm * tstep : cA; const char* nB = has_next ? (const char*)(g.Bt + (size_t)(nxt.pm >> g.bshift) * g.bstride) + (size_t)nxt.pn * tstep : cB;
        for (int t = 0; t < nt; t += 2) {
            const bool last = (t == nt - 2);
            const char* a1 = cA + (size_t)(t + 1) * kstep;
            const char* a2 = last ? nA : cA + (size_t)(t + 2) * kstep; const char* b2 = last ? nB : cB + (size_t)(t + 2) * kstep;
            const char* a3 = a2 + kstep; const char* b3 = b2 + kstep;
            if (last && has_next) S.a_ready(nxt);
            if constexpr (SP2) {
            PG8_LDB(B0, 0, 0); PG8_LDB(B1, 0, 1); PG8_SCHED; PG8_LDA(At, 0, 0); PG8_STAGE(PG8_SA(1, 1), a1 + hstep, voffA);
            PG8_WAIT_V(8); PG8_WAIT_L(0); PG8_BAR; PG8_MMA(0, 0, At, B0); PG8_MMA(0, 1, At, B1); PG8_BAR; PG8_SCHED;
            PG8_LDA(At, 0, 1); PG8_STAGE(PG8_SB(0, 0), b2, voffB); PG8_STAGE(PG8_SB(0, 1), b2 + hstep, voffB); PG8_STAGE(PG8_SA(0, 0), a2, voffA);
            PG8_WAIT_V(8); PG8_WAIT_L(0); PG8_BAR; PG8_MMA(1, 0, At, B0); PG8_MMA(1, 1, At, B1); PG8_BAR; PG8_SCHED;
            PG8_LDB(B0, 1, 0); PG8_LDB(B1, 1, 1); PG8_SCHED; PG8_LDA(At, 1, 0); PG8_STAGE(PG8_SA(0, 1), a2 + hstep, voffA);
            PG8_WAIT_V(8); PG8_WAIT_L(0); PG8_BAR; PG8_MMA(0, 0, At, B0); PG8_MMA(0, 1, At, B1); PG8_BAR; PG8_SCHED;
            PG8_LDA(At, 1, 1); PG8_STAGE(PG8_SB(1, 0), b3, voffB); PG8_STAGE(PG8_SB(1, 1), b3 + hstep, voffB); PG8_STAGE(PG8_SA(1, 0), a3, voffA);
            PG8_WAIT_V(8); PG8_WAIT_L(0); PG8_BAR; PG8_MMA(1, 0, At, B0); PG8_MMA(1, 1, At, B1); PG8_BAR; PG8_SCHED;
            } else {
            PG8_LDB(B0, 0, 0); PG8_SCHED; PG8_LDA(At, 0, 0); PG8_STAGE(PG8_SA(1, 1), a1 + hstep, voffA);
            PG8_WAIT_L(8); PG8_BAR; PG8_WAIT_L(0); PG8_MMA(0, 0, At, B0); PG8_BAR; PG8_SCHED;
            PG8_LDB(B1, 0, 1); PG8_STAGE(PG8_SB(0, 0), b2, voffB);
            PG8_BAR; PG8_WAIT_L(0); PG8_MMA(0, 1, At, B1); PG8_BAR;
            PG8_LDA(At, 0, 1); PG8_STAGE(PG8_SA(0, 0), a2, voffA);
            PG8_BAR; PG8_WAIT_L(0); PG8_MMA(1, 0, At, B0); PG8_BAR; PG8_SCHED;
            PG8_STAGE(PG8_SB(0, 1), b2 + hstep, voffB);
            PG8_WAIT_V(6); PG8_BAR; PG8_MMA(1, 1, At, B1); PG8_BAR;
            PG8_LDB(B0, 1, 0); PG8_SCHED; PG8_LDA(At, 1, 0); PG8_STAGE(PG8_SA(0, 1), a2 + hstep, voffA);
            PG8_WAIT_L(8); PG8_BAR; PG8_WAIT_L(0); PG8_MMA(0, 0, At, B0); PG8_BAR; PG8_SCHED;
            PG8_LDB(B1, 1, 1); PG8_STAGE(PG8_SB(1, 0), b3, voffB);
            PG8_BAR; PG8_WAIT_L(0); PG8_MMA(0, 1, At, B1); PG8_BAR;
            PG8_LDA(At, 1, 1); PG8_STAGE(PG8_SA(1, 0), a3, voffA);
            PG8_BAR; PG8_WAIT_L(0); PG8_MMA(1, 0, At, B0); PG8_BAR; PG8_SCHED;
            PG8_STAGE(PG8_SB(1, 1), b3 + hstep, voffB);
            PG8_WAIT_V(6); PG8_BAR; PG8_MMA(1, 1, At, B1); PG8_BAR;
            }
        }
        if constexpr (ALIGN_EPI) { if (wr == 0) PG8_BAR; }
        if constexpr (!Epi::AFTER_DRAIN) { E(acc, cur, wr, wc, fr, fq); S.done(cur); }
        if (!has_next) break;
#pragma unroll
        for (int a = 0; a < 2; ++a)
#pragma unroll
            for (int b = 0; b < 2; ++b)
#pragma unroll
                for (int m = 0; m < 4; ++m)
#pragma unroll
                    for (int n = 0; n < 2; ++n) acc[a][b][m][n] = (f32x4){0.f, 0.f, 0.f, 0.f};
        cur = nxt; cA = nA; cB = nB; ++ui;
        if constexpr (ALIGN_EPI) { if (wr == 1) PG8_BAR; }
    }
    PG8_WAIT_V(0);
    if constexpr (!ALIGN_EPI) { if (wr == 0) PG8_BAR; }
    PG8_BAR;
    if constexpr (Epi::AFTER_DRAIN) { E.fused(acc, cur, wr, wc, fr, fq, lds, wid, lane); S.done(cur); }
#undef PG8_SA
#undef PG8_SB
#undef PG8_STAGE
#undef PG8_LDA
#undef PG8_LDB
#undef PG8_MMA
#undef PG8_WAIT_V
#undef PG8_WAIT_L
#undef PG8_BAR
#undef PG8_SCHED
}
}

constexpr int NWAVES = 8;
constexpr int BATCH = 8, SEQ = 4096, D = 1024, M = BATCH * SEQ;
constexpr int NH = 8, NKV = 2, HD = 64, AW = 512, KVW = 128, PW = 512, INW = 1280, FF = 4096, NMOD = 6;
constexpr float EPS = 1e-6f;
#ifndef MK_N_LAUNCHES
#define MK_N_LAUNCHES 1
#endif
#ifndef DUP_PHASE
#define DUP_PHASE -1
#endif
#ifndef EPI_PHASE
#define EPI_PHASE -1
#endif
#ifndef TAILCONV
#define TAILCONV 1
#endif
#ifndef OLDTR
#define OLDTR 0
#endif
#ifndef MODUNROLL
#define MODUNROLL 32
#endif
#ifndef DUP_SUB
#define DUP_SUB 7
#endif
#ifndef PERBATCH
#define PERBATCH 0
#endif
#ifndef P4ORDER
#define P4ORDER BatchOrder
#endif
#ifndef TS_PHASE
#define TS_PHASE -2
#endif
#ifndef TS_SCALE
#define TS_SCALE 4
#endif
#ifndef TS_BUCKET
#define TS_BUCKET 0
#endif
#ifndef TS_OFFSET
#define TS_OFFSET 0
#endif
constexpr int N_PHASES = 7;
constexpr int N_LAUNCHES = MK_N_LAUNCHES;

constexpr size_t MiB = 1u << 20;
constexpr size_t WS_CTL = 0, CTL_ZERO_BYTES = 64 * 1024;
constexpr size_t WS_MOD = 1 * MiB;
constexpr size_t WS_BIAS2 = 1 * MiB + 256 * 1024;
constexpr size_t WS_A2 = 1 * MiB + 512 * 1024;
constexpr size_t WS_ROPE = 2 * MiB;
constexpr size_t WS_STATS = 4 * MiB;
constexpr size_t WS_WIN = 6 * MiB, WS_WO = 9 * MiB, WS_W1 = 12 * MiB, WS_W2 = 20 * MiB;
constexpr size_t WS_XB1 = 32 * MiB;
constexpr size_t WS_H = 96 * MiB;
constexpr size_t WS_XN = 96 * MiB, WS_Q = 160 * MiB, WS_K = 192 * MiB, WS_V = 200 * MiB, WS_U = 208 * MiB, WS_MIX = 240 * MiB;
constexpr size_t WS_W1B = 352 * MiB;
constexpr size_t WS_Z2 = 416 * MiB;
constexpr size_t WS_END = 480 * MiB;
constexpr int CW_BAR = 1024;

constexpr int LDS_BYTES = 160 * 1024;
constexpr int MISC_OFF = LDS_BYTES - 256;
constexpr int ATT_K = 0, ATT_V = 24576, ATT_WS = 49152, ATT_OST = ATT_WS + NWAVES * 256, ATT_END = ATT_OST + NWAVES * 4096;

#define GAS __attribute__((address_space(1)))
#define LAS __attribute__((address_space(3)))
typedef unsigned short bf16;
typedef unsigned v4u __attribute__((ext_vector_type(4)));
typedef float f32x4 __attribute__((ext_vector_type(4)));
typedef short bf16x8 __attribute__((ext_vector_type(8)));
typedef GAS unsigned gu32;
typedef GAS unsigned long long gu64;
#define RLX_AGENT __ATOMIC_RELAXED, __HIP_MEMORY_SCOPE_AGENT
#define LDS_WAIT() asm volatile("s_waitcnt lgkmcnt(0)" ::: "memory")
#define VM_WAIT() asm volatile("s_waitcnt vmcnt(0)" ::: "memory")
__device__ __forceinline__ unsigned long long rt() { return __builtin_amdgcn_s_memrealtime(); }
__device__ __forceinline__ unsigned f2bf(float f) { unsigned u = __builtin_bit_cast(unsigned, f); return (u + 0x7fffu + ((u >> 16) & 1u)) >> 16; }
__device__ __forceinline__ unsigned pk2(float lo, float hi) { return f2bf(lo) | (f2bf(hi) << 16); }

#define XB_TMO      128
#define XB_XCNT(j)  (256  + 64 * (j))
#define XB_XSUB(j)  (1280 + 64 * (j))
#define XB_XGEN(j)  (2304 + 64 * (j))
#define XB_TOP      3328
#define XB_TOPGEN   3392
#define XCD_BAR_WORDS 3456
#define XB_SPIN_CAP (1u << 18)

__device__ __forceinline__ unsigned xb_ld(unsigned* p)              { return __hip_atomic_load(p, __ATOMIC_RELAXED, __HIP_MEMORY_SCOPE_AGENT); }
__device__ __forceinline__ unsigned xb_add(unsigned* p, unsigned v) { return __hip_atomic_fetch_add(p, v, __ATOMIC_RELAXED, __HIP_MEMORY_SCOPE_AGENT); }
__device__ __forceinline__ unsigned xb_xcc_id() { return (unsigned)__builtin_amdgcn_s_getreg((3 << 11) | 20) & 0xFu; }
#define XB_SPIN(cond, bar) do { unsigned _sp = 0; while (cond) { __builtin_amdgcn_s_sleep(1); \
    if ((++_sp & 255u) == 0u) { if (xb_ld(&(bar)[XB_TMO])) break; if (_sp > XB_SPIN_CAP) { atomicAdd(&(bar)[XB_TMO], 1u); break; } } } } while (0)

struct XcdBarrier {
    unsigned* bar; unsigned x;
    volatile LAS unsigned* st;
};

__device__ __forceinline__ XcdBarrier xcd_barrier_post(unsigned* bar, volatile LAS unsigned* st) {
    XcdBarrier b; b.bar = bar; b.x = xb_xcc_id(); b.st = st;
    if (threadIdx.x == 0) (void)xb_add(&bar[XB_XCNT(b.x)], 1u);
    return b;
}
__device__ __forceinline__ void xcd_barrier_complete(unsigned* bar, unsigned x, unsigned& nloc, unsigned& nx) {
    const unsigned G = gridDim.x * gridDim.y * gridDim.z;
    unsigned sum, cnt, mine, sp = 0u;
    for (;;) {
        sum = 0u; cnt = 0u; mine = 0u;
#pragma unroll
        for (unsigned j = 0; j < 16; ++j) { const unsigned c = xb_ld(&bar[XB_XCNT(j)]); sum += c; cnt += (c > 0u) ? 1u : 0u; mine = (j == x) ? c : mine; }
        if (sum == G) break;
        __builtin_amdgcn_s_sleep(1);
        if ((++sp & 255u) == 0u) { if (xb_ld(&bar[XB_TMO])) break; if (sp > XB_SPIN_CAP) { atomicAdd(&bar[XB_TMO], 1u); break; } }
    }
    nloc = mine > 0u ? mine : 1u; nx = cnt > 0u ? cnt : 1u;
}

__device__ __forceinline__ void xcd_barrier(const XcdBarrier& b) {
    asm volatile("s_waitcnt vmcnt(0)" ::: "memory");
    __syncthreads();
    if (threadIdx.x == 0) {
        unsigned* bar = b.bar;
        __builtin_amdgcn_s_waitcnt(0);
        unsigned nloc = b.st[0], nx = b.st[1];
        if (nloc == 0u) { xcd_barrier_complete(bar, b.x, nloc, nx); b.st[0] = nloc; b.st[1] = nx; }
        const unsigned old = xb_add(&bar[XB_XSUB(b.x)], 1u);
        const unsigned gen = old / nloc;
        if (old + 1u == (gen + 1u) * nloc) {
            __builtin_amdgcn_fence(__ATOMIC_RELEASE, "agent");
            asm volatile("s_waitcnt vmcnt(0)" ::: "memory");
            const unsigned og = xb_add(&bar[XB_TOP], 1u);
            const unsigned tg = og / nx;
            if (og + 1u == (tg + 1u) * nx) xb_add(&bar[XB_TOPGEN], 1u);
            else XB_SPIN(xb_ld(&bar[XB_TOPGEN]) == tg, bar);
            __builtin_amdgcn_fence(__ATOMIC_ACQUIRE, "agent");
            xb_add(&bar[XB_XGEN(b.x)], 1u);
            asm volatile("s_waitcnt vmcnt(0)" ::: "memory");
        } else {
            XB_SPIN(xb_ld(&bar[XB_XGEN(b.x)]) == gen, bar);
            __builtin_amdgcn_fence(__ATOMIC_ACQUIRE, "agent");
            asm volatile("s_waitcnt vmcnt(0)" ::: "memory");
        }
    }
    __syncthreads();
}

#if USE_NT
#define NTLOAD(p) __builtin_nontemporal_load(p)
#else
#define NTLOAD(p) (*(p))
#endif
typedef float f32x16 __attribute__((ext_vector_type(16)));
typedef short s16x4 __attribute__((ext_vector_type(4)));
struct Frame {
    LAS unsigned char* lds;
    int tid, lane, wave, vcu, G;
};
__device__ __forceinline__ float wave_sum(float v) {
#pragma unroll
    for (int o = 1; o < 64; o <<= 1) v += __shfl_xor(v, o);
    return v;
}
__device__ __forceinline__ float bf2f(unsigned short h) { return __builtin_bit_cast(float, (unsigned)h << 16); }
__device__ __forceinline__ float bflo(unsigned w) { return __builtin_bit_cast(float, w << 16); }
__device__ __forceinline__ float bfhi(unsigned w) { return __builtin_bit_cast(float, w & 0xffff0000u); }

__device__ __forceinline__ void p0_transpose_item(const float* W, int N, bf16* WT, int Kd, int k0, int n0, int dst_row0, LAS float* scr, int lane) {
#if OLDTR
#pragma unroll 8
    for (int i = 0; i < 32; ++i) { const int kk = 2 * i + (lane >> 5); scr[kk * 33 + (lane & 31)] = W[(size_t)(k0 + kk) * N + n0 + (lane & 31)]; }
#else
    f32x4 v[8];
#pragma unroll
    for (int i = 0; i < 8; ++i) v[i] = NTLOAD((const GAS f32x4*)(W + (size_t)(k0 + 8 * i + (lane >> 3)) * N + n0 + 4 * (lane & 7)));
#pragma unroll
    for (int i = 0; i < 8; ++i) { LAS float* d = scr + (8 * i + (lane >> 3)) * 33 + 4 * (lane & 7); d[0] = v[i][0]; d[1] = v[i][1]; d[2] = v[i][2]; d[3] = v[i][3]; }
#endif
    LDS_WAIT(); asm volatile("" ::: "memory");
    const int c = lane & 7;
#pragma unroll
    for (int j = 0; j < 4; ++j) { const int n = (lane >> 3) + 8 * j; const LAS float* s = scr + (8 * c) * 33 + n;
        v4u o; o.x = pk2(s[0 * 33], s[1 * 33]); o.y = pk2(s[2 * 33], s[3 * 33]); o.z = pk2(s[4 * 33], s[5 * 33]); o.w = pk2(s[6 * 33], s[7 * 33]);
        *(GAS v4u*)(WT + (size_t)(dst_row0 + n) * Kd + k0 + 8 * c) = o; }
    LDS_WAIT(); asm volatile("" ::: "memory");
}
__device__ __forceinline__ int win_slot(int n) { const int pn = n >> 8, r = n & 255; return 256 * pn + 128 * ((r >> 5) & 1) + 32 * (r >> 6) + (r & 31); }

struct Ptrs {
    const float *x, *c, *w_ada, *b_ada, *norm1_g, *w_in, *q_norm_g, *k_norm_g, *sinks, *pool_w, *pool_scale, *w_o, *norm2_g, *w1, *w2; const int* positions;
    float *out, *mod, *bias2, *a2, *rope, *stats; bf16 *Win_t, *Wo_t, *W1b, *W2_t, *XN, *Q, *K, *V, *U, *MIX, *XB1, *H, *Z2;
};

template <bool SILU> __device__ __forceinline__ void skinny_task(Frame& F, const float* src, int spitch, const float* W, int wpitch, const float* bias, float* out, int opitch, int t) {
    LAS float* vT = (LAS float*)F.lds;
    LAS float* red = (LAS float*)(F.lds + 65536);
    { float cv[16];
#pragma unroll
      for (int i = 0; i < 16; ++i) { const int idx = F.tid + 512 * i; cv[i] = src[(size_t)(idx >> 10) * spitch + (idx & 1023)]; }
#pragma unroll
      for (int i = 0; i < 16; ++i) { const int idx = F.tid + 512 * i, b = idx >> 10, k = idx & 1023; vT[k * 16 + b] = SILU ? cv[i] / (1.f + __expf(-cv[i])) : cv[i]; vT[k * 16 + 8 + b] = 0.f; } }
    __syncthreads();
    const int j0 = 64 * t, kb = 128 * F.wave, kq = F.lane >> 4, jl = F.lane & 15;
    f32x4 acc[4];
#pragma unroll
    for (int e = 0; e < 4; ++e) acc[e] = (f32x4){0.f, 0.f, 0.f, 0.f};
    const GAS float* wp = (const GAS float*)W + (size_t)(kb + kq) * wpitch + j0 + 4 * jl;
#pragma unroll
    for (int s0 = 0; s0 < 32; s0 += 16) {
        f32x4 wv[16];
#pragma unroll
        for (int s = 0; s < 16; ++s) wv[s] = NTLOAD((const GAS f32x4*)(wp + (size_t)(4 * (s0 + s)) * wpitch));
#pragma unroll
        for (int s = 0; s < 16; ++s) { const float a = vT[(kb + 4 * (s0 + s) + kq) * 16 + jl];
#pragma unroll
            for (int e = 0; e < 4; ++e) acc[e] = __builtin_amdgcn_mfma_f32_16x16x4f32(a, wv[s][e], acc[e], 0, 0, 0); }
    }
    if (F.lane < 32) {
#pragma unroll
        for (int e = 0; e < 4; ++e)
#pragma unroll
            for (int r = 0; r < 4; ++r) red[((F.wave * 4 + e) * 4 + r) * 32 + F.lane] = acc[e][r];
    }
    __syncthreads();
    { const int b = F.tid >> 6, col = F.tid & 63, e = col & 3, lane = (b >> 2) * 16 + (col >> 2), r = b & 3; float sum = 0.f;
#pragma unroll
      for (int w = 0; w < NWAVES; ++w) sum += red[((w * 4 + e) * 4 + r) * 32 + lane];
      out[(size_t)b * opitch + j0 + col] = sum + (bias ? bias[j0 + col] : 0.f); }
    __syncthreads();
}
__device__ __forceinline__ void p0_fold_task(Frame& F, const Ptrs& P, int t) {
    const int g = t >> 5, n0 = (t & 31) * 32;
    LAS float* Pm = (LAS float*)F.lds;
    LAS float* Wm = (LAS float*)(F.lds + 128 * 129 * 4);
    { float pv[32], wv[8];
#pragma unroll
      for (int i = 0; i < 32; ++i) pv[i] = P.pool_w[(size_t)g * 16384 + F.tid + 512 * i];
#pragma unroll
      for (int i = 0; i < 8; ++i) { const int idx = F.tid + 512 * i; wv[i] = P.w_o[(size_t)(512 + 128 * g + (idx >> 5)) * D + n0 + (idx & 31)]; }
      const float sc = P.pool_scale[128 * g + (F.tid & 127)];
#pragma unroll
      for (int i = 0; i < 32; ++i) { const int idx = F.tid + 512 * i; Pm[(idx >> 7) * 129 + (idx & 127)] = pv[i] * sc; }
#pragma unroll
      for (int i = 0; i < 8; ++i) { const int idx = F.tid + 512 * i; Wm[(idx >> 5) * 33 + (idx & 31)] = wv[i]; } }
    __syncthreads();
    const int c0 = 16 * F.wave, li = F.lane & 15, lq = F.lane >> 4;
    f32x4 acc0 = (f32x4){0.f, 0.f, 0.f, 0.f}, acc1 = acc0;
#pragma unroll 8
    for (int d0 = 0; d0 < 128; d0 += 4) {
        const float a = Pm[(c0 + li) * 129 + d0 + lq], b0 = Wm[(d0 + lq) * 33 + li], b1 = Wm[(d0 + lq) * 33 + 16 + li];
        acc0 = __builtin_amdgcn_mfma_f32_16x16x4f32(a, b0, acc0, 0, 0, 0); acc1 = __builtin_amdgcn_mfma_f32_16x16x4f32(a, b1, acc1, 0, 0, 0);
    }
#pragma unroll
    for (int r = 0; r < 4; ++r) { const int c = c0 + 4 * lq + r;
        P.Wo_t[(size_t)(n0 + li) * D + 512 + 128 * g + c] = (bf16)f2bf(acc0[r]); P.Wo_t[(size_t)(n0 + 16 + li) * D + 512 + 128 * g + c] = (bf16)f2bf(acc1[r]); }
    __syncthreads();
}
__device__ __forceinline__ void p0a_prologue(Frame& F, const Ptrs& P) {
    for (int t = F.vcu; t < 96; t += F.G) skinny_task<true>(F, P.c, D, P.w_ada, NMOD * D, P.b_ada, P.mod, NMOD * D, t);
    LAS float* scr = (LAS float*)(F.lds + F.wave * 16384);
    const int gw = (F.G - 1 - F.vcu) * NWAVES + F.wave, NGW = F.G * NWAVES;
    constexpr int I_IN = (D / 64) * (INW / 32), I_2 = (FF / 64) * (D / 32);
    for (int it = gw; it < I_IN; it += NGW) { const int nblk = INW / 32, kb = it / nblk, nb = it % nblk; p0_transpose_item(P.w_in, INW, P.Win_t, D, 64 * kb, 32 * nb, win_slot(32 * nb), scr, F.lane); }
    { const int nfree = F.G > 96 ? F.G - 96 : F.G, ordf = F.G > 96 ? F.vcu - 96 : F.vcu;
      if (ordf >= 0) for (int it = ordf * NWAVES + F.wave; it < I_2; it += nfree * NWAVES) { const int nblk = D / 32, kb = it / nblk, nb = it % nblk; p0_transpose_item(P.w2, D, P.W2_t, FF, 64 * kb, 32 * nb, 32 * nb, scr, F.lane); } }
    for (int idx = (F.vcu * NWAVES * 64 + F.tid); idx < M * 8; idx += F.G * NWAVES * 64) {
        const int m = idx >> 3, i = idx & 7;
        const float inv_freq = (i == 0) ? 1.0f : (i == 1) ? 0.1939227432012558f : (i == 2) ? 0.03760603070259094f : (i == 3) ? 0.007292664609849453f : (i == 4) ? 0.0014142135623842478f : (i == 5) ? 0.00027424818836152554f : (i == 6) ? 5.3182957344688475e-05f : 1.0313385246263351e-05f;
        const float ang = (float)P.positions[m] * inv_freq;
        P.rope[(size_t)m * 16 + i] = (float)cos((double)ang); P.rope[(size_t)m * 16 + 8 + i] = (float)sin((double)ang);
    }
}

__device__ __forceinline__ void p1_tail_work(Frame& F, const Ptrs& P, int ord, int cnt) {
    for (int t = ord; t < 128; t += cnt) p0_fold_task(F, P, t);
    for (int t = cnt - 1 - ord; t < FF / 64; t += cnt) skinny_task<false>(F, P.mod + 3 * D, NMOD * D, P.w1, FF, nullptr, P.bias2, FF, t);
    LAS float* scr = (LAS float*)(F.lds + F.wave * 16384);
    constexpr int I_1 = (D / 64) * (FF / 32), I_O = (AW / 64) * (D / 32);
    for (int it = ord * NWAVES + F.wave; it < I_1 + I_O; it += cnt * NWAVES) {
        int r = it;
        if (r < I_1) { const int nblk = FF / 32, kb = r / nblk, nb = r % nblk; p0_transpose_item(P.w1, FF, P.W1b, D, 64 * kb, 32 * nb, 32 * nb, scr, F.lane); continue; } r -= I_1;
        { const int nblk = D / 32, kb = r / nblk, nb = r % nblk; p0_transpose_item(P.w_o, D, P.Wo_t, D, 64 * kb, 32 * nb, 32 * nb, scr, F.lane); }
    }
}

__device__ __forceinline__ void p0b_norm(Frame& F, const Ptrs& P) {
    const int gt = F.vcu * NWAVES * 64 + F.tid, NGT = F.G * NWAVES * 64;
    for (int i = gt; i < BATCH * D; i += NGT) { const int b = i >> 10, col = i & 1023; P.a2[i] = P.norm2_g[col] * (1.f + P.mod[(size_t)b * NMOD * D + 4 * D + col]); }
    const int gw = F.vcu * NWAVES + F.wave, NGW = F.G * NWAVES;
    for (int rb = gw; rb < M / 16; rb += NGW) {
        const int b = (rb * 16) / SEQ; const float* mb = P.mod + (size_t)b * NMOD * D;
        f32x4 av[4], sv[4];
#pragma unroll
        for (int j = 0; j < 4; ++j) { const int col = 256 * j + 4 * F.lane; const f32x4 g = *(const f32x4*)(P.norm1_g + col), sc = *(const f32x4*)(mb + D + col); av[j] = g * (sc + 1.0f); sv[j] = *(const f32x4*)(mb + col); }
        for (int rr = 0; rr < 16; rr += 4) {
            f32x4 v[4][4]; float s[4];
#pragma unroll
            for (int q = 0; q < 4; ++q) { const GAS f32x4* xr = (const GAS f32x4*)(P.x + (size_t)(rb * 16 + rr + q) * D) + F.lane;
#pragma unroll
                for (int j = 0; j < 4; ++j) v[q][j] = NTLOAD(xr + 64 * j); }
#pragma unroll
            for (int q = 0; q < 4; ++q) { float t = 0.f;
#pragma unroll
                for (int j = 0; j < 4; ++j) t += (v[q][j][0] * v[q][j][0] + v[q][j][1] * v[q][j][1]) + (v[q][j][2] * v[q][j][2] + v[q][j][3] * v[q][j][3]);
                s[q] = t; }
#pragma unroll
            for (int o = 1; o < 64; o <<= 1) {
#pragma unroll
                for (int q = 0; q < 4; ++q) s[q] += __shfl_xor(s[q], o); }
#pragma unroll
            for (int q = 0; q < 4; ++q) { const float r = rsqrtf(s[q] * (1.f / D) + EPS);
                GAS unsigned long long* o8 = (GAS unsigned long long*)(P.XN + (size_t)(rb * 16 + rr + q) * D) + F.lane;
#pragma unroll
                for (int j = 0; j < 4; ++j) { const f32x4 y = v[q][j] * r * av[j] + sv[j]; o8[64 * j] = (unsigned long long)pk2(y[0], y[1]) | ((unsigned long long)pk2(y[2], y[3]) << 32); } }
        }
    }
}
__device__ __forceinline__ int crow(int r, int hi) { return (r & 3) + 8 * (r >> 2) + 4 * hi; }
__device__ __forceinline__ unsigned cvtpk(float lo, float hi) { unsigned r; asm volatile("v_cvt_pk_bf16_f32 %0, %1, %2" : "=v"(r) : "v"(lo), "v"(hi)); return r; }
typedef short v4i16_t __attribute__((ext_vector_type(4)));
__device__ __forceinline__ s16x4 vtr(LAS const unsigned char* p) { return __builtin_bit_cast(s16x4, __builtin_amdgcn_ds_read_tr16_b64_v4i16((LAS v4i16_t*)p)); }

struct AttnRegs { v4u k[3], v[3]; bf16x8 q[4]; };
__device__ __forceinline__ void attn_load(Frame& F, const Ptrs& P, int unit, AttnRegs& R) {
    const int lane = F.lane, wid = F.wave, r32 = lane & 31, hi = lane >> 5;
    const int bk = unit >> 6, qb = unit & 63, b = bk >> 1, kvh = bk & 1, wh = wid & 1, hq = kvh * 4 + (wid >> 1);
    const long rowbase = (long)b * SEQ; const int q0 = qb * 64, kv0 = q0 - 128, qw0 = q0 + 32 * wh;
#pragma unroll
    for (int i = 0; i < 3; ++i) { const int kvr = kv0 + 64 * i + lane, kc = kvr < 0 ? 0 : kvr; const v4u t = *(const GAS v4u*)(P.K + (rowbase + kc) * KVW + kvh * 64 + wid * 8); const unsigned mk = kvr < 0 ? 0u : 0xffffffffu; R.k[i] = (v4u){t.x & mk, t.y & mk, t.z & mk, t.w & mk}; }
#pragma unroll
    for (int i = 0; i < 3; ++i) { const int kvr = kv0 + 64 * i + 16 * (wid & 3) + (lane >> 2), kc = kvr < 0 ? 0 : kvr; const v4u t = *(const GAS v4u*)(P.V + (rowbase + kc) * KVW + kvh * 64 + (wid >> 2) * 32 + (lane & 3) * 8); const unsigned mk = kvr < 0 ? 0u : 0xffffffffu; R.v[i] = (v4u){t.x & mk, t.y & mk, t.z & mk, t.w & mk}; }
    const bf16* Qw = P.Q + (rowbase + qw0 + r32) * AW + hq * 64 + hi * 8;
#pragma unroll
    for (int d0 = 0; d0 < 4; ++d0) R.q[d0] = *(const GAS bf16x8*)(Qw + d0 * 16);
}
__device__ __forceinline__ void attn_compute(Frame& F, const Ptrs& P, int unit, const bf16x8 (&qr)[4]) {
    const int lane = F.lane, wid = F.wave, r32 = lane & 31, hi = lane >> 5;
    const int bk = unit >> 6, qb = unit & 63, b = bk >> 1, kvh = bk & 1, wh = wid & 1, hq = kvh * 4 + (wid >> 1);
    const long rowbase = (long)b * SEQ; const int q0 = qb * 64, qw0 = q0 + 32 * wh;
    LAS unsigned char* lds = F.lds;
    f32x16 p[5];
#pragma unroll
    for (int j = 0; j < 5; ++j) {
        const int hb = wh + j; const LAS unsigned char* kp = lds + ATT_K + (hb >> 1) * 8192 + hi * 1024 + ((hb & 1) * 32 + r32) * 16;
        f32x16 a = {0.f, 0.f, 0.f, 0.f, 0.f, 0.f, 0.f, 0.f, 0.f, 0.f, 0.f, 0.f, 0.f, 0.f, 0.f, 0.f};
#pragma unroll
        for (int d0 = 0; d0 < 4; ++d0) { const bf16x8 kf = *(const LAS bf16x8*)(kp + d0 * 2048); a = __builtin_amdgcn_mfma_f32_32x32x16_bf16(kf, qr[d0], a, 0, 0, 0); }
        p[j] = a;
    }
    const float NEG = -INFINITY;
#pragma unroll
    for (int j = 0; j < 5; ++j) {
        const bool valid = (qw0 - 128 + 32 * j) >= 0;
#pragma unroll
        for (int r = 0; r < 16; ++r) { bool keep = valid; if (j == 0) keep = keep && (crow(r, hi) > r32); if (j == 4) keep = keep && (crow(r, hi) <= r32); if (!keep) p[j][r] = NEG; }
    }
    const float sinkl2 = P.sinks[hq] * 1.4426950408889634f;
    float mx = sinkl2;
#pragma unroll
    for (int j = 0; j < 5; ++j)
#pragma unroll
        for (int r = 0; r < 16; ++r) mx = fmaxf(mx, p[j][r]);
    { auto rr = __builtin_amdgcn_permlane32_swap(__float_as_uint(mx), __float_as_uint(mx), false, false); mx = fmaxf(__uint_as_float(rr[0]), __uint_as_float(rr[1])); }
    float l = 0.f;
#pragma unroll
    for (int j = 0; j < 5; ++j)
#pragma unroll
        for (int r = 0; r < 16; ++r) { const float e = __builtin_amdgcn_exp2f(p[j][r] - mx); p[j][r] = e; l += e; }
    { auto rr = __builtin_amdgcn_permlane32_swap(__float_as_uint(l), __float_as_uint(l), false, false); l = __uint_as_float(rr[0]) + __uint_as_float(rr[1]); }
    l += __builtin_amdgcn_exp2f(sinkl2 - mx);
    f32x16 o[2];
    o[0] = (f32x16){0.f, 0.f, 0.f, 0.f, 0.f, 0.f, 0.f, 0.f, 0.f, 0.f, 0.f, 0.f, 0.f, 0.f, 0.f, 0.f}; o[1] = o[0];
    const LAS unsigned char* vb = lds + ATT_V + ((lane >> 4) & 1) * 32 + (lane & 3) * 8 + (4 * hi + ((lane & 15) >> 2)) * 64;
#pragma unroll
    for (int j = 0; j < 5; ++j) {
        const int hb = wh + j; const LAS unsigned char* vt = vb + (hb >> 1) * 8192 + (hb & 1) * 2048;
#pragma unroll
        for (int s = 0; s < 2; ++s) {
            v4u pw; pw.x = cvtpk(p[j][8 * s + 0], p[j][8 * s + 1]); pw.y = cvtpk(p[j][8 * s + 2], p[j][8 * s + 3]); pw.z = cvtpk(p[j][8 * s + 4], p[j][8 * s + 5]); pw.w = cvtpk(p[j][8 * s + 6], p[j][8 * s + 7]);
            const bf16x8 pf = __builtin_bit_cast(bf16x8, pw);
#pragma unroll
            for (int d0 = 0; d0 < 2; ++d0) {
                const s16x4 lo = vtr(vt + d0 * 4096 + s * 1024), hh = vtr(vt + d0 * 4096 + s * 1024 + 512);
                const bf16x8 vf = (bf16x8){lo[0], lo[1], lo[2], lo[3], hh[0], hh[1], hh[2], hh[3]};
                o[d0] = __builtin_amdgcn_mfma_f32_32x32x16_bf16(pf, vf, o[d0], 0, 0, 0);
            }
        }
    }
    LAS float* wsf = (LAS float*)(lds + ATT_WS) + wid * 64;
    if (hi == 0) wsf[r32] = l;
    LDS_WAIT(); asm volatile("" ::: "memory");
    float rli[16];
#pragma unroll
    for (int r = 0; r < 16; ++r) rli[r] = __builtin_amdgcn_rcpf(wsf[crow(r, hi)]);
    LAS bf16* stg = (LAS bf16*)(lds + ATT_OST) + wid * 2048;
#pragma unroll
    for (int r = 0; r < 16; ++r) { const int orow = crow(r, hi);
#pragma unroll
        for (int d0 = 0; d0 < 2; ++d0) stg[orow * 64 + d0 * 32 + r32] = (bf16)f2bf(o[d0][r] * rli[r]); }
    LDS_WAIT(); asm volatile("" ::: "memory");
    bf16* Ow = P.MIX + (rowbase + qw0) * D + hq * 64;
#pragma unroll
    for (int i = 0; i < 4; ++i) { const int row = i * 8 + (lane >> 3), ch = lane & 7; const v4u v = *(const LAS v4u*)(stg + row * 64 + ch * 8); *(GAS v4u*)(Ow + (size_t)row * D + ch * 8) = v; }
}
__device__ __forceinline__ void unpack8(const v4u w, float (&f)[8]) { f[0] = bflo(w.x); f[1] = bfhi(w.x); f[2] = bflo(w.y); f[3] = bfhi(w.y); f[4] = bflo(w.z); f[5] = bfhi(w.z); f[6] = bflo(w.w); f[7] = bfhi(w.w); }
template <int W> __device__ __forceinline__ void pool_task_w(Frame& F, const Ptrs& P, int g, int rb) {
    const int ch = F.lane & 15, run = F.lane >> 4;
    const int t0 = (rb * 64 + run * 16) & (SEQ - 1);
    const GAS char* ub = (const GAS char*)(P.U + (size_t)(rb * 64) * PW + g * 128);
    GAS char* ob = (GAS char*)(P.MIX + (size_t)(rb * 64) * D + AW + g * 128);
    const unsigned loff = (unsigned)((run * 16 * PW + ch * 8) * 2), ooff = (unsigned)((run * 16 * D + ch * 8) * 2);
    v4u cur[16], prev[W];
#pragma unroll
    for (int i = 0; i < 16; ++i) cur[i] = *(const GAS v4u*)(ub + (size_t)i * (PW * 2) + loff);
#pragma unroll
    for (int j = 1; j <= W; ++j) { const bool ok = (t0 - j) >= 0; const v4u t = *(const GAS v4u*)(ub + loff - (ok ? (size_t)j * (PW * 2) : (size_t)0)); const unsigned mk = ok ? 0xffffffffu : 0u; prev[j - 1] = (v4u){t.x & mk, t.y & mk, t.z & mk, t.w & mk}; }
    float S[8];
#pragma unroll
    for (int e = 0; e < 8; ++e) S[e] = 0.f;
#pragma unroll
    for (int j = 1; j <= W; ++j) { float f[8]; unpack8(prev[j - 1], f);
#pragma unroll
        for (int e = 0; e < 8; ++e) S[e] += f[e]; }
#pragma unroll
    for (int i = 0; i < 16; ++i) {
        const int t = t0 + i; float u[8]; unpack8(cur[i], u);
        float f[8]; unpack8(i < W ? prev[(W - 1 - i) >= 0 ? (W - 1 - i) : 0] : cur[(i - W) >= 0 ? (i - W) : 0], f);
#pragma unroll
        for (int e = 0; e < 8; ++e) S[e] += u[e] - f[e];
        const float inv = 1.0f / (float)((t + 1) < W ? (t + 1) : W);
        v4u o; o.x = pk2(S[0] * inv - u[0], S[1] * inv - u[1]); o.y = pk2(S[2] * inv - u[2], S[3] * inv - u[3]); o.z = pk2(S[4] * inv - u[4], S[5] * inv - u[5]); o.w = pk2(S[6] * inv - u[6], S[7] * inv - u[7]);
        *(GAS v4u*)(ob + (size_t)i * (D * 2) + ooff) = o;
    }
}
__device__ __forceinline__ void pool_task(Frame& F, const Ptrs& P, int task) {
    const int g = task & 3, rb = task >> 2;
    if (g == 0) pool_task_w<2>(F, P, 0, rb); else if (g == 1) pool_task_w<4>(F, P, 1, rb); else if (g == 2) pool_task_w<8>(F, P, 2, rb); else pool_task_w<16>(F, P, 3, rb);
}
__device__ __forceinline__ void p2_attn_pool(Frame& F, const Ptrs& P, int sub) {
    constexpr int NUNITS = BATCH * NKV * (SEQ / 64);
    const int upw = (NUNITS + F.G - 1) / F.G, first = F.vcu * upw;
    int n = NUNITS - first; n = n < 0 ? 0 : (n > upw ? upw : n);
    if (!(sub & 1)) n = 0;
    AttnRegs R;
    if (n > 0) attn_load(F, P, first, R);
    for (int i = 0; i < n; ++i) {
        bf16x8 qr[4];
#pragma unroll
        for (int d0 = 0; d0 < 4; ++d0) qr[d0] = R.q[d0];
#pragma unroll
        for (int t = 0; t < 3; ++t) { *(LAS v4u*)(F.lds + ATT_K + t * 8192 + F.wave * 1024 + F.lane * 16) = R.k[t]; *(LAS v4u*)(F.lds + ATT_V + t * 8192 + F.wave * 1024 + F.lane * 16) = R.v[t]; }
        __syncthreads();
        if (i + 1 < n) attn_load(F, P, first + i + 1, R);
        attn_compute(F, P, first + i, qr);
        __syncthreads();
    }
    const int gw = F.vcu * NWAVES + F.wave, NGW = F.G * NWAVES;
    if (sub & 2) for (int t = gw; t < 4 * (M / 64); t += NGW) pool_task(F, P, t);
}

struct Args { const void* in[16]; float* out; unsigned char* ws; int ph_lo, ph_hi, sub, pad; };
__global__ void __launch_bounds__(NWAVES * 64, 2) fwd_megakernel(Args args) {
    extern __shared__ __attribute__((aligned(16))) unsigned char lds[];
    Frame F;
    F.lds = (LAS unsigned char*)lds;
    F.tid = threadIdx.x; F.lane = F.tid & 63; F.wave = __builtin_amdgcn_readfirstlane(F.tid >> 6);
    F.G = gridDim.x; { const int bx = blockIdx.x; F.vcu = (F.G % 8 == 0) ? (bx % 8) * (F.G / 8) + bx / 8 : bx; }
    unsigned char* ws = args.ws;
    Ptrs P;
    P.x = (const float*)args.in[0]; P.c = (const float*)args.in[1]; P.positions = (const int*)args.in[2]; P.w_ada = (const float*)args.in[3]; P.b_ada = (const float*)args.in[4];
    P.norm1_g = (const float*)args.in[5]; P.w_in = (const float*)args.in[6]; P.q_norm_g = (const float*)args.in[7]; P.k_norm_g = (const float*)args.in[8]; P.sinks = (const float*)args.in[9];
    P.pool_w = (const float*)args.in[10]; P.pool_scale = (const float*)args.in[11]; P.w_o = (const float*)args.in[12]; P.norm2_g = (const float*)args.in[13]; P.w1 = (const float*)args.in[14]; P.w2 = (const float*)args.in[15];
    P.out = args.out; P.mod = (float*)(ws + WS_MOD); P.bias2 = (float*)(ws + WS_BIAS2); P.a2 = (float*)(ws + WS_A2); P.rope = (float*)(ws + WS_ROPE); P.stats = (float*)(ws + WS_STATS);
    P.Win_t = (bf16*)(ws + WS_WIN); P.Wo_t = (bf16*)(ws + WS_WO); P.W1b = (bf16*)(ws + WS_W1B); P.W2_t = (bf16*)(ws + WS_W2);
    P.XN = (bf16*)(ws + WS_XN); P.Q = (bf16*)(ws + WS_Q); P.K = (bf16*)(ws + WS_K); P.V = (bf16*)(ws + WS_V); P.U = (bf16*)(ws + WS_U); P.MIX = (bf16*)(ws + WS_MIX); P.XB1 = (bf16*)(ws + WS_XB1); P.Z2 = (bf16*)(ws + WS_Z2); P.H = (bf16*)(ws + WS_H);
    volatile LAS unsigned* MISC = (volatile LAS unsigned*)(F.lds + MISC_OFF);
    if (F.tid < 64) MISC[F.tid] = 0u;
    __syncthreads();
    XcdBarrier bar; bar.bar = (unsigned*)(ws + WS_CTL) + CW_BAR; bar.x = 0; bar.st = nullptr;
    if (N_LAUNCHES == 1) bar = xcd_barrier_post((unsigned*)(ws + WS_CTL) + CW_BAR, MISC + 8);
    const int lo = args.ph_lo, hi = args.ph_hi;
#define IN(k) (lo <= (k) && (k) < hi)
#if TS_PHASE >= -1
    unsigned long long* const tsp = (unsigned long long*)(ws + 61440);
#define STAMP(i) do { if (blockIdx.x == 0 && F.tid == 0) tsp[i] = __builtin_amdgcn_s_memrealtime(); } while (0)
#else
#define STAMP(i) do { } while (0)
#endif
#define SEAM(k) do { if (IN(k) && IN((k) + 1)) { xcd_barrier(bar); STAMP((k) + 1); } } while (0)
    STAMP(0);

    if (IN(0)) { p0a_prologue(F, P); SEAM(0); }
    if (IN(1)) { p0b_norm(F, P); SEAM(1); }
    if (IN(2)) {
        pg8::Gemm g{P.XN, P.Win_t, M, INW, D, 0, 0}; pg8::StaticOrder S; S.init(M, INW, F.G, (int)blockIdx.x);
        pg8::EpiProj E{P.Q, P.K, P.V, P.U, P.rope, P.q_norm_g, P.k_norm_g};
        pg8::gemm_phase<pg8::EpiProj, pg8::StaticOrder, true, true>(F.lds, g, S, E);
        { const int nwg = (M / 256) * (INW / 256), rem = nwg % F.G;
          if (rem == 0) p1_tail_work(F, P, (int)blockIdx.x, F.G); else if ((int)blockIdx.x >= rem) p1_tail_work(F, P, (int)blockIdx.x - rem, F.G - rem); }
        SEAM(2);
    }
    if (IN(3)) { p2_attn_pool(F, P, args.sub); SEAM(3); }
    if (IN(4)) {
        pg8::Gemm g{P.MIX, P.Wo_t, M, D, D, 0, 0}; pg8::StaticOrder S; S.init(M, D, F.G, (int)blockIdx.x);
        pg8::EpiWo E{P.x, P.XB1, P.mod, P.stats, P.Z2, P.a2};
        pg8::gemm_phase<pg8::EpiWo, pg8::StaticOrder, true, true>(F.lds, g, S, E);
        SEAM(4);
    }
    if (IN(5)) {
        pg8::Gemm g{P.Z2, P.W1b, M, FF, D, 0, 0}; pg8::StaticOrder S; S.init(M, FF, F.G, (int)blockIdx.x);
        pg8::EpiUp E{P.H, P.stats, P.bias2, FF};
        pg8::gemm_phase<pg8::EpiUp, pg8::StaticOrder, true, true>(F.lds, g, S, E);
        SEAM(5);
    }
    if (IN(6)) {
        pg8::Gemm g{P.H, P.W2_t, M, D, FF, 0, 0}; pg8::StaticOrder S; S.init(M, D, F.G, (int)blockIdx.x);
        pg8::EpiDown E{P.out, P.XB1, P.mod};
        pg8::gemm_phase<pg8::EpiDown, pg8::StaticOrder, true, true>(F.lds, g, S, E);
    }
#if TS_PHASE >= -1
    xcd_barrier(bar); STAMP(7); __syncthreads();
    if (blockIdx.x == 0) { __builtin_amdgcn_fence(__ATOMIC_ACQUIRE, "agent");
        unsigned n = (TS_PHASE < 0) ? 100000u : (unsigned)(__hip_atomic_load(tsp + (TS_PHASE == 9 ? 7 : TS_PHASE + 1), __ATOMIC_RELAXED, __HIP_MEMORY_SCOPE_AGENT) - __hip_atomic_load(tsp + ((TS_PHASE < 0 || TS_PHASE == 9) ? 0 : TS_PHASE), __ATOMIC_RELAXED, __HIP_MEMORY_SCOPE_AGENT)) * (unsigned)TS_SCALE;
        if (TS_BUCKET > 0) n = ((n / TS_SCALE + TS_OFFSET) / TS_BUCKET) * 10000u;
        for (unsigned i = F.tid; i < n && i < 130000u; i += NWAVES * 64) P.out[(size_t)i * 257] += 0.125f; }
#endif
#undef IN
#undef SEAM
}

#ifndef HYB
extern "C" void kernel_launch(void* const* d_in, const int* in_sizes, int n_in, void* d_out, int out_size, void* d_ws, size_t ws_size, hipStream_t stream) {
    static int grid = 0;
    if (grid == 0) {
        if (n_in != 16 || out_size != M * D || ws_size < WS_END) { fprintf(stderr, "kernel_launch: unexpected shapes (n_in %d out %d ws %zu)\n", n_in, out_size, ws_size); grid = -1; return; }
        int dev = 0, cus = 0, per_cu = 0;
        if (hipGetDevice(&dev) != hipSuccess || hipDeviceGetAttribute(&cus, hipDeviceAttributeMultiprocessorCount, dev) != hipSuccess) { grid = -1; return; }
        if (hipFuncSetAttribute((const void*)fwd_megakernel, hipFuncAttributeMaxDynamicSharedMemorySize, LDS_BYTES) != hipSuccess) { fprintf(stderr, "kernel_launch: hipFuncSetAttribute failed\n"); grid = -1; return; }
        if (hipOccupancyMaxActiveBlocksPerMultiprocessor(&per_cu, (const void*)fwd_megakernel, NWAVES * 64, LDS_BYTES) != hipSuccess || per_cu < 1) { fprintf(stderr, "kernel_launch: occupancy query says %d\n", per_cu); per_cu = 1; }
        (void)hipGetLastError();
        if (per_cu > 1) per_cu = 1;
        grid = cus * per_cu;
    }
    if (grid < 0) return;
    (void)hipMemsetAsync((char*)d_ws + WS_CTL, 0, CTL_ZERO_BYTES, stream);
#ifdef EXTRA_MEMSET
    for (int i = 0; i < EXTRA_MEMSET; ++i) (void)hipMemsetAsync((char*)d_ws + WS_CTL + CTL_ZERO_BYTES, 0, 4096, stream);
#endif
    Args a{};
    for (int i = 0; i < 16; ++i) a.in[i] = d_in[i];
    a.out = (float*)d_out; a.ws = (unsigned char*)d_ws; a.sub = 7;
    if (N_LAUNCHES == 1 && DUP_PHASE == 6) {
        a.ph_lo = 0; a.ph_hi = N_PHASES; hipLaunchKernelGGL(fwd_megakernel, dim3(grid), dim3(NWAVES * 64), LDS_BYTES, stream, a);
        (void)hipMemsetAsync((char*)d_ws + WS_CTL, 0, CTL_ZERO_BYTES, stream);
        a.out = (float*)((char*)d_ws + WS_W1B); a.ph_lo = 6; a.ph_hi = 7; hipLaunchKernelGGL(fwd_megakernel, dim3(grid), dim3(NWAVES * 64), LDS_BYTES, stream, a);
    } else if (N_LAUNCHES == 1 && DUP_PHASE >= 0) {
        a.ph_lo = 0; a.ph_hi = DUP_PHASE + 1; hipLaunchKernelGGL(fwd_megakernel, dim3(grid), dim3(NWAVES * 64), LDS_BYTES, stream, a);
        (void)hipMemsetAsync((char*)d_ws + WS_CTL, 0, CTL_ZERO_BYTES, stream);
        a.sub = DUP_SUB; a.ph_lo = DUP_PHASE; a.ph_hi = DUP_PHASE + 1; hipLaunchKernelGGL(fwd_megakernel, dim3(grid), dim3(NWAVES * 64), LDS_BYTES, stream, a);
        (void)hipMemsetAsync((char*)d_ws + WS_CTL, 0, CTL_ZERO_BYTES, stream);
        a.sub = 7; a.ph_lo = DUP_PHASE + 1; a.ph_hi = N_PHASES; hipLaunchKernelGGL(fwd_megakernel, dim3(grid), dim3(NWAVES * 64), LDS_BYTES, stream, a);
    } else if (N_LAUNCHES == 1) { a.ph_lo = 0; a.ph_hi = N_PHASES; hipLaunchKernelGGL(fwd_megakernel, dim3(grid), dim3(NWAVES * 64), LDS_BYTES, stream, a); }
    else for (int li = 0; li < N_PHASES; ++li) { a.ph_lo = li; a.ph_hi = li + 1; hipLaunchKernelGGL(fwd_megakernel, dim3(grid), dim3(NWAVES * 64), LDS_BYTES, stream, a); }
}
#endif

#ifdef HYB
__global__ void dbg_norm(const float* __restrict__ x, const float* __restrict__ g, const float* __restrict__ mod, int sh_off, int sc_off, bf16* __restrict__ out) {
    const int wave = (blockIdx.x * blockDim.x + threadIdx.x) >> 6, lane = threadIdx.x & 63;
    if (wave >= M) return;
    const int b = wave / SEQ; const float* xr = x + (size_t)wave * D;
    float v[16]; float s = 0.f;
#pragma unroll
    for (int j = 0; j < 4; ++j) { const f32x4 t = *(const f32x4*)(xr + j * 256 + lane * 4); v[4 * j] = t[0]; v[4 * j + 1] = t[1]; v[4 * j + 2] = t[2]; v[4 * j + 3] = t[3]; s += t[0] * t[0] + t[1] * t[1] + t[2] * t[2] + t[3] * t[3]; }
    s = wave_sum(s);
    const float r = rsqrtf(s * (1.f / D) + EPS); const float* mb = mod + (size_t)b * NMOD * D;
#pragma unroll
    for (int j = 0; j < 4; ++j)
#pragma unroll
        for (int i = 0; i < 4; ++i) { const int col = j * 256 + lane * 4 + i; const float y = v[4 * j + i] * r * g[col] * (1.f + mb[sc_off + col]) + mb[sh_off + col]; out[(size_t)wave * D + col] = (bf16)f2bf(y); }
}
template <int MODE>
__global__ __launch_bounds__(256) void dbg_gemm(const bf16* __restrict__ A, const float* __restrict__ B, int N, int K, void* Cout, const float* X, const float* __restrict__ mod, int gate_off) {
    __shared__ __attribute__((aligned(16))) bf16 sA[128][40];
    __shared__ __attribute__((aligned(16))) bf16 sB[128][40];
    const int tid = threadIdx.x, lane = tid & 63, w = tid >> 6, wr = w >> 1, wc = w & 1;
    const int m0 = blockIdx.y * 128, n0 = blockIdx.x * 128;
    f32x4 acc[4][4];
#pragma unroll
    for (int i = 0; i < 4; ++i)
#pragma unroll
        for (int j = 0; j < 4; ++j) acc[i][j] = (f32x4){0.f, 0.f, 0.f, 0.f};
    for (int k0 = 0; k0 < K; k0 += 32) {
        { const int r = tid >> 1, cc = (tid & 1) * 16; const bf16x8* src = (const bf16x8*)(A + (size_t)(m0 + r) * K + k0 + cc); *(bf16x8*)&sA[r][cc] = src[0]; *(bf16x8*)&sA[r][cc + 8] = src[1]; }
        { const int kk = tid >> 3, nn = (tid & 7) * 16; const float* src = B + (size_t)(k0 + kk) * N + n0 + nn;
#pragma unroll
          for (int i = 0; i < 16; ++i) sB[nn + i][kk] = (bf16)f2bf(src[i]); }
        __syncthreads();
        bf16x8 a[4], b[4];
#pragma unroll
        for (int i = 0; i < 4; ++i) a[i] = *(const bf16x8*)&sA[wr * 64 + i * 16 + (lane & 15)][8 * (lane >> 4)];
#pragma unroll
        for (int j = 0; j < 4; ++j) b[j] = *(const bf16x8*)&sB[wc * 64 + j * 16 + (lane & 15)][8 * (lane >> 4)];
#pragma unroll
        for (int i = 0; i < 4; ++i)
#pragma unroll
            for (int j = 0; j < 4; ++j) acc[i][j] = __builtin_amdgcn_mfma_f32_16x16x32_bf16(a[i], b[j], acc[i][j], 0, 0, 0);
        __syncthreads();
    }
#pragma unroll
    for (int i = 0; i < 4; ++i)
#pragma unroll
        for (int j = 0; j < 4; ++j)
#pragma unroll
            for (int r = 0; r < 4; ++r) {
                const int row = m0 + wr * 64 + i * 16 + (lane >> 4) * 4 + r, col = n0 + wc * 64 + j * 16 + (lane & 15);
                const float v = acc[i][j][r]; const size_t o = (size_t)row * N + col;
                if (MODE == 0) ((bf16*)Cout)[o] = (bf16)f2bf(v);
                else if (MODE == 2) { const float t = v > 0.f ? v : 0.f; ((bf16*)Cout)[o] = (bf16)f2bf(t * t); }
                else { const int b_ = row / SEQ; const float gt = mod[(size_t)b_ * NMOD * D + gate_off + col]; const float base = (MODE == 1) ? X[o] : ((float*)Cout)[o]; ((float*)Cout)[o] = base + gt * v; }
            }
}
__global__ __launch_bounds__(64) void dbg_attn(const bf16* __restrict__ Q, const bf16* __restrict__ Kb, const bf16* __restrict__ Vb, const float* __restrict__ sinks, bf16* __restrict__ MIX) {
    const int id = blockIdx.x * blockDim.x + threadIdx.x;
    if (id >= M * NH) return;
    const int m = id / NH, hq = id % NH, kvh = hq / 4, b = m / SEQ, t = m % SEQ;
    float q[64], acc[64];
#pragma unroll
    for (int d = 0; d < 64; ++d) { q[d] = bf2f(Q[(size_t)m * AW + hq * 64 + d]); acc[d] = 0.f; }
    float mx = -1e30f, l = 0.f;
    const int j0 = t - 127 < 0 ? 0 : t - 127;
    for (int j = j0; j <= t; ++j) {
        const size_t kr = (size_t)(b * SEQ + j); float s = 0.f;
#pragma unroll
        for (int d = 0; d < 64; ++d) s += q[d] * bf2f(Kb[kr * KVW + kvh * 64 + d]);
        s *= 0.6931471805599453f;
        const float mn = fmaxf(mx, s); const float f = __expf(mx - mn), p = __expf(s - mn);
        l = l * f + p;
#pragma unroll
        for (int d = 0; d < 64; ++d) acc[d] = acc[d] * f + p * bf2f(Vb[kr * KVW + kvh * 64 + d]);
        mx = mn;
    }
    const float sk = sinks[hq]; const float mn = fmaxf(mx, sk); const float f = __expf(mx - mn);
    l = l * f + __expf(sk - mn);
    const float inv = f / l;
#pragma unroll
    for (int d = 0; d < 64; ++d) MIX[(size_t)m * D + hq * 64 + d] = (bf16)f2bf(acc[d] * inv);
}
__global__ void dbg_pool(const bf16* __restrict__ U, bf16* __restrict__ POOLED) {
    const int id = blockIdx.x * blockDim.x + threadIdx.x;
    if (id >= M * PW) return;
    const int m = id / PW, c = id % PW, g = c / 128, w = 2 << g, t = m % SEQ;
    const int cnt = (t + 1) < w ? (t + 1) : w; float s = 0.f;
    for (int j = 0; j < cnt; ++j) s += bf2f(U[(size_t)(m - j) * PW + c]);
    POOLED[(size_t)m * PW + c] = (bf16)f2bf(s / (float)cnt - bf2f(U[(size_t)m * PW + c]));
}
__global__ void dbg_copy_pooled(const bf16* __restrict__ MIX, bf16* __restrict__ POOLED) {
    const int id = blockIdx.x * blockDim.x + threadIdx.x;
    if (id >= M * PW) return;
    POOLED[id] = MIX[(size_t)(id / PW) * D + AW + (id % PW)];
}
__global__ void dbg_poolmm(const bf16* __restrict__ POOLED, const float* __restrict__ pool_w, const float* __restrict__ pool_scale, bf16* __restrict__ MIX) {
    const int id = blockIdx.x * blockDim.x + threadIdx.x;
    if (id >= M * PW) return;
    const int m = id / PW, c = id % PW, g = c / 128, d = c % 128; float s = 0.f;
    for (int k = 0; k < 128; ++k) s += bf2f(POOLED[(size_t)m * PW + g * 128 + k]) * pool_w[(size_t)(g * 128 + k) * 128 + d];
    MIX[(size_t)m * D + AW + c] = (bf16)f2bf(s * pool_scale[c]);
}
extern "C" void kernel_launch(void* const* d_in, const int* in_sizes, int n_in, void* d_out, int out_size, void* d_ws, size_t ws_size, hipStream_t stream) {
    static int grid = 0;
    if (grid == 0) {
        hipFuncSetAttribute((const void*)fwd_megakernel, hipFuncAttributeMaxDynamicSharedMemorySize, LDS_BYTES);
        grid = 256;
    }
    (void)hipMemsetAsync((char*)d_ws + WS_CTL, 0, CTL_ZERO_BYTES, stream);
    Args a{};
    for (int i = 0; i < 16; ++i) a.in[i] = d_in[i];
    a.out = (float*)d_out; a.ws = (unsigned char*)d_ws;
    unsigned char* ws = (unsigned char*)d_ws;
    const float* x = (const float*)d_in[0]; const float* sinks = (const float*)d_in[9]; const float* pool_w = (const float*)d_in[10]; const float* pool_scale = (const float*)d_in[11];
    const float* w_o = (const float*)d_in[12]; const float* norm2_g = (const float*)d_in[13]; const float* w1 = (const float*)d_in[14]; const float* w2 = (const float*)d_in[15];
    float* out = (float*)d_out; float* mod = (float*)(ws + WS_MOD);
    bf16 *Q = (bf16*)(ws + WS_Q), *Kb = (bf16*)(ws + WS_K), *Vb = (bf16*)(ws + WS_V), *U = (bf16*)(ws + WS_U), *MIX = (bf16*)(ws + WS_MIX), *Z2 = (bf16*)(ws + WS_XB1), *H = (bf16*)(ws + WS_H);
#define PH(lo_, hi_) do { a.ph_lo = lo_; a.ph_hi = hi_; for (int li = lo_; li < hi_; ++li) { a.ph_lo = li; a.ph_hi = li + 1; hipLaunchKernelGGL(fwd_megakernel, dim3(grid), dim3(NWAVES * 64), LDS_BYTES, stream, a); } } while (0)
    PH(0, 3);
#if HYB == 1
    dbg_attn<<<M * NH / 64, 64, 0, stream>>>(Q, Kb, Vb, sinks, MIX);
    dbg_pool<<<M * PW / 256, 256, 0, stream>>>(U, Z2);
#else
    PH(3, 4);
    dbg_copy_pooled<<<M * PW / 256, 256, 0, stream>>>(MIX, Z2);
#endif
    dbg_poolmm<<<M * PW / 256, 256, 0, stream>>>(Z2, pool_w, pool_scale, MIX);
    dbg_gemm<1><<<dim3(D / 128, M / 128), 256, 0, stream>>>(MIX, w_o, D, D, out, x, mod, 2 * D);
    dbg_norm<<<M / 4, 256, 0, stream>>>(out, norm2_g, mod, 3 * D, 4 * D, Z2);
    dbg_gemm<2><<<dim3(FF / 128, M / 128), 256, 0, stream>>>(Z2, w1, FF, D, H, nullptr, mod, 0);
    dbg_gemm<3><<<dim3(D / 128, M / 128), 256, 0, stream>>>(H, w2, D, FF, out, nullptr, mod, 5 * D);
}
#endif
```

```cpp
#define MK_N_LAUNCHES 1
#include <hip/hip_runtime.h>
#include <cstdio>
#include <cstdint>
#include <cmath>
#define MODUNROLL 8
namespace pg8 {
#define PG8_LAS __attribute__((address_space(3)))
typedef unsigned short bf16_t;
typedef short bf16x8 __attribute__((ext_vector_type(8)));
typedef float f32x4 __attribute__((ext_vector_type(4)));
typedef unsigned u32x4 __attribute__((ext_vector_type(4)));
constexpr int BM = 256, BK = 64, HALF = 128, HTB = HALF * BK * 2  , STAGE_BYTES = 8 * HTB, NXCD = 8, WGM = 8;

__host__ __device__ __forceinline__ int lds_byte(int r, int c) { const int st = (r >> 4) * 2 + (c >> 5), rr = r & 15, cc = c & 31, ob = rr * 64 + cc * 2; return st * 1024 + (ob ^ (((ob >> 9) & 1) << 5)); }
__host__ __device__ __forceinline__ void stage_rc(int b, int& R, int& C) { const int st = b / 1024, sb = b % 1024, swz = sb ^ (((sb >> 9) & 1) << 5); R = (st >> 1) * 16 + swz / 64; C = (st & 1) * 32 + (swz % 64) / 2; }
__host__ __device__ __forceinline__ int perm32(int rho) { const int n = rho >> 4, i = rho & 15; return 8 * (i >> 2) + 4 * n + (i & 3); }

struct Unit { int pm, pn; };
struct Gemm { const bf16_t* A; const bf16_t* Bt; int M, N, K; int bshift; size_t bstride; };

struct StaticOrder {
    int nM, nN, nwg, G, c, wgm, rev;
    __host__ __device__ void init(int M, int N, int G_, int c_, int wgm_ = WGM, int rev_ = 0) { nM = M / BM; nN = N / BM; nwg = nM * nN; G = G_; c = c_; wgm = wgm_; rev = (rev_ && nwg % G_ == 0) ? 1 : 0; }
    __host__ __device__ bool next(int i, Unit& u) const {
        if ((long)i * G + c >= nwg) return false;
        const long L = (long)(rev ? (nwg / G - 1 - i) : i) * G + c;
        int wgid = (int)L; { const int q = nwg / NXCD, r = nwg % NXCD, xcd = wgid % NXCD, off = wgid / NXCD; wgid = (xcd < r ? xcd * (q + 1) : r * (q + 1) + (xcd - r) * q) + off; }
        const int nig = wgm * nN, gid = wgid / nig, fm = gid * wgm, gsz = (nM - fm) < wgm ? (nM - fm) : wgm;
        u.pm = fm + ((wgid % nig) % gsz); u.pn = (wgid % nig) / gsz; return true;
    }
    __device__ __forceinline__ void a_ready(const Unit&) const {}
    __device__ __forceinline__ void done(const Unit&) const {}
};

struct BatchOrder : StaticOrder {
    __host__ __device__ bool next(int i, Unit& u) const {
        if (G != 256 || nM != 128 || nN != 16) return StaticOrder::next(i, u);
        if (i >= 8) return false;
        const int x = c & 7, j = c >> 3;
        u.pm = 16 * i + 4 * (x >> 1) + (j & 3); u.pn = 8 * (x & 1) + (j >> 2); return true;
    }
};

__device__ __forceinline__ unsigned cvt_pk_bf16(float lo, float hi) { unsigned r; asm volatile("v_cvt_pk_bf16_f32 %0, %1, %2" : "=v"(r) : "v"(lo), "v"(hi)); return r; }
typedef float f32x2 __attribute__((ext_vector_type(2)));
constexpr int SEQ_ = 4096, DM_ = 1024, NMOD_ = 6;
#ifndef USE_NT
#define USE_NT 1
#endif
#if USE_NT
#define PG8_NTLOAD(p) __builtin_nontemporal_load(p)
#else
#define PG8_NTLOAD(p) (*(p))
#endif
constexpr float EPS_ = 1e-6f;
constexpr float QSCALE = 0.125f * 1.4426950408889634f;

__device__ __forceinline__ u32x4 pack8(const f32x4 a, const f32x4 b) { u32x4 w; w.x = cvt_pk_bf16(a[0], a[1]); w.y = cvt_pk_bf16(a[2], a[3]); w.z = cvt_pk_bf16(b[0], b[1]); w.w = cvt_pk_bf16(b[2], b[3]); return w; }

struct EpiProj {
    static constexpr bool PERM = true, AFTER_DRAIN = false;
    bf16_t *Q, *Kb, *V, *U; const float* rope; const float* qg; const float* kg;
    __device__ __forceinline__ void operator()(const f32x4 (&acc)[2][2][4][2], const Unit& u, int wr, int wc, int fr, int fq) const {
        const int row0 = u.pm * BM + wr * 64 + fr;
        if (u.pn >= 3 || (u.pn == 2 && wc >= 2)) {
            bf16_t* base; int pitch;
            if (u.pn >= 3) { base = U + (u.pn - 3) * 256 + wc * 64 + 8 * fq; pitch = 512; } else { base = V + (wc - 2) * 64 + 8 * fq; pitch = 128; }
#pragma unroll
            for (int ai = 0; ai < 2; ++ai)
#pragma unroll
                for (int m = 0; m < 4; ++m) { bf16_t* rowp = base + (size_t)(row0 + ai * HALF + m * 16) * pitch;
#pragma unroll
                    for (int bj = 0; bj < 2; ++bj) *(u32x4*)(rowp + bj * 32) = pack8(acc[ai][bj][m][0], acc[ai][bj][m][1]); }
        } else {
            const bool isq = u.pn < 2; const float* g = isq ? qg : kg; const float sc = isq ? QSCALE : 1.0f;
            bf16_t* base = isq ? Q + (4 * u.pn + wc) * 64 + 8 * fq : Kb + wc * 64 + 8 * fq; const int pitch = isq ? 512 : 128;
            f32x4 gv[2][2];
#pragma unroll
            for (int bj = 0; bj < 2; ++bj)
#pragma unroll
                for (int n = 0; n < 2; ++n) gv[bj][n] = *(const f32x4*)(g + 32 * bj + 8 * fq + 4 * n);
#pragma unroll
            for (int ai = 0; ai < 2; ++ai)
#pragma unroll
                for (int m = 0; m < 4; ++m) {
                    const int row = row0 + ai * HALF + m * 16;
                    f32x4 cs[2], sn[2];
#pragma unroll
                    for (int n = 0; n < 2; ++n) { cs[n] = *(const f32x4*)(rope + (size_t)row * 16 + 4 * n); sn[n] = *(const f32x4*)(rope + (size_t)row * 16 + 8 + 4 * n); }
                    float ss = 0.f;
#pragma unroll
                    for (int bj = 0; bj < 2; ++bj)
#pragma unroll
                        for (int n = 0; n < 2; ++n) { const f32x4 v = acc[ai][bj][m][n]; ss += (v[0] * v[0] + v[1] * v[1]) + (v[2] * v[2] + v[3] * v[3]); }
                    ss += __shfl_xor(ss, 16); ss += __shfl_xor(ss, 32);
                    const float r = rsqrtf(ss * (1.0f / 64.0f) + EPS_);
                    f32x4 y[2][2];
#pragma unroll
                    for (int bj = 0; bj < 2; ++bj)
#pragma unroll
                        for (int n = 0; n < 2; ++n) y[bj][n] = acc[ai][bj][m][n] * r * gv[bj][n];
#pragma unroll
                    for (int n = 0; n < 2; ++n)
#pragma unroll
                        for (int e = 0; e < 4; ++e) { const float mine = y[0][n][e]; const float other = __shfl_xor(mine, 16);
                            const float ro = (fq == 0) ? mine * cs[n][e] - other * sn[n][e] : mine * cs[n][e] + other * sn[n][e];
                            y[0][n][e] = (fq < 2) ? ro : mine; }
                    bf16_t* rowp = base + (size_t)row * pitch;
#pragma unroll
                    for (int bj = 0; bj < 2; ++bj) *(u32x4*)(rowp + bj * 32) = pack8(y[bj][0] * sc, y[bj][1] * sc);
                }
        }
    }
};

struct EpiWo {
    static constexpr bool PERM = true, AFTER_DRAIN = false;
    const float* x; bf16_t* xb1; const float* mod; float* stats; bf16_t* z; const float* a2;
    __device__ __forceinline__ void operator()(const f32x4 (&acc)[2][2][4][2], const Unit& u, int wr, int wc, int fr, int fq) const {
        const int b = (u.pm * BM) / SEQ_; const int col0 = u.pn * BM + wc * 32 + 8 * fq; const int row0 = u.pm * BM + wr * 64 + fr;
        f32x4 gv[2][2], av[2][2];
#pragma unroll
        for (int bj = 0; bj < 2; ++bj)
#pragma unroll
            for (int n = 0; n < 2; ++n) { gv[bj][n] = *(const f32x4*)(mod + (size_t)b * NMOD_ * DM_ + 2 * DM_ + col0 + bj * HALF + 4 * n); av[bj][n] = z ? *(const f32x4*)(a2 + (size_t)b * DM_ + col0 + bj * HALF + 4 * n) : (f32x4){1.f, 1.f, 1.f, 1.f}; }
#pragma unroll
        for (int ai = 0; ai < 2; ++ai)
#pragma unroll
            for (int m = 0; m < 4; ++m) {
                const int row = row0 + ai * HALF + m * 16; const size_t off = (size_t)row * DM_ + col0; float ss = 0.f;
#pragma unroll
                for (int bj = 0; bj < 2; ++bj) {
                    const f32x4 xa = PG8_NTLOAD((const f32x4*)(x + off + bj * HALF)), xb = PG8_NTLOAD((const f32x4*)(x + off + bj * HALF + 4));
                    const f32x4 v0 = xa + gv[bj][0] * acc[ai][bj][m][0], v1 = xb + gv[bj][1] * acc[ai][bj][m][1];
                    ss += (v0[0] * v0[0] + v0[1] * v0[1]) + (v0[2] * v0[2] + v0[3] * v0[3]) + (v1[0] * v1[0] + v1[1] * v1[1]) + (v1[2] * v1[2] + v1[3] * v1[3]);
                    *(u32x4*)(xb1 + off + bj * HALF) = pack8(v0, v1);
                    if (z) *(u32x4*)(z + off + bj * HALF) = pack8(v0 * av[bj][0], v1 * av[bj][1]);
                }
                ss += __shfl_xor(ss, 16); ss += __shfl_xor(ss, 32);
                if (fq == 0) stats[(size_t)row * 16 + u.pn * 4 + wc] = ss;
            }
    }
};

struct EpiUp {
    static constexpr bool PERM = true, AFTER_DRAIN = false;
    bf16_t* H; const float* stats; const float* bias2; int ldc;
    __device__ __forceinline__ void operator()(const f32x4 (&acc)[2][2][4][2], const Unit& u, int wr, int wc, int fr, int fq) const {
        const int b = (u.pm * BM) / SEQ_; const int col0 = u.pn * BM + wc * 32 + 8 * fq; const int row0 = u.pm * BM + wr * 64 + fr;
        f32x4 bv[2][2];
#pragma unroll
        for (int bj = 0; bj < 2; ++bj)
#pragma unroll
            for (int n = 0; n < 2; ++n) bv[bj][n] = *(const f32x4*)(bias2 + (size_t)b * ldc + col0 + bj * HALF + 4 * n);
#pragma unroll
        for (int ai = 0; ai < 2; ++ai)
#pragma unroll
            for (int m = 0; m < 4; ++m) {
                const int row = row0 + ai * HALF + m * 16;
                const f32x4 st = *(const f32x4*)(stats + (size_t)row * 16 + 4 * fq);
                float s = (st[0] + st[1]) + (st[2] + st[3]); s += __shfl_xor(s, 16); s += __shfl_xor(s, 32);
                const float r = rsqrtf(s * (1.0f / DM_) + EPS_);
                bf16_t* rowp = H + (size_t)row * ldc + col0;
#pragma unroll
                for (int bj = 0; bj < 2; ++bj) {
                    f32x4 v0 = acc[ai][bj][m][0] * r + bv[bj][0], v1 = acc[ai][bj][m][1] * r + bv[bj][1];
#pragma unroll
                    for (int e = 0; e < 4; ++e) { const float t0 = fmaxf(v0[e], 0.f), t1 = fmaxf(v1[e], 0.f); v0[e] = t0 * t0; v1[e] = t1 * t1; }
                    *(u32x4*)(rowp + bj * HALF) = pack8(v0, v1);
                }
            }
    }
};

struct EpiDown {
    static constexpr bool PERM = true, AFTER_DRAIN = false;
    float* out; const bf16_t* xb1; const float* mod;
    __device__ __forceinline__ void operator()(const f32x4 (&acc)[2][2][4][2], const Unit& u, int wr, int wc, int fr, int fq) const {
        const int b = (u.pm * BM) / SEQ_; const int col0 = u.pn * BM + wc * 32 + 8 * fq; const int row0 = u.pm * BM + wr * 64 + fr;
        f32x4 gv[2][2];
#pragma unroll
        for (int bj = 0; bj < 2; ++bj)
#pragma unroll
            for (int n = 0; n < 2; ++n) gv[bj][n] = *(const f32x4*)(mod + (size_t)b * NMOD_ * DM_ + 5 * DM_ + col0 + bj * HALF + 4 * n);
#pragma unroll
        for (int ai = 0; ai < 2; ++ai)
#pragma unroll
            for (int m = 0; m < 4; ++m) {
                const size_t off = (size_t)(row0 + ai * HALF + m * 16) * DM_ + col0;
#pragma unroll
                for (int bj = 0; bj < 2; ++bj) {
                    const u32x4 w = *(const u32x4*)(xb1 + off + bj * HALF);
                    const f32x4 xa = (f32x4){__builtin_bit_cast(float, w.x << 16), __builtin_bit_cast(float, w.x & 0xffff0000u), __builtin_bit_cast(float, w.y << 16), __builtin_bit_cast(float, w.y & 0xffff0000u)};
                    const f32x4 xb = (f32x4){__builtin_bit_cast(float, w.z << 16), __builtin_bit_cast(float, w.z & 0xffff0000u), __builtin_bit_cast(float, w.w << 16), __builtin_bit_cast(float, w.w & 0xffff0000u)};
                    *(f32x4*)(out + off + bj * HALF) = xa + gv[bj][0] * acc[ai][bj][m][0]; *(f32x4*)(out + off + bj * HALF + 4) = xb + gv[bj][1] * acc[ai][bj][m][1];
                }
            }
    }
};

template <class Epi, class Sched, bool ALIGN_EPI = false, bool SP2 = false>
__device__ __forceinline__ void gemm_phase(PG8_LAS unsigned char* lds, const Gemm g, const Sched& S, const Epi& E) {
    const int tid = threadIdx.x, wid = __builtin_amdgcn_readfirstlane(tid >> 6), lane = tid & 63, wr = wid >> 2, wc = wid & 3, fr = lane & 15, fq = lane >> 4;
    const int K = g.K, nt = K / BK;
    unsigned voffA[2], voffB[2];
#pragma unroll
    for (int i = 0; i < 2; ++i) { int R, C; stage_rc(tid * 16 + i * 8192, R, C); const int Rb = Epi::PERM ? ((R & ~31) + perm32(R & 31)) : R;
        voffA[i] = (unsigned)(R * K + C) * 2u; voffB[i] = (unsigned)(Rb * K + C) * 2u; }
    const size_t kstep = (size_t)(BK * 2);
    const size_t hstep = (size_t)HALF * K * 2;
    const size_t tstep = 2 * hstep;
    const unsigned ldsw = (unsigned)wid * 1024u;
    const int aoff = lds_byte(wr * 64 + fr, fq * 8), boff = lds_byte(wc * 32 + fr, fq * 8);
#define PG8_SA(b, h) (((b) * 2 + (h)) * HTB)
#define PG8_SB(b, h) ((4 + (b) * 2 + (h)) * HTB)
#define PG8_STAGE(bufoff, gbase, voff) do { _Pragma("unroll") for (int _i = 0; _i < 2; ++_i) \
        __builtin_amdgcn_global_load_lds((const unsigned*)((const char*)(gbase) + (voff)[_i]), (PG8_LAS unsigned*)(lds + (bufoff) + ldsw + _i * 8192), 16, 0, 0); } while (0)
#define PG8_LDA(dst, b, h) do { _Pragma("unroll") for (int m = 0; m < 4; ++m) _Pragma("unroll") for (int k = 0; k < 2; ++k) dst[m][k] = *(const PG8_LAS bf16x8*)(lds + PG8_SA(b, h) + aoff + m * 2048 + k * 1024); } while (0)
#define PG8_LDB(dst, b, h) do { _Pragma("unroll") for (int n = 0; n < 2; ++n) _Pragma("unroll") for (int k = 0; k < 2; ++k) dst[n][k] = *(const PG8_LAS bf16x8*)(lds + PG8_SB(b, h) + boff + n * 2048 + k * 1024); } while (0)
#define PG8_MMA(ai, bj, At, Bt) do { __builtin_amdgcn_s_setprio(1); _Pragma("unroll") for (int m = 0; m < 4; ++m) _Pragma("unroll") for (int n = 0; n < 2; ++n) _Pragma("unroll") for (int k = 0; k < 2; ++k) \
        acc[ai][bj][m][n] = __builtin_amdgcn_mfma_f32_16x16x32_bf16(Bt[n][k], At[m][k], acc[ai][bj][m][n], 0, 0, 0); __builtin_amdgcn_s_setprio(0); } while (0)
#define PG8_WAIT_V(n) asm volatile("s_waitcnt vmcnt(" #n ")" ::: "memory")
#define PG8_WAIT_L(n) asm volatile("s_waitcnt lgkmcnt(" #n ")" ::: "memory")
#define PG8_BAR __builtin_amdgcn_s_barrier()
#define PG8_SCHED __builtin_amdgcn_sched_barrier(0)
    Unit cur, nxt; int ui = 0;
    if (!S.next(0, cur)) return;
    f32x4 acc[2][2][4][2];
#pragma unroll
    for (int a = 0; a < 2; ++a)
#pragma unroll
        for (int b = 0; b < 2; ++b)
#pragma unroll
            for (int m = 0; m < 4; ++m)
#pragma unroll
                for (int n = 0; n < 2; ++n) acc[a][b][m][n] = (f32x4){0.f, 0.f, 0.f, 0.f};
    bf16x8 At[4][2], B0[2][2], B1[2][2];
    const char* cA = (const char*)g.A + (size_t)cur.pm * tstep; const char* cB = (const char*)(g.Bt + (size_t)(cur.pm >> g.bshift) * g.bstride) + (size_t)cur.pn * tstep;
    S.a_ready(cur);
    if constexpr (SP2) {
        PG8_STAGE(PG8_SB(0, 0), cB, voffB); PG8_STAGE(PG8_SB(0, 1), cB + hstep, voffB); PG8_STAGE(PG8_SA(0, 0), cA, voffA); PG8_STAGE(PG8_SA(0, 1), cA + hstep, voffA);
        if (wr == 1) PG8_BAR;
        PG8_WAIT_V(2); PG8_BAR;
        PG8_STAGE(PG8_SB(1, 0), cB + kstep, voffB); PG8_STAGE(PG8_SA(1, 0), cA + kstep, voffA); PG8_STAGE(PG8_SB(1, 1), cB + hstep + kstep, voffB);
        PG8_WAIT_V(6); PG8_BAR;
    } else {
        PG8_STAGE(PG8_SB(0, 0), cB, voffB); PG8_STAGE(PG8_SA(0, 0), cA, voffA); PG8_STAGE(PG8_SB(0, 1), cB + hstep, voffB); PG8_STAGE(PG8_SA(0, 1), cA + hstep, voffA);
        if (wr == 1) PG8_BAR;
        PG8_WAIT_V(4); PG8_BAR;
        PG8_STAGE(PG8_SB(1, 0), cB + kstep, voffB); PG8_STAGE(PG8_SA(1, 0), cA + kstep, voffA); PG8_STAGE(PG8_SB(1, 1), cB + hstep + kstep, voffB);
        PG8_WAIT_V(6); PG8_BAR;
    }
    for (;;) {
        const bool has_next = S.next(ui + 1, nxt);
        const char* nA = has_next ? (const char*)g.A + (size_t)nxt.pm * tstep : cA; const char* nB = has_next ? (const char*)(g.Bt + (size_t)(nxt.pm >> g.bshift) * g.bstride) + (size_t)nxt.pn * tstep : cB;
        for (int t = 0; t < nt; t += 2) {
            const bool last = (t == nt - 2);
            const char* a1 = cA + (size_t)(t + 1) * kstep;
            const char* a2 = last ? nA : cA + (size_t)(t + 2) * kstep; const char* b2 = last ? nB : cB + (size_t)(t + 2) * kstep;
            const char* a3 = a2 + kstep; const char* b3 = b2 + kstep;
            if (last && has_next) S.a_ready(nxt);
            if constexpr (SP2) {
            PG8_LDB(B0, 0, 0); PG8_LDB(B1, 0, 1); PG8_SCHED; PG8_LDA(At, 0, 0); PG8_STAGE(PG8_SA(1, 1), a1 + hstep, voffA);
            PG8_WAIT_V(8); PG8_WAIT_L(0); PG8_BAR; PG8_MMA(0, 0, At, B0); PG8_MMA(0, 1, At, B1); PG8_BAR; PG8_SCHED;
            PG8_LDA(At, 0, 1); PG8_STAGE(PG8_SB(0, 0), b2, voffB); PG8_STAGE(PG8_SB(0, 1), b2 + hstep, voffB); PG8_STAGE(PG8_SA(0, 0), a2, voffA);
            PG8_WAIT_V(8); PG8_WAIT_L(0); PG8_BAR; PG8_MMA(1, 0, At, B0); PG8_MMA(1, 1, At, B1); PG8_BAR; PG8_SCHED;
            PG8_LDB(B0, 1, 0); PG8_LDB(B1, 1, 1); PG8_SCHED; PG8_LDA(At, 1, 0); PG8_STAGE(PG8_SA(0, 1), a2 + hstep, voffA);
            PG8_WAIT_V(8); PG8_WAIT_L(0); PG8_BAR; PG8_MMA(0, 0, At, B0); PG8_MMA(0, 1, At, B1); PG8_BAR; PG8_SCHED;
            PG8_LDA(At, 1, 1); PG8_STAGE(PG8_SB(1, 0), b3, voffB); PG8_STAGE(PG8_SB(1, 1), b3 + hstep, voffB); PG8_STAGE(PG8_SA(1, 0), a3, voffA);
            PG8_WAIT_V(8); PG8_WAIT_L(0); PG8_BAR; PG8_MMA(1, 0, At, B0); PG8_MMA(1, 1, At, B1); PG8_BAR; PG8_SCHED;
            } else {
            PG8_LDB(B0, 0, 0); PG8_SCHED; PG8_LDA(At, 0, 0); PG8_STAGE(PG8_SA(1, 1), a1 + hstep, voffA);
            PG8_WAIT_L(8); PG8_BAR; PG8_WAIT_L(0); PG8_MMA(0, 0, At, B0); PG8_BAR; PG8_SCHED;
            PG8_LDB(B1, 0, 1); PG8_STAGE(PG8_SB(0, 0), b2, voffB);
            PG8_BAR; PG8_WAIT_L(0); PG8_MMA(0, 1, At, B1); PG8_BAR;
            PG8_LDA(At, 0, 1); PG8_STAGE(PG8_SA(0, 0), a2, voffA);
            PG8_BAR; PG8_WAIT_L(0); PG8_MMA(1, 0, At, B0); PG8_BAR; PG8_SCHED;
            PG8_STAGE(PG8_SB(0, 1), b2 + hstep, voffB);
            PG8_WAIT_V(6); PG8_BAR; PG8_MMA(1, 1, At, B1); PG8_BAR;
            PG8_LDB(B0, 1, 0); PG8_SCHED; PG8_LDA(At, 1, 0); PG8_STAGE(PG8_SA(0, 1), a2 + hstep, voffA);
            PG8_WAIT_L(8); PG8_BAR; PG8_WAIT_L(0); PG8_MMA(0, 0, At, B0); PG8_BAR; PG8_SCHED;
            PG8_LDB(B1, 1, 1); PG8_STAGE(PG8_SB(1, 0), b3, voffB);
            PG8_BAR; PG8_WAIT_L(0); PG8_MMA(0, 1, At, B1); PG8_BAR;
            PG8_LDA(At, 1, 1); PG8_STAGE(PG8_SA(1, 0), a3, voffA);
            PG8_BAR; PG8_WAIT_L(0); PG8_MMA(1, 0, At, B0); PG8_BAR; PG8_SCHED;
            PG8_STAGE(PG8_SB(1, 1), b3 + hstep, voffB);
            PG8_WAIT_V(6); PG8_BAR; PG8_MMA(1, 1, At, B1); PG8_BAR;
            }
        }
        if constexpr (ALIGN_EPI) { if (wr == 0) PG8_BAR; }
        if constexpr (!Epi::AFTER_DRAIN) { E(acc, cur, wr, wc, fr, fq); S.done(cur); }
        if (!has_next) break;
#pragma unroll
        for (int a = 0; a < 2; ++a)
#pragma unroll
            for (int b = 0; b < 2; ++b)
#pragma unroll
                for (int m = 0; m < 4; ++m)
#pragma unroll
                    for (int n = 0; n < 2; ++n) acc[a][b][m][n] = (f32x4){0.f, 0.f, 0.f, 0.f};
        cur = nxt; cA = nA; cB = nB; ++ui;
        if constexpr (ALIGN_EPI) { if (wr == 1) PG8_BAR; }
    }
    PG8_WAIT_V(0);
    if constexpr (!ALIGN_EPI) { if (wr == 0) PG8_BAR; }
    PG8_BAR;
    if constexpr (Epi::AFTER_DRAIN) { E.fused(acc, cur, wr, wc, fr, fq, lds, wid, lane); S.done(cur); }
#undef PG8_SA
#undef PG8_SB
#undef PG8_STAGE
#undef PG8_LDA
#undef PG8_LDB
#undef PG8_MMA
#undef PG8_WAIT_V
#undef PG8_WAIT_L
#undef PG8_BAR
#undef PG8_SCHED
}
}

constexpr int NWAVES = 8;
constexpr int BATCH = 8, SEQ = 4096, D = 1024, M = BATCH * SEQ;
constexpr int NH = 8, NKV = 2, HD = 64, AW = 512, KVW = 128, PW = 512, INW = 1280, FF = 4096, NMOD = 6;
constexpr float EPS = 1e-6f;
#ifndef MK_N_LAUNCHES
#define MK_N_LAUNCHES 1
#endif
#ifndef DUP_PHASE
#define DUP_PHASE -1
#endif
#ifndef EPI_PHASE
#define EPI_PHASE -1
#endif
#ifndef TAILCONV
#define TAILCONV 1
#endif
#ifndef OLDTR
#define OLDTR 0
#endif
#ifndef MODUNROLL
#define MODUNROLL 32
#endif
#ifndef DUP_SUB
#define DUP_SUB 7
#endif
#ifndef PERBATCH
#define PERBATCH 0
#endif
#ifndef P4ORDER
#define P4ORDER BatchOrder
#endif
#ifndef TS_PHASE
#define TS_PHASE -2
#endif
#ifndef TS_SCALE
#define TS_SCALE 4
#endif
#ifndef TS_BUCKET
#define TS_BUCKET 0
#endif
#ifndef TS_OFFSET
#define TS_OFFSET 0
#endif
#ifndef WGM_P1
#define WGM_P1 8
#endif
#ifndef WGM_P3
#define WGM_P3 8
#endif
#ifndef WGM_P4
#define WGM_P4 8
#endif
#ifndef WGM_P5
#define WGM_P5 8
#endif
#ifndef REV_P5
#define REV_P5 1
#endif
#ifndef REV_P4
#define REV_P4 0
#endif
constexpr int N_PHASES = 7;
constexpr int N_LAUNCHES = MK_N_LAUNCHES;

constexpr size_t MiB = 1u << 20;
constexpr size_t WS_CTL = 0, CTL_ZERO_BYTES = 64 * 1024;
constexpr size_t WS_MOD = 1 * MiB;
constexpr size_t WS_BIAS2 = 1 * MiB + 256 * 1024;
constexpr size_t WS_A2 = 1 * MiB + 512 * 1024;
constexpr size_t WS_ROPE = 2 * MiB;
constexpr size_t WS_STATS = 4 * MiB;
constexpr size_t WS_WIN = 6 * MiB, WS_WO = 9 * MiB, WS_W1 = 12 * MiB, WS_W2 = 20 * MiB;
constexpr size_t WS_XB1 = 32 * MiB;
constexpr size_t WS_H = 96 * MiB;
constexpr size_t WS_XN = 96 * MiB, WS_Q = 160 * MiB, WS_K = 192 * MiB, WS_V = 200 * MiB, WS_U = 208 * MiB, WS_MIX = 240 * MiB;
constexpr size_t WS_W1B = 352 * MiB;
constexpr size_t WS_Z2 = 416 * MiB;
constexpr size_t WS_END = 480 * MiB;
constexpr int CW_BAR = 1024;

constexpr int LDS_BYTES = 160 * 1024;
constexpr int MISC_OFF = LDS_BYTES - 256;
constexpr int ATT_K = 0, ATT_V = 24576, ATT_WS = 49152, ATT_OST = ATT_WS + NWAVES * 256, ATT_END = ATT_OST + NWAVES * 4096;

#define GAS __attribute__((address_space(1)))
#define LAS __attribute__((address_space(3)))
typedef unsigned short bf16;
typedef unsigned v4u __attribute__((ext_vector_type(4)));
typedef float f32x4 __attribute__((ext_vector_type(4)));
typedef short bf16x8 __attribute__((ext_vector_type(8)));
typedef GAS unsigned gu32;
typedef GAS unsigned long long gu64;
#define RLX_AGENT __ATOMIC_RELAXED, __HIP_MEMORY_SCOPE_AGENT
#define LDS_WAIT() asm volatile("s_waitcnt lgkmcnt(0)" ::: "memory")
#define VM_WAIT() asm volatile("s_waitcnt vmcnt(0)" ::: "memory")
__device__ __forceinline__ unsigned long long rt() { return __builtin_amdgcn_s_memrealtime(); }
__device__ __forceinline__ unsigned f2bf(float f) { unsigned u = __builtin_bit_cast(unsigned, f); return (u + 0x7fffu + ((u >> 16) & 1u)) >> 16; }
__device__ __forceinline__ unsigned pk2(float lo, float hi) { return f2bf(lo) | (f2bf(hi) << 16); }

#define XB_TMO      128
#define XB_XCNT(j)  (256  + 64 * (j))
#define XB_XSUB(j)  (1280 + 64 * (j))
#define XB_XGEN(j)  (2304 + 64 * (j))
#define XB_TOP      3328
#define XB_TOPGEN   3392
#define XCD_BAR_WORDS 3456
#define XB_SPIN_CAP (1u << 18)

__device__ __forceinline__ unsigned xb_ld(unsigned* p)              { return __hip_atomic_load(p, __ATOMIC_RELAXED, __HIP_MEMORY_SCOPE_AGENT); }
__device__ __forceinline__ unsigned xb_add(unsigned* p, unsigned v) { return __hip_atomic_fetch_add(p, v, __ATOMIC_RELAXED, __HIP_MEMORY_SCOPE_AGENT); }
__device__ __forceinline__ unsigned xb_xcc_id() { return (unsigned)__builtin_amdgcn_s_getreg((3 << 11) | 20) & 0xFu; }
#define XB_SPIN(cond, bar) do { unsigned _sp = 0; while (cond) { __builtin_amdgcn_s_sleep(1); \
    if ((++_sp & 255u) == 0u) { if (xb_ld(&(bar)[XB_TMO])) break; if (_sp > XB_SPIN_CAP) { atomicAdd(&(bar)[XB_TMO], 1u); break; } } } } while (0)

struct XcdBarrier {
    unsigned* bar; unsigned x;
    volatile LAS unsigned* st;
};

__device__ __forceinline__ XcdBarrier xcd_barrier_post(unsigned* bar, volatile LAS unsigned* st) {
    XcdBarrier b; b.bar = bar; b.x = xb_xcc_id(); b.st = st;
    if (threadIdx.x == 0) (void)xb_add(&bar[XB_XCNT(b.x)], 1u);
    return b;
}
__device__ __forceinline__ void xcd_barrier_complete(unsigned* bar, unsigned x, unsigned& nloc, unsigned& nx) {
    const unsigned G = gridDim.x * gridDim.y * gridDim.z;
    unsigned sum, cnt, mine, sp = 0u;
    for (;;) {
        sum = 0u; cnt = 0u; mine = 0u;
#pragma unroll
        for (unsigned j = 0; j < 16; ++j) { const unsigned c = xb_ld(&bar[XB_XCNT(j)]); sum += c; cnt += (c > 0u) ? 1u : 0u; mine = (j == x) ? c : mine; }
        if (sum == G) break;
        __builtin_amdgcn_s_sleep(1);
        if ((++sp & 255u) == 0u) { if (xb_ld(&bar[XB_TMO])) break; if (sp > XB_SPIN_CAP) { atomicAdd(&bar[XB_TMO], 1u); break; } }
    }
    nloc = mine > 0u ? mine : 1u; nx = cnt > 0u ? cnt : 1u;
}

__device__ __forceinline__ void xcd_barrier(const XcdBarrier& b) {
    asm volatile("s_waitcnt vmcnt(0)" ::: "memory");
    __syncthreads();
    if (threadIdx.x == 0) {
        unsigned* bar = b.bar;
        __builtin_amdgcn_s_waitcnt(0);
        unsigned nloc = b.st[0], nx = b.st[1];
        if (nloc == 0u) { xcd_barrier_complete(bar, b.x, nloc, nx); b.st[0] = nloc; b.st[1] = nx; }
        const unsigned old = xb_add(&bar[XB_XSUB(b.x)], 1u);
        const unsigned gen = old / nloc;
        if (old + 1u == (gen + 1u) * nloc) {
            __builtin_amdgcn_fence(__ATOMIC_RELEASE, "agent");
            asm volatile("s_waitcnt vmcnt(0)" ::: "memory");
            const unsigned og = xb_add(&bar[XB_TOP], 1u);
            const unsigned tg = og / nx;
            if (og + 1u == (tg + 1u) * nx) xb_add(&bar[XB_TOPGEN], 1u);
            else XB_SPIN(xb_ld(&bar[XB_TOPGEN]) == tg, bar);
            __builtin_amdgcn_fence(__ATOMIC_ACQUIRE, "agent");
            xb_add(&bar[XB_XGEN(b.x)], 1u);
            asm volatile("s_waitcnt vmcnt(0)" ::: "memory");
        } else {
            XB_SPIN(xb_ld(&bar[XB_XGEN(b.x)]) == gen, bar);
            __builtin_amdgcn_fence(__ATOMIC_ACQUIRE, "agent");
            asm volatile("s_waitcnt vmcnt(0)" ::: "memory");
        }
    }
    __syncthreads();
}

#if USE_NT
#define NTLOAD(p) __builtin_nontemporal_load(p)
#else
#define NTLOAD(p) (*(p))
#endif
typedef float f32x16 __attribute__((ext_vector_type(16)));
typedef short s16x4 __attribute__((ext_vector_type(4)));
struct Frame {
    LAS unsigned char* lds;
    int tid, lane, wave, vcu, G;
};
__device__ __forceinline__ float wave_sum(float v) {
#pragma unroll
    for (int o = 1; o < 64; o <<= 1) v += __shfl_xor(v, o);
    return v;
}
__device__ __forceinline__ float bf2f(unsigned short h) { return __builtin_bit_cast(float, (unsigned)h << 16); }
__device__ __forceinline__ float bflo(unsigned w) { return __builtin_bit_cast(float, w << 16); }
__device__ __forceinline__ float bfhi(unsigned w) { return __builtin_bit_cast(float, w & 0xffff0000u); }

__device__ __forceinline__ void p0_transpose_item(const float* W, int N, bf16* WT, int Kd, int k0, int n0, int dst_row0, LAS float* scr, int lane) {
#if OLDTR
#pragma unroll 8
    for (int i = 0; i < 32; ++i) { const int kk = 2 * i + (lane >> 5); scr[kk * 33 + (lane & 31)] = W[(size_t)(k0 + kk) * N + n0 + (lane & 31)]; }
#else
    f32x4 v[8];
#pragma unroll
    for (int i = 0; i < 8; ++i) v[i] = NTLOAD((const GAS f32x4*)(W + (size_t)(k0 + 8 * i + (lane >> 3)) * N + n0 + 4 * (lane & 7)));
#pragma unroll
    for (int i = 0; i < 8; ++i) { LAS float* d = scr + (8 * i + (lane >> 3)) * 33 + 4 * (lane & 7); d[0] = v[i][0]; d[1] = v[i][1]; d[2] = v[i][2]; d[3] = v[i][3]; }
#endif
    LDS_WAIT(); asm volatile("" ::: "memory");
    const int c = lane & 7;
#pragma unroll
    for (int j = 0; j < 4; ++j) { const int n = (lane >> 3) + 8 * j; const LAS float* s = scr + (8 * c) * 33 + n;
        v4u o; o.x = pk2(s[0 * 33], s[1 * 33]); o.y = pk2(s[2 * 33], s[3 * 33]); o.z = pk2(s[4 * 33], s[5 * 33]); o.w = pk2(s[6 * 33], s[7 * 33]);
        *(GAS v4u*)(WT + (size_t)(dst_row0 + n) * Kd + k0 + 8 * c) = o; }
    LDS_WAIT(); asm volatile("" ::: "memory");
}
__device__ __forceinline__ int win_slot(int n) { const int pn = n >> 8, r = n & 255; return 256 * pn + 128 * ((r >> 5) & 1) + 32 * (r >> 6) + (r & 31); }

struct Ptrs {
    const float *x, *c, *w_ada, *b_ada, *norm1_g, *w_in, *q_norm_g, *k_norm_g, *sinks, *pool_w, *pool_scale, *w_o, *norm2_g, *w1, *w2; const int* positions;
    float *out, *mod, *bias2, *a2, *rope, *stats; bf16 *Win_t, *Wo_t, *W1b, *W2_t, *XN, *Q, *K, *V, *U, *MIX, *XB1, *H, *Z2;
};

template <bool SILU> __device__ __forceinline__ void skinny_task(Frame& F, const float* src, int spitch, const float* W, int wpitch, const float* bias, float* out, int opitch, int t) {
    LAS float* vT = (LAS float*)F.lds;
    LAS float* red = (LAS float*)(F.lds + 65536);
    { float cv[16];
#pragma unroll
      for (int i = 0; i < 16; ++i) { const int idx = F.tid + 512 * i; cv[i] = src[(size_t)(idx >> 10) * spitch + (idx & 1023)]; }
#pragma unroll
      for (int i = 0; i < 16; ++i) { const int idx = F.tid + 512 * i, b = idx >> 10, k = idx & 1023; vT[k * 16 + b] = SILU ? cv[i] / (1.f + __expf(-cv[i])) : cv[i]; vT[k * 16 + 8 + b] = 0.f; } }
    __syncthreads();
    const int j0 = 64 * t, kb = 128 * F.wave, kq = F.lane >> 4, jl = F.lane & 15;
    f32x4 acc[4];
#pragma unroll
    for (int e = 0; e < 4; ++e) acc[e] = (f32x4){0.f, 0.f, 0.f, 0.f};
    const GAS float* wp = (const GAS float*)W + (size_t)(kb + kq) * wpitch + j0 + 4 * jl;
#pragma unroll
    for (int s0 = 0; s0 < 32; s0 += 16) {
        f32x4 wv[16];
#pragma unroll
        for (int s = 0; s < 16; ++s) wv[s] = NTLOAD((const GAS f32x4*)(wp + (size_t)(4 * (s0 + s)) * wpitch));
#pragma unroll
        for (int s = 0; s < 16; ++s) { const float a = vT[(kb + 4 * (s0 + s) + kq) * 16 + jl];
#pragma unroll
            for (int e = 0; e < 4; ++e) acc[e] = __builtin_amdgcn_mfma_f32_16x16x4f32(a, wv[s][e], acc[e], 0, 0, 0); }
    }
    if (F.lane < 32) {
#pragma unroll
        for (int e = 0; e < 4; ++e)
#pragma unroll
            for (int r = 0; r < 4; ++r) red[((F.wave * 4 + e) * 4 + r) * 32 + F.lane] = acc[e][r];
    }
    __syncthreads();
    { const int b = F.tid >> 6, col = F.tid & 63, e = col & 3, lane = (b >> 2) * 16 + (col >> 2), r = b & 3; float sum = 0.f;
#pragma unroll
      for (int w = 0; w < NWAVES; ++w) sum += red[((w * 4 + e) * 4 + r) * 32 + lane];
      out[(size_t)b * opitch + j0 + col] = sum + (bias ? bias[j0 + col] : 0.f); }
    __syncthreads();
}
__device__ __forceinline__ void p0_fold_task(Frame& F, const Ptrs& P, int t) {
    const int g = t >> 5, n0 = (t & 31) * 32;
    LAS float* Pm = (LAS float*)F.lds;
    LAS float* Wm = (LAS float*)(F.lds + 128 * 129 * 4);
    { float pv[32], wv[8];
#pragma unroll
      for (int i = 0; i < 32; ++i) pv[i] = P.pool_w[(size_t)g * 16384 + F.tid + 512 * i];
#pragma unroll
      for (int i = 0; i < 8; ++i) { const int idx = F.tid + 512 * i; wv[i] = P.w_o[(size_t)(512 + 128 * g + (idx >> 5)) * D + n0 + (idx & 31)]; }
      const float sc = P.pool_scale[128 * g + (F.tid & 127)];
#pragma unroll
      for (int i = 0; i < 32; ++i) { const int idx = F.tid + 512 * i; Pm[(idx >> 7) * 129 + (idx & 127)] = pv[i] * sc; }
#pragma unroll
      for (int i = 0; i < 8; ++i) { const int idx = F.tid + 512 * i; Wm[(idx >> 5) * 33 + (idx & 31)] = wv[i]; } }
    __syncthreads();
    const int c0 = 16 * F.wave, li = F.lane & 15, lq = F.lane >> 4;
    f32x4 acc0 = (f32x4){0.f, 0.f, 0.f, 0.f}, acc1 = acc0;
#pragma unroll 8
    for (int d0 = 0; d0 < 128; d0 += 4) {
        const float a = Pm[(c0 + li) * 129 + d0 + lq], b0 = Wm[(d0 + lq) * 33 + li], b1 = Wm[(d0 + lq) * 33 + 16 + li];
        acc0 = __builtin_amdgcn_mfma_f32_16x16x4f32(a, b0, acc0, 0, 0, 0); acc1 = __builtin_amdgcn_mfma_f32_16x16x4f32(a, b1, acc1, 0, 0, 0);
    }
#pragma unroll
    for (int r = 0; r < 4; ++r) { const int c = c0 + 4 * lq + r;
        P.Wo_t[(size_t)(n0 + li) * D + 512 + 128 * g + c] = (bf16)f2bf(acc0[r]); P.Wo_t[(size_t)(n0 + 16 + li) * D + 512 + 128 * g + c] = (bf16)f2bf(acc1[r]); }
    __syncthreads();
}
__device__ __forceinline__ void p0a_prologue(Frame& F, const Ptrs& P) {
    for (int t = F.vcu; t < 96; t += F.G) skinny_task<true>(F, P.c, D, P.w_ada, NMOD * D, P.b_ada, P.mod, NMOD * D, t);
    LAS float* scr = (LAS float*)(F.lds + F.wave * 16384);
    const int gw = (F.G - 1 - F.vcu) * NWAVES + F.wave, NGW = F.G * NWAVES;
    constexpr int I_IN = (D / 64) * (INW / 32), I_2 = (FF / 64) * (D / 32);
    for (int it = gw; it < I_IN; it += NGW) { const int nblk = INW / 32, kb = it / nblk, nb = it % nblk; p0_transpose_item(P.w_in, INW, P.Win_t, D, 64 * kb, 32 * nb, win_slot(32 * nb), scr, F.lane); }
    { const int nfree = F.G > 96 ? F.G - 96 : F.G, ordf = F.G > 96 ? F.vcu - 96 : F.vcu;
      if (ordf >= 0) for (int it = ordf * NWAVES + F.wave; it < I_2; it += nfree * NWAVES) { const int nblk = D / 32, kb = it / nblk, nb = it % nblk; p0_transpose_item(P.w2, D, P.W2_t, FF, 64 * kb, 32 * nb, 32 * nb, scr, F.lane); } }
    for (int idx = (F.vcu * NWAVES * 64 + F.tid); idx < M * 8; idx += F.G * NWAVES * 64) {
        const int m = idx >> 3, i = idx & 7;
        const float inv_freq = (i == 0) ? 1.0f : (i == 1) ? 0.1939227432012558f : (i == 2) ? 0.03760603070259094f : (i == 3) ? 0.007292664609849453f : (i == 4) ? 0.0014142135623842478f : (i == 5) ? 0.00027424818836152554f : (i == 6) ? 5.3182957344688475e-05f : 1.0313385246263351e-05f;
        const float ang = (float)P.positions[m] * inv_freq;
        P.rope[(size_t)m * 16 + i] = (float)cos((double)ang); P.rope[(size_t)m * 16 + 8 + i] = (float)sin((double)ang);
    }
}

__device__ __forceinline__ void p1_tail_work(Frame& F, const Ptrs& P, int ord, int cnt) {
    for (int t = ord; t < 128; t += cnt) p0_fold_task(F, P, t);
    for (int t = cnt - 1 - ord; t < FF / 64; t += cnt) skinny_task<false>(F, P.mod + 3 * D, NMOD * D, P.w1, FF, nullptr, P.bias2, FF, t);
    LAS float* scr = (LAS float*)(F.lds + F.wave * 16384);
    constexpr int I_1 = (D / 64) * (FF / 32), I_O = (AW / 64) * (D / 32);
    for (int it = ord * NWAVES + F.wave; it < I_1 + I_O; it += cnt * NWAVES) {
        int r = it;
        if (r < I_1) { const int nblk = FF / 32, kb = r / nblk, nb = r % nblk; p0_transpose_item(P.w1, FF, P.W1b, D, 64 * kb, 32 * nb, 32 * nb, scr, F.lane); continue; } r -= I_1;
        { const int nblk = D / 32, kb = r / nblk, nb = r % nblk; p0_transpose_item(P.w_o, D, P.Wo_t, D, 64 * kb, 32 * nb, 32 * nb, scr, F.lane); }
    }
}

__device__ __forceinline__ void p0b_norm(Frame& F, const Ptrs& P) {
    const int gt = F.vcu * NWAVES * 64 + F.tid, NGT = F.G * NWAVES * 64;
    for (int i = gt; i < BATCH * D; i += NGT) { const int b = i >> 10, col = i & 1023; P.a2[i] = P.norm2_g[col] * (1.f + P.mod[(size_t)b * NMOD * D + 4 * D + col]); }
    const int gw = F.vcu * NWAVES + F.wave, NGW = F.G * NWAVES;
    for (int rb = gw; rb < M / 16; rb += NGW) {
        const int b = (rb * 16) / SEQ; const float* mb = P.mod + (size_t)b * NMOD * D;
        f32x4 av[4], sv[4];
#pragma unroll
        for (int j = 0; j < 4; ++j) { const int col = 256 * j + 4 * F.lane; const f32x4 g = *(const f32x4*)(P.norm1_g + col), sc = *(const f32x4*)(mb + D + col); av[j] = g * (sc + 1.0f); sv[j] = *(const f32x4*)(mb + col); }
        for (int rr = 0; rr < 16; rr += 4) {
            f32x4 v[4][4]; float s[4];
#pragma unroll
            for (int q = 0; q < 4; ++q) { const GAS f32x4* xr = (const GAS f32x4*)(P.x + (size_t)(rb * 16 + rr + q) * D) + F.lane;
#pragma unroll
                for (int j = 0; j < 4; ++j) v[q][j] = NTLOAD(xr + 64 * j); }
#pragma unroll
            for (int q = 0; q < 4; ++q) { float t = 0.f;
#pragma unroll
                for (int j = 0; j < 4; ++j) t += (v[q][j][0] * v[q][j][0] + v[q][j][1] * v[q][j][1]) + (v[q][j][2] * v[q][j][2] + v[q][j][3] * v[q][j][3]);
                s[q] = t; }
#pragma unroll
            for (int o = 1; o < 64; o <<= 1) {
#pragma unroll
                for (int q = 0; q < 4; ++q) s[q] += __shfl_xor(s[q], o); }
#pragma unroll
            for (int q = 0; q < 4; ++q) { const float r = rsqrtf(s[q] * (1.f / D) + EPS);
                GAS unsigned long long* o8 = (GAS unsigned long long*)(P.XN + (size_t)(rb * 16 + rr + q) * D) + F.lane;
#pragma unroll
                for (int j = 0; j < 4; ++j) { const f32x4 y = v[q][j] * r * av[j] + sv[j]; o8[64 * j] = (unsigned long long)pk2(y[0], y[1]) | ((unsigned long long)pk2(y[2], y[3]) << 32); } }
        }
    }
}
__device__ __forceinline__ int crow(int r, int hi) { return (r & 3) + 8 * (r >> 2) + 4 * hi; }
__device__ __forceinline__ unsigned cvtpk(float lo, float hi) { unsigned r; asm volatile("v_cvt_pk_bf16_f32 %0, %1, %2" : "=v"(r) : "v"(lo), "v"(hi)); return r; }
typedef short v4i16_t __attribute__((ext_vector_type(4)));
__device__ __forceinline__ s16x4 vtr(LAS const unsigned char* p) { return __builtin_bit_cast(s16x4, __builtin_amdgcn_ds_read_tr16_b64_v4i16((LAS v4i16_t*)p)); }

struct AttnRegs { v4u k[3], v[3]; bf16x8 q[4]; };
__device__ __forceinline__ void attn_load(Frame& F, const Ptrs& P, int unit, AttnRegs& R) {
    const int lane = F.lane, wid = F.wave, r32 = lane & 31, hi = lane >> 5;
    const int bk = unit >> 6, qb = unit & 63, b = bk >> 1, kvh = bk & 1, wh = wid & 1, hq = kvh * 4 + (wid >> 1);
    const long rowbase = (long)b * SEQ; const int q0 = qb * 64, kv0 = q0 - 128, qw0 = q0 + 32 * wh;
#pragma unroll
    for (int i = 0; i < 3; ++i) { const int kvr = kv0 + 64 * i + lane, kc = kvr < 0 ? 0 : kvr; const v4u t = *(const GAS v4u*)(P.K + (rowbase + kc) * KVW + kvh * 64 + wid * 8); const unsigned mk = kvr < 0 ? 0u : 0xffffffffu; R.k[i] = (v4u){t.x & mk, t.y & mk, t.z & mk, t.w & mk}; }
#pragma unroll
    for (int i = 0; i < 3; ++i) { const int kvr = kv0 + 64 * i + 16 * (wid & 3) + (lane >> 2), kc = kvr < 0 ? 0 : kvr; const v4u t = *(const GAS v4u*)(P.V + (rowbase + kc) * KVW + kvh * 64 + (wid >> 2) * 32 + (lane & 3) * 8); const unsigned mk = kvr < 0 ? 0u : 0xffffffffu; R.v[i] = (v4u){t.x & mk, t.y & mk, t.z & mk, t.w & mk}; }
    const bf16* Qw = P.Q + (rowbase + qw0 + r32) * AW + hq * 64 + hi * 8;
#pragma unroll
    for (int d0 = 0; d0 < 4; ++d0) R.q[d0] = *(const GAS bf16x8*)(Qw + d0 * 16);
}
__device__ __forceinline__ void attn_compute(Frame& F, const Ptrs& P, int unit, const bf16x8 (&qr)[4], float sink0, float sink1) {
    const int lane = F.lane, wid = F.wave, r32 = lane & 31, hi = lane >> 5;
    const int bk = unit >> 6, qb = unit & 63, b = bk >> 1, kvh = bk & 1, wh = wid & 1, hq = kvh * 4 + (wid >> 1);
    const long rowbase = (long)b * SEQ; const int q0 = qb * 64, qw0 = q0 + 32 * wh;
    LAS unsigned char* lds = F.lds;
    f32x16 p[5];
#pragma unroll
    for (int j = 0; j < 5; ++j) {
        const int hb = wh + j; const LAS unsigned char* kp = lds + ATT_K + (hb >> 1) * 8192 + hi * 1024 + ((hb & 1) * 32 + r32) * 16;
        f32x16 a = {0.f, 0.f, 0.f, 0.f, 0.f, 0.f, 0.f, 0.f, 0.f, 0.f, 0.f, 0.f, 0.f, 0.f, 0.f, 0.f};
#pragma unroll
        for (int d0 = 0; d0 < 4; ++d0) { const bf16x8 kf = *(const LAS bf16x8*)(kp + d0 * 2048); a = __builtin_amdgcn_mfma_f32_32x32x16_bf16(kf, qr[d0], a, 0, 0, 0); }
        p[j] = a;
    }
    const float NEG = -INFINITY;
#pragma unroll
    for (int j = 0; j < 5; ++j) {
        const bool valid = (qw0 - 128 + 32 * j) >= 0;
#pragma unroll
        for (int r = 0; r < 16; ++r) { bool keep = valid; if (j == 0) keep = keep && (crow(r, hi) > r32); if (j == 4) keep = keep && (crow(r, hi) <= r32); if (!keep) p[j][r] = NEG; }
    }
    const float sinkl2 = (kvh ? sink1 : sink0) * 1.4426950408889634f;
    float mx = sinkl2;
#pragma unroll
    for (int j = 0; j < 5; ++j)
#pragma unroll
        for (int r = 0; r < 16; ++r) mx = fmaxf(mx, p[j][r]);
    { auto rr = __builtin_amdgcn_permlane32_swap(__float_as_uint(mx), __float_as_uint(mx), false, false); mx = fmaxf(__uint_as_float(rr[0]), __uint_as_float(rr[1])); }
    float l = 0.f;
#pragma unroll
    for (int j = 0; j < 5; ++j)
#pragma unroll
        for (int r = 0; r < 16; ++r) { const float e = __builtin_amdgcn_exp2f(p[j][r] - mx); p[j][r] = e; l += e; }
    { auto rr = __builtin_amdgcn_permlane32_swap(__float_as_uint(l), __float_as_uint(l), false, false); l = __uint_as_float(rr[0]) + __uint_as_float(rr[1]); }
    l += __builtin_amdgcn_exp2f(sinkl2 - mx);
    f32x16 o[2];
    o[0] = (f32x16){0.f, 0.f, 0.f, 0.f, 0.f, 0.f, 0.f, 0.f, 0.f, 0.f, 0.f, 0.f, 0.f, 0.f, 0.f, 0.f}; o[1] = o[0];
    const LAS unsigned char* vb = lds + ATT_V + ((lane >> 4) & 1) * 32 + (lane & 3) * 8 + (4 * hi + ((lane & 15) >> 2)) * 64;
#pragma unroll
    for (int j = 0; j < 5; ++j) {
        const int hb = wh + j; const LAS unsigned char* vt = vb + (hb >> 1) * 8192 + (hb & 1) * 2048;
#pragma unroll
        for (int s = 0; s < 2; ++s) {
            v4u pw; pw.x = cvtpk(p[j][8 * s + 0], p[j][8 * s + 1]); pw.y = cvtpk(p[j][8 * s + 2], p[j][8 * s + 3]); pw.z = cvtpk(p[j][8 * s + 4], p[j][8 * s + 5]); pw.w = cvtpk(p[j][8 * s + 6], p[j][8 * s + 7]);
            const bf16x8 pf = __builtin_bit_cast(bf16x8, pw);
#pragma unroll
            for (int d0 = 0; d0 < 2; ++d0) {
                const s16x4 lo = vtr(vt + d0 * 4096 + s * 1024), hh = vtr(vt + d0 * 4096 + s * 1024 + 512);
                const bf16x8 vf = (bf16x8){lo[0], lo[1], lo[2], lo[3], hh[0], hh[1], hh[2], hh[3]};
                o[d0] = __builtin_amdgcn_mfma_f32_32x32x16_bf16(pf, vf, o[d0], 0, 0, 0);
            }
        }
    }
    LAS float* wsf = (LAS float*)(lds + ATT_WS) + wid * 64;
    if (hi == 0) wsf[r32] = l;
    LDS_WAIT(); asm volatile("" ::: "memory");
    float rli[16];
#pragma unroll
    for (int r = 0; r < 16; ++r) rli[r] = __builtin_amdgcn_rcpf(wsf[crow(r, hi)]);
    LAS bf16* stg = (LAS bf16*)(lds + ATT_OST) + wid * 2048;
#pragma unroll
    for (int r = 0; r < 16; ++r) { const int orow = crow(r, hi);
#pragma unroll
        for (int d0 = 0; d0 < 2; ++d0) stg[orow * 64 + d0 * 32 + r32] = (bf16)f2bf(o[d0][r] * rli[r]); }
    LDS_WAIT(); asm volatile("" ::: "memory");
    bf16* Ow = P.MIX + (rowbase + qw0) * D + hq * 64;
#pragma unroll
    for (int i = 0; i < 4; ++i) { const int row = i * 8 + (lane >> 3), ch = lane & 7; const v4u v = *(const LAS v4u*)(stg + row * 64 + ch * 8); *(GAS v4u*)(Ow + (size_t)row * D + ch * 8) = v; }
}
__device__ __forceinline__ void unpack8(const v4u w, float (&f)[8]) { f[0] = bflo(w.x); f[1] = bfhi(w.x); f[2] = bflo(w.y); f[3] = bfhi(w.y); f[4] = bflo(w.z); f[5] = bfhi(w.z); f[6] = bflo(w.w); f[7] = bfhi(w.w); }
template <int W> __device__ __forceinline__ void pool_task_w(Frame& F, const Ptrs& P, int g, int rb) {
    const int ch = F.lane & 15, run = F.lane >> 4;
    const int t0 = (rb * 64 + run * 16) & (SEQ - 1);
    const GAS char* ub = (const GAS char*)(P.U + (size_t)(rb * 64) * PW + g * 128);
    GAS char* ob = (GAS char*)(P.MIX + (size_t)(rb * 64) * D + AW + g * 128);
    const unsigned loff = (unsigned)((run * 16 * PW + ch * 8) * 2), ooff = (unsigned)((run * 16 * D + ch * 8) * 2);
    v4u cur[16], prev[W];
#pragma unroll
    for (int i = 0; i < 16; ++i) cur[i] = *(const GAS v4u*)(ub + (size_t)i * (PW * 2) + loff);
#pragma unroll
    for (int j = 1; j <= W; ++j) { const bool ok = (t0 - j) >= 0; const v4u t = *(const GAS v4u*)(ub + loff - (ok ? (size_t)j * (PW * 2) : (size_t)0)); const unsigned mk = ok ? 0xffffffffu : 0u; prev[j - 1] = (v4u){t.x & mk, t.y & mk, t.z & mk, t.w & mk}; }
    float S[8];
#pragma unroll
    for (int e = 0; e < 8; ++e) S[e] = 0.f;
#pragma unroll
    for (int j = 1; j <= W; ++j) { float f[8]; unpack8(prev[j - 1], f);
#pragma unroll
        for (int e = 0; e < 8; ++e) S[e] += f[e]; }
#pragma unroll
    for (int i = 0; i < 16; ++i) {
        const int t = t0 + i; float u[8]; unpack8(cur[i], u);
        float f[8]; unpack8(i < W ? prev[(W - 1 - i) >= 0 ? (W - 1 - i) : 0] : cur[(i - W) >= 0 ? (i - W) : 0], f);
#pragma unroll
        for (int e = 0; e < 8; ++e) S[e] += u[e] - f[e];
        const float inv = 1.0f / (float)((t + 1) < W ? (t + 1) : W);
        v4u o; o.x = pk2(S[0] * inv - u[0], S[1] * inv - u[1]); o.y = pk2(S[2] * inv - u[2], S[3] * inv - u[3]); o.z = pk2(S[4] * inv - u[4], S[5] * inv - u[5]); o.w = pk2(S[6] * inv - u[6], S[7] * inv - u[7]);
        *(GAS v4u*)(ob + (size_t)i * (D * 2) + ooff) = o;
    }
}
__device__ __forceinline__ void pool_task(Frame& F, const Ptrs& P, int task) {
    const int g = task & 3, rb = task >> 2;
    if (g == 0) pool_task_w<2>(F, P, 0, rb); else if (g == 1) pool_task_w<4>(F, P, 1, rb); else if (g == 2) pool_task_w<8>(F, P, 2, rb); else pool_task_w<16>(F, P, 3, rb);
}
__device__ __forceinline__ void p2_attn_pool(Frame& F, const Ptrs& P, int sub) {
    constexpr int NUNITS = BATCH * NKV * (SEQ / 64);
    const int upw = (NUNITS + F.G - 1) / F.G, first = F.vcu * upw;
    int n = NUNITS - first; n = n < 0 ? 0 : (n > upw ? upw : n);
    if (!(sub & 1)) n = 0;
    const float sink0 = P.sinks[F.wave >> 1], sink1 = P.sinks[4 + (F.wave >> 1)];
    AttnRegs R;
    if (n > 0) attn_load(F, P, first, R);
    for (int i = 0; i < n; ++i) {
        bf16x8 qr[4];
#pragma unroll
        for (int d0 = 0; d0 < 4; ++d0) qr[d0] = R.q[d0];
#pragma unroll
        for (int t = 0; t < 3; ++t) { *(LAS v4u*)(F.lds + ATT_K + t * 8192 + F.wave * 1024 + F.lane * 16) = R.k[t]; *(LAS v4u*)(F.lds + ATT_V + t * 8192 + F.wave * 1024 + F.lane * 16) = R.v[t]; }
        __syncthreads();
        if (i + 1 < n) attn_load(F, P, first + i + 1, R);
        attn_compute(F, P, first + i, qr, sink0, sink1);
        __syncthreads();
    }
    const int gw = F.vcu * NWAVES + F.wave, NGW = F.G * NWAVES;
    if (sub & 2) for (int t = gw; t < 4 * (M / 64); t += NGW) pool_task(F, P, t);
}

struct Args { const void* in[16]; float* out; unsigned char* ws; int ph_lo, ph_hi, sub, pad; };
__global__ void __launch_bounds__(NWAVES * 64, 2) fwd_megakernel(Args args) {
    extern __shared__ __attribute__((aligned(16))) unsigned char lds[];
    Frame F;
    F.lds = (LAS unsigned char*)lds;
    F.tid = threadIdx.x; F.lane = F.tid & 63; F.wave = __builtin_amdgcn_readfirstlane(F.tid >> 6);
    F.G = gridDim.x; { const int bx = blockIdx.x; F.vcu = (F.G % 8 == 0) ? (bx % 8) * (F.G / 8) + bx / 8 : bx; }
    unsigned char* ws = args.ws;
    Ptrs P;
    P.x = (const float*)args.in[0]; P.c = (const float*)args.in[1]; P.positions = (const int*)args.in[2]; P.w_ada = (const float*)args.in[3]; P.b_ada = (const float*)args.in[4];
    P.norm1_g = (const float*)args.in[5]; P.w_in = (const float*)args.in[6]; P.q_norm_g = (const float*)args.in[7]; P.k_norm_g = (const float*)args.in[8]; P.sinks = (const float*)args.in[9];
    P.pool_w = (const float*)args.in[10]; P.pool_scale = (const float*)args.in[11]; P.w_o = (const float*)args.in[12]; P.norm2_g = (const float*)args.in[13]; P.w1 = (const float*)args.in[14]; P.w2 = (const float*)args.in[15];
    P.out = args.out; P.mod = (float*)(ws + WS_MOD); P.bias2 = (float*)(ws + WS_BIAS2); P.a2 = (float*)(ws + WS_A2); P.rope = (float*)(ws + WS_ROPE); P.stats = (float*)(ws + WS_STATS);
    P.Win_t = (bf16*)(ws + WS_WIN); P.Wo_t = (bf16*)(ws + WS_WO); P.W1b = (bf16*)(ws + WS_W1B); P.W2_t = (bf16*)(ws + WS_W2);
    P.XN = (bf16*)(ws + WS_XN); P.Q = (bf16*)(ws + WS_Q); P.K = (bf16*)(ws + WS_K); P.V = (bf16*)(ws + WS_V); P.U = (bf16*)(ws + WS_U); P.MIX = (bf16*)(ws + WS_MIX); P.XB1 = (bf16*)(ws + WS_XB1); P.Z2 = (bf16*)(ws + WS_Z2); P.H = (bf16*)(ws + WS_H);
    volatile LAS unsigned* MISC = (volatile LAS unsigned*)(F.lds + MISC_OFF);
    if (F.tid < 64) MISC[F.tid] = 0u;
    __syncthreads();
    XcdBarrier bar; bar.bar = (unsigned*)(ws + WS_CTL) + CW_BAR; bar.x = 0; bar.st = nullptr;
    if (N_LAUNCHES == 1) bar = xcd_barrier_post((unsigned*)(ws + WS_CTL) + CW_BAR, MISC + 8);
    const int lo = args.ph_lo, hi = args.ph_hi;
#define IN(k) (lo <= (k) && (k) < hi)
#if TS_PHASE >= -1
    unsigned long long* const tsp = (unsigned long long*)(ws + 61440);
#define STAMP(i) do { if (blockIdx.x == 0 && F.tid == 0) tsp[i] = __builtin_amdgcn_s_memrealtime(); } while (0)
#else
#define STAMP(i) do { } while (0)
#endif
#define SEAM(k) do { if (IN(k) && IN((k) + 1)) { xcd_barrier(bar); STAMP((k) + 1); } } while (0)
    STAMP(0);

    if (IN(0)) { p0a_prologue(F, P); SEAM(0); }
    if (IN(1)) { p0b_norm(F, P); SEAM(1); }
    if (IN(2)) {
        pg8::Gemm g{P.XN, P.Win_t, M, INW, D, 0, 0}; pg8::StaticOrder S; S.init(M, INW, F.G, (int)blockIdx.x, WGM_P1);
        pg8::EpiProj E{P.Q, P.K, P.V, P.U, P.rope, P.q_norm_g, P.k_norm_g};
        pg8::gemm_phase<pg8::EpiProj, pg8::StaticOrder, true, true>(F.lds, g, S, E);
        { const int nwg = (M / 256) * (INW / 256), rem = nwg % F.G;
          if (rem == 0) p1_tail_work(F, P, (int)blockIdx.x, F.G); else if ((int)blockIdx.x >= rem) p1_tail_work(F, P, (int)blockIdx.x - rem, F.G - rem); }
        SEAM(2);
    }
    if (IN(3)) { p2_attn_pool(F, P, args.sub); SEAM(3); }
    if (IN(4)) {
        pg8::Gemm g{P.MIX, P.Wo_t, M, D, D, 0, 0}; pg8::StaticOrder S; S.init(M, D, F.G, (int)blockIdx.x, WGM_P3);
        pg8::EpiWo E{P.x, P.XB1, P.mod, P.stats, P.Z2, P.a2};
        pg8::gemm_phase<pg8::EpiWo, pg8::StaticOrder, true, true>(F.lds, g, S, E);
        SEAM(4);
    }
    if (IN(5)) {
        pg8::Gemm g{P.Z2, P.W1b, M, FF, D, 0, 0}; pg8::StaticOrder S; S.init(M, FF, F.G, (int)blockIdx.x, WGM_P4, REV_P4);
        pg8::EpiUp E{P.H, P.stats, P.bias2, FF};
        pg8::gemm_phase<pg8::EpiUp, pg8::StaticOrder, true, true>(F.lds, g, S, E);
        SEAM(5);
    }
    if (IN(6)) {
        pg8::Gemm g{P.H, P.W2_t, M, D, FF, 0, 0}; pg8::StaticOrder S; S.init(M, D, F.G, (int)blockIdx.x, WGM_P5, REV_P5);
        pg8::EpiDown E{P.out, P.XB1, P.mod};
        pg8::gemm_phase<pg8::EpiDown, pg8::StaticOrder, true, true>(F.lds, g, S, E);
    }
#if TS_PHASE >= -1
    xcd_barrier(bar); STAMP(7); __syncthreads();
    if (blockIdx.x == 0) { __builtin_amdgcn_fence(__ATOMIC_ACQUIRE, "agent");
        unsigned n = (TS_PHASE < 0) ? 100000u : (unsigned)(__hip_atomic_load(tsp + (TS_PHASE == 9 ? 7 : TS_PHASE + 1), __ATOMIC_RELAXED, __HIP_MEMORY_SCOPE_AGENT) - __hip_atomic_load(tsp + ((TS_PHASE < 0 || TS_PHASE == 9) ? 0 : TS_PHASE), __ATOMIC_RELAXED, __HIP_MEMORY_SCOPE_AGENT)) * (unsigned)TS_SCALE;
        if (TS_BUCKET > 0) n = ((n / TS_SCALE + TS_OFFSET) / TS_BUCKET) * 10000u;
        for (unsigned i = F.tid; i < n && i < 130000u; i += NWAVES * 64) P.out[(size_t)i * 257] += 0.125f; }
#endif
#undef IN
#undef SEAM
}

#ifndef HYB
extern "C" void kernel_launch(void* const* d_in, const int* in_sizes, int n_in, void* d_out, int out_size, void* d_ws, size_t ws_size, hipStream_t stream) {
    static int grid = 0;
    if (grid == 0) {
        if (n_in != 16 || out_size != M * D || ws_size < WS_END) { fprintf(stderr, "kernel_launch: unexpected shapes (n_in %d out %d ws %zu)\n", n_in, out_size, ws_size); grid = -1; return; }
        int dev = 0, cus = 0, per_cu = 0;
        if (hipGetDevice(&dev) != hipSuccess || hipDeviceGetAttribute(&cus, hipDeviceAttributeMultiprocessorCount, dev) != hipSuccess) { grid = -1; return; }
        if (hipFuncSetAttribute((const void*)fwd_megakernel, hipFuncAttributeMaxDynamicSharedMemorySize, LDS_BYTES) != hipSuccess) { fprintf(stderr, "kernel_launch: hipFuncSetAttribute failed\n"); grid = -1; return; }
        if (hipOccupancyMaxActiveBlocksPerMultiprocessor(&per_cu, (const void*)fwd_megakernel, NWAVES * 64, LDS_BYTES) != hipSuccess || per_cu < 1) { fprintf(stderr, "kernel_launch: occupancy query says %d\n", per_cu); per_cu = 1; }
        (void)hipGetLastError();
        if (per_cu > 1) per_cu = 1;
        grid = cus * per_cu;
    }
    if (grid < 0) return;
    (void)hipMemsetAsync((char*)d_ws + WS_CTL, 0, CTL_ZERO_BYTES, stream);
#ifdef EXTRA_MEMSET
    for (int i = 0; i < EXTRA_MEMSET; ++i) (void)hipMemsetAsync((char*)d_ws + WS_CTL + CTL_ZERO_BYTES, 0, 4096, stream);
#endif
    Args a{};
    for (int i = 0; i < 16; ++i) a.in[i] = d_in[i];
    a.out = (float*)d_out; a.ws = (unsigned char*)d_ws; a.sub = 7;
    if (N_LAUNCHES == 1 && DUP_PHASE == 6) {
        a.ph_lo = 0; a.ph_hi = N_PHASES; hipLaunchKernelGGL(fwd_megakernel, dim3(grid), dim3(NWAVES * 64), LDS_BYTES, stream, a);
        (void)hipMemsetAsync((char*)d_ws + WS_CTL, 0, CTL_ZERO_BYTES, stream);
        a.out = (float*)((char*)d_ws + WS_W1B); a.ph_lo = 6; a.ph_hi = 7; hipLaunchKernelGGL(fwd_megakernel, dim3(grid), dim3(NWAVES * 64), LDS_BYTES, stream, a);
    } else if (N_LAUNCHES == 1 && DUP_PHASE >= 0) {
        a.ph_lo = 0; a.ph_hi = DUP_PHASE + 1; hipLaunchKernelGGL(fwd_megakernel, dim3(grid), dim3(NWAVES * 64), LDS_BYTES, stream, a);
        (void)hipMemsetAsync((char*)d_ws + WS_CTL, 0, CTL_ZERO_BYTES, stream);
        a.sub = DUP_SUB; a.ph_lo = DUP_PHASE; a.ph_hi = DUP_PHASE + 1; hipLaunchKernelGGL(fwd_megakernel, dim3(grid), dim3(NWAVES * 64), LDS_BYTES, stream, a);
        (void)hipMemsetAsync((char*)d_ws + WS_CTL, 0, CTL_ZERO_BYTES, stream);
        a.sub = 7; a.ph_lo = DUP_PHASE + 1; a.ph_hi = N_PHASES; hipLaunchKernelGGL(fwd_megakernel, dim3(grid), dim3(NWAVES * 64), LDS_BYTES, stream, a);
    } else if (N_LAUNCHES == 1) { a.ph_lo = 0; a.ph_hi = N_PHASES; hipLaunchKernelGGL(fwd_megakernel, dim3(grid), dim3(NWAVES * 64), LDS_BYTES, stream, a); }
    else for (int li = 0; li < N_PHASES; ++li) { a.ph_lo = li; a.ph_hi = li + 1; hipLaunchKernelGGL(fwd_megakernel, dim3(grid), dim3(NWAVES * 64), LDS_BYTES, stream, a); }
}
#endif

#ifdef HYB
__global__ void dbg_norm(const float* __restrict__ x, const float* __restrict__ g, const float* __restrict__ mod, int sh_off, int sc_off, bf16* __restrict__ out) {
    const int wave = (blockIdx.x * blockDim.x + threadIdx.x) >> 6, lane = threadIdx.x & 63;
    if (wave >= M) return;
    const int b = wave / SEQ; const float* xr = x + (size_t)wave * D;
    float v[16]; float s = 0.f;
#pragma unroll
    for (int j = 0; j < 4; ++j) { const f32x4 t = *(const f32x4*)(xr + j * 256 + lane * 4); v[4 * j] = t[0]; v[4 * j + 1] = t[1]; v[4 * j + 2] = t[2]; v[4 * j + 3] = t[3]; s += t[0] * t[0] + t[1] * t[1] + t[2] * t[2] + t[3] * t[3]; }
    s = wave_sum(s);
    const float r = rsqrtf(s * (1.f / D) + EPS); const float* mb = mod + (size_t)b * NMOD * D;
#pragma unroll
    for (int j = 0; j < 4; ++j)
#pragma unroll
        for (int i = 0; i < 4; ++i) { const int col = j * 256 + lane * 4 + i; const float y = v[4 * j + i] * r * g[col] * (1.f + mb[sc_off + col]) + mb[sh_off + col]; out[(size_t)wave * D + col] = (bf16)f2bf(y); }
}
template <int MODE>
__global__ __launch_bounds__(256) void dbg_gemm(const bf16* __restrict__ A, const float* __restrict__ B, int N, int K, void* Cout, const float* X, const float* __restrict__ mod, int gate_off) {
    __shared__ __attribute__((aligned(16))) bf16 sA[128][40];
    __shared__ __attribute__((aligned(16))) bf16 sB[128][40];
    const int tid = threadIdx.x, lane = tid & 63, w = tid >> 6, wr = w >> 1, wc = w & 1;
    const int m0 = blockIdx.y * 128, n0 = blockIdx.x * 128;
    f32x4 acc[4][4];
#pragma unroll
    for (int i = 0; i < 4; ++i)
#pragma unroll
        for (int j = 0; j < 4; ++j) acc[i][j] = (f32x4){0.f, 0.f, 0.f, 0.f};
    for (int k0 = 0; k0 < K; k0 += 32) {
        { const int r = tid >> 1, cc = (tid & 1) * 16; const bf16x8* src = (const bf16x8*)(A + (size_t)(m0 + r) * K + k0 + cc); *(bf16x8*)&sA[r][cc] = src[0]; *(bf16x8*)&sA[r][cc + 8] = src[1]; }
        { const int kk = tid >> 3, nn = (tid & 7) * 16; const float* src = B + (size_t)(k0 + kk) * N + n0 + nn;
#pragma unroll
          for (int i = 0; i < 16; ++i) sB[nn + i][kk] = (bf16)f2bf(src[i]); }
        __syncthreads();
        bf16x8 a[4], b[4];
#pragma unroll
        for (int i = 0; i < 4; ++i) a[i] = *(const bf16x8*)&sA[wr * 64 + i * 16 + (lane & 15)][8 * (lane >> 4)];
#pragma unroll
        for (int j = 0; j < 4; ++j) b[j] = *(const bf16x8*)&sB[wc * 64 + j * 16 + (lane & 15)][8 * (lane >> 4)];
#pragma unroll
        for (int i = 0; i < 4; ++i)
#pragma unroll
            for (int j = 0; j < 4; ++j) acc[i][j] = __builtin_amdgcn_mfma_f32_16x16x32_bf16(a[i], b[j], acc[i][j], 0, 0, 0);
        __syncthreads();
    }
#pragma unroll
    for (int i = 0; i < 4; ++i)
#pragma unroll
        for (int j = 0; j < 4; ++j)
#pragma unroll
            for (int r = 0; r < 4; ++r) {
                const int row = m0 + wr * 64 + i * 16 + (lane >> 4) * 4 + r, col = n0 + wc * 64 + j * 16 + (lane & 15);
                const float v = acc[i][j][r]; const size_t o = (size_t)row * N + col;
                if (MODE == 0) ((bf16*)Cout)[o] = (bf16)f2bf(v);
                else if (MODE == 2) { const float t = v > 0.f ? v : 0.f; ((bf16*)Cout)[o] = (bf16)f2bf(t * t); }
                else { const int b_ = row / SEQ; const float gt = mod[(size_t)b_ * NMOD * D + gate_off + col]; const float base = (MODE == 1) ? X[o] : ((float*)Cout)[o]; ((float*)Cout)[o] = base + gt * v; }
            }
}
__global__ __launch_bounds__(64) void dbg_attn(const bf16* __restrict__ Q, const bf16* __restrict__ Kb, const bf16* __restrict__ Vb, const float* __restrict__ sinks, bf16* __restrict__ MIX) {
    const int id = blockIdx.x * blockDim.x + threadIdx.x;
    if (id >= M * NH) return;
    const int m = id / NH, hq = id % NH, kvh = hq / 4, b = m / SEQ, t = m % SEQ;
    float q[64], acc[64];
#pragma unroll
    for (int d = 0; d < 64; ++d) { q[d] = bf2f(Q[(size_t)m * AW + hq * 64 + d]); acc[d] = 0.f; }
    float mx = -1e30f, l = 0.f;
    const int j0 = t - 127 < 0 ? 0 : t - 127;
    for (int j = j0; j <= t; ++j) {
        const size_t kr = (size_t)(b * SEQ + j); float s = 0.f;
#pragma unroll
        for (int d = 0; d < 64; ++d) s += q[d] * bf2f(Kb[kr * KVW + kvh * 64 + d]);
        s *= 0.6931471805599453f;
        const float mn = fmaxf(mx, s); const float f = __expf(mx - mn), p = __expf(s - mn);
        l = l * f + p;
#pragma unroll
        for (int d = 0; d < 64; ++d) acc[d] = acc[d] * f + p * bf2f(Vb[kr * KVW + kvh * 64 + d]);
        mx = mn;
    }
    const float sk = sinks[hq]; const float mn = fmaxf(mx, sk); const float f = __expf(mx - mn);
    l = l * f + __expf(sk - mn);
    const float inv = f / l;
#pragma unroll
    for (int d = 0; d < 64; ++d) MIX[(size_t)m * D + hq * 64 + d] = (bf16)f2bf(acc[d] * inv);
}
__global__ void dbg_pool(const bf16* __restrict__ U, bf16* __restrict__ POOLED) {
    const int id = blockIdx.x * blockDim.x + threadIdx.x;
    if (id >= M * PW) return;
    const int m = id / PW, c = id % PW, g = c / 128, w = 2 << g, t = m % SEQ;
    const int cnt = (t + 1) < w ? (t + 1) : w; float s = 0.f;
    for (int j = 0; j < cnt; ++j) s += bf2f(U[(size_t)(m - j) * PW + c]);
    POOLED[(size_t)m * PW + c] = (bf16)f2bf(s / (float)cnt - bf2f(U[(size_t)m * PW + c]));
}
__global__ void dbg_copy_pooled(const bf16* __restrict__ MIX, bf16* __restrict__ POOLED) {
    const int id = blockIdx.x * blockDim.x + threadIdx.x;
    if (id >= M * PW) return;
    POOLED[id] = MIX[(size_t)(id / PW) * D + AW + (id % PW)];
}
__global__ void dbg_poolmm(const bf16* __restrict__ POOLED, const float* __restrict__ pool_w, const float* __restrict__ pool_scale, bf16* __restrict__ MIX) {
    const int id = blockIdx.x * blockDim.x + threadIdx.x;
    if (id >= M * PW) return;
    const int m = id / PW, c = id % PW, g = c / 128, d = c % 128; float s = 0.f;
    for (int k = 0; k < 128; ++k) s += bf2f(POOLED[(size_t)m * PW + g * 128 + k]) * pool_w[(size_t)(g * 128 + k) * 128 + d];
    MIX[(size_t)m * D + AW + c] = (bf16)f2bf(s * pool_scale[c]);
}
extern "C" void kernel_launch(void* const* d_in, const int* in_sizes, int n_in, void* d_out, int out_size, void* d_ws, size_t ws_size, hipStream_t stream) {
    static int grid = 0;
    if (grid == 0) {
        hipFuncSetAttribute((const void*)fwd_megakernel, hipFuncAttributeMaxDynamicSharedMemorySize, LDS_BYTES);
        grid = 256;
    }
    (void)hipMemsetAsync((char*)d_ws + WS_CTL, 0, CTL_ZERO_BYTES, stream);
    Args a{};
    for (int i = 0; i < 16; ++i) a.in[i] = d_in[i];
    a.out = (float*)d_out; a.ws = (unsigned char*)d_ws;
    unsigned char* ws = (unsigned char*)d_ws;
    const float* x = (const float*)d_in[0]; const float* sinks = (const float*)d_in[9]; const float* pool_w = (const float*)d_in[10]; const float* pool_scale = (const float*)d_in[11];
    const float* w_o = (const float*)d_in[12]; const float* norm2_g = (const float*)d_in[13]; const float* w1 = (const float*)d_in[14]; const float* w2 = (const float*)d_in[15];
    float* out = (float*)d_out; float* mod = (float*)(ws + WS_MOD);
    bf16 *Q = (bf16*)(ws + WS_Q), *Kb = (bf16*)(ws + WS_K), *Vb = (bf16*)(ws + WS_V), *U = (bf16*)(ws + WS_U), *MIX = (bf16*)(ws + WS_MIX), *Z2 = (bf16*)(ws + WS_XB1), *H = (bf16*)(ws + WS_H);
#define PH(lo_, hi_) do { a.ph_lo = lo_; a.ph_hi = hi_; for (int li = lo_; li < hi_; ++li) { a.ph_lo = li; a.ph_hi = li + 1; hipLaunchKernelGGL(fwd_megakernel, dim3(grid), dim3(NWAVES * 64), LDS_BYTES, stream, a); } } while (0)
    PH(0, 3);
#if HYB == 1
    dbg_attn<<<M * NH / 64, 64, 0, stream>>>(Q, Kb, Vb, sinks, MIX);
    dbg_pool<<<M * PW / 256, 256, 0, stream>>>(U, Z2);
#else
    PH(3, 4);
    dbg_copy_pooled<<<M * PW / 256, 256, 0, stream>>>(MIX, Z2);
#endif
    dbg_poolmm<<<M * PW / 256, 256, 0, stream>>>(Z2, pool_w, pool_scale, MIX);
    dbg_gemm<1><<<dim3(D / 128, M / 128), 256, 0, stream>>>(MIX, w_o, D, D, out, x, mod, 2 * D);
    dbg_norm<<<M / 4, 256, 0, stream>>>(out, norm2_g, mod, 3 * D, 4 * D, Z2);
    dbg_gemm<2><<<dim3(FF / 128, M / 128), 256, 0, stream>>>(Z2, w1, FF, D, H, nullptr, mod, 0);
    dbg_gemm<3><<<dim3(D / 128, M / 128), 256, 0, stream>>>(H, w2, D, FF, out, nullptr, mod, 5 * D);
}
#endif
```

```cpp
#include <hip/hip_runtime.h>
#include <cstdio>
#include <cstdint>
#include <cmath>
namespace pg8 {
#define PG8_LAS __attribute__((address_space(3)))
typedef unsigned short bf16_t;
typedef short bf16x8 __attribute__((ext_vector_type(8)));
typedef float f32x4 __attribute__((ext_vector_type(4)));
typedef unsigned u32x4 __attribute__((ext_vector_type(4)));
constexpr int BM = 256, BK = 64, HALF = 128, HTB = HALF * BK * 2  , STAGE_BYTES = 8 * HTB, NXCD = 8, WGM = 8;

__host__ __device__ __forceinline__ int lds_byte(int r, int c) { const int st = (r >> 4) * 2 + (c >> 5), rr = r & 15, cc = c & 31, ob = rr * 64 + cc * 2; return st * 1024 + (ob ^ (((ob >> 9) & 1) << 5)); }
__host__ __device__ __forceinline__ void stage_rc(int b, int& R, int& C) { const int st = b / 1024, sb = b % 1024, swz = sb ^ (((sb >> 9) & 1) << 5); R = (st >> 1) * 16 + swz / 64; C = (st & 1) * 32 + (swz % 64) / 2; }
__host__ __device__ __forceinline__ int perm32(int rho) { const int n = rho >> 4, i = rho & 15; return 8 * (i >> 2) + 4 * n + (i & 3); }

struct Unit { int pm, pn; };
struct Gemm { const bf16_t* A; const bf16_t* Bt; int M, N, K; };

struct StaticOrder {
    int nM, nN, nwg, G, c, wgm, rev;
    __host__ __device__ void init(int M, int N, int G_, int c_, int wgm_ = WGM, int rev_ = 0) { nM = M / BM; nN = N / BM; nwg = nM * nN; G = G_; c = c_; wgm = wgm_; rev = (rev_ && nwg % G_ == 0) ? 1 : 0; }
    __host__ __device__ bool next(int i, Unit& u) const {
        if ((long)i * G + c >= nwg) return false;
        const long L = (long)(rev ? (nwg / G - 1 - i) : i) * G + c;
        int wgid = (int)L; { const int q = nwg / NXCD, r = nwg % NXCD, xcd = wgid % NXCD, off = wgid / NXCD; wgid = (xcd < r ? xcd * (q + 1) : r * (q + 1) + (xcd - r) * q) + off; }
        const int nig = wgm * nN, gid = wgid / nig, fm = gid * wgm, gsz = (nM - fm) < wgm ? (nM - fm) : wgm;
        u.pm = fm + ((wgid % nig) % gsz); u.pn = (wgid % nig) / gsz; return true;
    }
    __device__ __forceinline__ void a_ready(const Unit&) const {}
    __device__ __forceinline__ void done(const Unit&) const {}
};

__device__ __forceinline__ unsigned cvt_pk_bf16(float lo, float hi) { unsigned r; asm volatile("v_cvt_pk_bf16_f32 %0, %1, %2" : "=v"(r) : "v"(lo), "v"(hi)); return r; }
typedef float f32x2 __attribute__((ext_vector_type(2)));
constexpr int SEQ_ = 4096, DM_ = 1024, NMOD_ = 6;
constexpr float EPS_ = 1e-6f;
constexpr float QSCALE = 0.125f * 1.4426950408889634f;

__device__ __forceinline__ u32x4 pack8(const f32x4 a, const f32x4 b) { u32x4 w; w.x = cvt_pk_bf16(a[0], a[1]); w.y = cvt_pk_bf16(a[2], a[3]); w.z = cvt_pk_bf16(b[0], b[1]); w.w = cvt_pk_bf16(b[2], b[3]); return w; }

struct EpiProj {
    static constexpr bool PERM = true, AFTER_DRAIN = false;
    bf16_t *Q, *Kb, *V, *U; const float* rope; const float* qg; const float* kg;
    __device__ __forceinline__ void operator()(const f32x4 (&acc)[2][2][4][2], const Unit& u, int wr, int wc, int fr, int fq) const {
        const int row0 = u.pm * BM + wr * 64 + fr;
        if (u.pn >= 3 || (u.pn == 2 && wc >= 2)) {
            bf16_t* base; int pitch;
            if (u.pn >= 3) { base = U + (u.pn - 3) * 256 + wc * 64 + 8 * fq; pitch = 512; } else { base = V + (wc - 2) * 64 + 8 * fq; pitch = 128; }
#pragma unroll
            for (int ai = 0; ai < 2; ++ai)
#pragma unroll
                for (int m = 0; m < 4; ++m) { bf16_t* rowp = base + (size_t)(row0 + ai * HALF + m * 16) * pitch;
#pragma unroll
                    for (int bj = 0; bj < 2; ++bj) *(u32x4*)(rowp + bj * 32) = pack8(acc[ai][bj][m][0], acc[ai][bj][m][1]); }
        } else {
            const bool isq = u.pn < 2; const float* g = isq ? qg : kg; const float sc = isq ? QSCALE : 1.0f;
            bf16_t* base = isq ? Q + (4 * u.pn + wc) * 64 + 8 * fq : Kb + wc * 64 + 8 * fq; const int pitch = isq ? 512 : 128;
            f32x4 gv[2][2];
#pragma unroll
            for (int bj = 0; bj < 2; ++bj)
#pragma unroll
                for (int n = 0; n < 2; ++n) gv[bj][n] = *(const f32x4*)(g + 32 * bj + 8 * fq + 4 * n);
#pragma unroll
            for (int ai = 0; ai < 2; ++ai)
#pragma unroll
                for (int m = 0; m < 4; ++m) {
                    const int row = row0 + ai * HALF + m * 16;
                    f32x4 cs[2], sn[2];
#pragma unroll
                    for (int n = 0; n < 2; ++n) { cs[n] = *(const f32x4*)(rope + (size_t)row * 16 + 4 * n); sn[n] = *(const f32x4*)(rope + (size_t)row * 16 + 8 + 4 * n); }
                    float ss = 0.f;
#pragma unroll
                    for (int bj = 0; bj < 2; ++bj)
#pragma unroll
                        for (int n = 0; n < 2; ++n) { const f32x4 v = acc[ai][bj][m][n]; ss += (v[0] * v[0] + v[1] * v[1]) + (v[2] * v[2] + v[3] * v[3]); }
                    ss += __shfl_xor(ss, 16); ss += __shfl_xor(ss, 32);
                    const float r = rsqrtf(ss * (1.0f / 64.0f) + EPS_);
                    f32x4 y[2][2];
#pragma unroll
                    for (int bj = 0; bj < 2; ++bj)
#pragma unroll
                        for (int n = 0; n < 2; ++n) y[bj][n] = acc[ai][bj][m][n] * r * gv[bj][n];
#pragma unroll
                    for (int n = 0; n < 2; ++n)
#pragma unroll
                        for (int e = 0; e < 4; ++e) { const float mine = y[0][n][e]; const float other = __shfl_xor(mine, 16);
                            const float ro = (fq == 0) ? mine * cs[n][e] - other * sn[n][e] : mine * cs[n][e] + other * sn[n][e];
                            y[0][n][e] = (fq < 2) ? ro : mine; }
                    bf16_t* rowp = base + (size_t)row * pitch;
#pragma unroll
                    for (int bj = 0; bj < 2; ++bj) *(u32x4*)(rowp + bj * 32) = pack8(y[bj][0] * sc, y[bj][1] * sc);
                }
        }
    }
};

struct EpiWo {
    static constexpr bool PERM = true, AFTER_DRAIN = false;
    const float* x; bf16_t* xb1; const float* mod; float* stats; bf16_t* z; const float* a2;
    __device__ __forceinline__ void operator()(const f32x4 (&acc)[2][2][4][2], const Unit& u, int wr, int wc, int fr, int fq) const {
        const int b = (u.pm * BM) / SEQ_; const int col0 = u.pn * BM + wc * 32 + 8 * fq; const int row0 = u.pm * BM + wr * 64 + fr;
        f32x4 gv[2][2], av[2][2];
#pragma unroll
        for (int bj = 0; bj < 2; ++bj)
#pragma unroll
            for (int n = 0; n < 2; ++n) { gv[bj][n] = *(const f32x4*)(mod + (size_t)b * NMOD_ * DM_ + 2 * DM_ + col0 + bj * HALF + 4 * n); av[bj][n] = *(const f32x4*)(a2 + (size_t)b * DM_ + col0 + bj * HALF + 4 * n); }
#pragma unroll
        for (int ai = 0; ai < 2; ++ai)
#pragma unroll
            for (int m = 0; m < 4; ++m) {
                const int row = row0 + ai * HALF + m * 16; const size_t off = (size_t)row * DM_ + col0; float ss = 0.f;
#pragma unroll
                for (int bj = 0; bj < 2; ++bj) {
                    const f32x4 xa = __builtin_nontemporal_load((const f32x4*)(x + off + bj * HALF)), xb = __builtin_nontemporal_load((const f32x4*)(x + off + bj * HALF + 4));
                    const f32x4 v0 = xa + gv[bj][0] * acc[ai][bj][m][0], v1 = xb + gv[bj][1] * acc[ai][bj][m][1];
                    ss += (v0[0] * v0[0] + v0[1] * v0[1]) + (v0[2] * v0[2] + v0[3] * v0[3]) + (v1[0] * v1[0] + v1[1] * v1[1]) + (v1[2] * v1[2] + v1[3] * v1[3]);
                    *(u32x4*)(xb1 + off + bj * HALF) = pack8(v0, v1);
                    *(u32x4*)(z + off + bj * HALF) = pack8(v0 * av[bj][0], v1 * av[bj][1]);
                }
                ss += __shfl_xor(ss, 16); ss += __shfl_xor(ss, 32);
                if (fq == 0) stats[(size_t)row * 16 + u.pn * 4 + wc] = ss;
            }
    }
};

struct EpiUp {
    static constexpr bool PERM = true, AFTER_DRAIN = false;
    bf16_t* H; const float* stats; const float* bias2; int ldc;
    __device__ __forceinline__ void operator()(const f32x4 (&acc)[2][2][4][2], const Unit& u, int wr, int wc, int fr, int fq) const {
        const int b = (u.pm * BM) / SEQ_; const int col0 = u.pn * BM + wc * 32 + 8 * fq; const int row0 = u.pm * BM + wr * 64 + fr;
        f32x4 bv[2][2];
#pragma unroll
        for (int bj = 0; bj < 2; ++bj)
#pragma unroll
            for (int n = 0; n < 2; ++n) bv[bj][n] = *(const f32x4*)(bias2 + (size_t)b * ldc + col0 + bj * HALF + 4 * n);
#pragma unroll
        for (int ai = 0; ai < 2; ++ai)
#pragma unroll
            for (int m = 0; m < 4; ++m) {
                const int row = row0 + ai * HALF + m * 16;
                const f32x4 st = *(const f32x4*)(stats + (size_t)row * 16 + 4 * fq);
                float s = (st[0] + st[1]) + (st[2] + st[3]); s += __shfl_xor(s, 16); s += __shfl_xor(s, 32);
                const float r = rsqrtf(s * (1.0f / DM_) + EPS_);
                bf16_t* rowp = H + (size_t)row * ldc + col0;
#pragma unroll
                for (int bj = 0; bj < 2; ++bj) {
                    f32x4 v0 = acc[ai][bj][m][0] * r + bv[bj][0], v1 = acc[ai][bj][m][1] * r + bv[bj][1];
#pragma unroll
                    for (int e = 0; e < 4; ++e) { const float t0 = fmaxf(v0[e], 0.f), t1 = fmaxf(v1[e], 0.f); v0[e] = t0 * t0; v1[e] = t1 * t1; }
                    *(u32x4*)(rowp + bj * HALF) = pack8(v0, v1);
                }
            }
    }
};

struct EpiDown {
    static constexpr bool PERM = true, AFTER_DRAIN = false;
    float* out; const bf16_t* xb1; const float* mod;
    __device__ __forceinline__ void operator()(const f32x4 (&acc)[2][2][4][2], const Unit& u, int wr, int wc, int fr, int fq) const {
        const int b = (u.pm * BM) / SEQ_; const int col0 = u.pn * BM + wc * 32 + 8 * fq; const int row0 = u.pm * BM + wr * 64 + fr;
        f32x4 gv[2][2];
#pragma unroll
        for (int bj = 0; bj < 2; ++bj)
#pragma unroll
            for (int n = 0; n < 2; ++n) gv[bj][n] = *(const f32x4*)(mod + (size_t)b * NMOD_ * DM_ + 5 * DM_ + col0 + bj * HALF + 4 * n);
#pragma unroll
        for (int ai = 0; ai < 2; ++ai)
#pragma unroll
            for (int m = 0; m < 4; ++m) {
                const size_t off = (size_t)(row0 + ai * HALF + m * 16) * DM_ + col0;
#pragma unroll
                for (int bj = 0; bj < 2; ++bj) {
                    const u32x4 w = *(const u32x4*)(xb1 + off + bj * HALF);
                    const f32x4 xa = (f32x4){__builtin_bit_cast(float, w.x << 16), __builtin_bit_cast(float, w.x & 0xffff0000u), __builtin_bit_cast(float, w.y << 16), __builtin_bit_cast(float, w.y & 0xffff0000u)};
                    const f32x4 xb = (f32x4){__builtin_bit_cast(float, w.z << 16), __builtin_bit_cast(float, w.z & 0xffff0000u), __builtin_bit_cast(float, w.w << 16), __builtin_bit_cast(float, w.w & 0xffff0000u)};
                    *(f32x4*)(out + off + bj * HALF) = xa + gv[bj][0] * acc[ai][bj][m][0]; *(f32x4*)(out + off + bj * HALF + 4) = xb + gv[bj][1] * acc[ai][bj][m][1];
                }
            }
    }
};

template <class Epi, class Sched, bool ALIGN_EPI = false, bool SP2 = false>
__device__ __forceinline__ void gemm_phase(PG8_LAS unsigned char* lds, const Gemm g, const Sched& S, const Epi& E) {
    const int tid = threadIdx.x, wid = __builtin_amdgcn_readfirstlane(tid >> 6), lane = tid & 63, wr = wid >> 2, wc = wid & 3, fr = lane & 15, fq = lane >> 4;
    const int K = g.K, nt = K / BK;
    unsigned voffA[2], voffB[2];
#pragma unroll
    for (int i = 0; i < 2; ++i) { int R, C; stage_rc(tid * 16 + i * 8192, R, C); const int Rb = Epi::PERM ? ((R & ~31) + perm32(R & 31)) : R;
        voffA[i] = (unsigned)(R * K + C) * 2u; voffB[i] = (unsigned)(Rb * K + C) * 2u; }
    const size_t kstep = (size_t)(BK * 2);
    const size_t hstep = (size_t)HALF * K * 2;
    const size_t tstep = 2 * hstep;
    const unsigned ldsw = (unsigned)wid * 1024u;
    const int aoff = lds_byte(wr * 64 + fr, fq * 8), boff = lds_byte(wc * 32 + fr, fq * 8);
#define PG8_SA(b, h) (((b) * 2 + (h)) * HTB)
#define PG8_SB(b, h) ((4 + (b) * 2 + (h)) * HTB)
#define PG8_STAGE(bufoff, gbase, voff) do { _Pragma("unroll") for (int _i = 0; _i < 2; ++_i) \
        __builtin_amdgcn_global_load_lds((const unsigned*)((const char*)(gbase) + (voff)[_i]), (PG8_LAS unsigned*)(lds + (bufoff) + ldsw + _i * 8192), 16, 0, 0); } while (0)
#define PG8_LDA(dst, b, h) do { _Pragma("unroll") for (int m = 0; m < 4; ++m) _Pragma("unroll") for (int k = 0; k < 2; ++k) dst[m][k] = *(const PG8_LAS bf16x8*)(lds + PG8_SA(b, h) + aoff + m * 2048 + k * 1024); } while (0)
#define PG8_LDB(dst, b, h) do { _Pragma("unroll") for (int n = 0; n < 2; ++n) _Pragma("unroll") for (int k = 0; k < 2; ++k) dst[n][k] = *(const PG8_LAS bf16x8*)(lds + PG8_SB(b, h) + boff + n * 2048 + k * 1024); } while (0)
#define PG8_MMA(ai, bj, At, Bt) do { __builtin_amdgcn_s_setprio(1); _Pragma("unroll") for (int m = 0; m < 4; ++m) _Pragma("unroll") for (int n = 0; n < 2; ++n) _Pragma("unroll") for (int k = 0; k < 2; ++k) \
        acc[ai][bj][m][n] = __builtin_amdgcn_mfma_f32_16x16x32_bf16(Bt[n][k], At[m][k], acc[ai][bj][m][n], 0, 0, 0); __builtin_amdgcn_s_setprio(0); } while (0)
#define PG8_WAIT_V(n) asm volatile("s_waitcnt vmcnt(" #n ")" ::: "memory")
#define PG8_WAIT_L(n) asm volatile("s_waitcnt lgkmcnt(" #n ")" ::: "memory")
#define PG8_BAR __builtin_amdgcn_s_barrier()
#define PG8_SCHED __builtin_amdgcn_sched_barrier(0)
    Unit cur, nxt; int ui = 0;
    if (!S.next(0, cur)) return;
    f32x4 acc[2][2][4][2];
#pragma unroll
    for (int a = 0; a < 2; ++a)
#pragma unroll
        for (int b = 0; b < 2; ++b)
#pragma unroll
            for (int m = 0; m < 4; ++m)
#pragma unroll
                for (int n = 0; n < 2; ++n) acc[a][b][m][n] = (f32x4){0.f, 0.f, 0.f, 0.f};
    bf16x8 At[4][2], B0[2][2], B1[2][2];
    const char* cA = (const char*)g.A + (size_t)cur.pm * tstep; const char* cB = (const char*)g.Bt + (size_t)cur.pn * tstep;
    S.a_ready(cur);
    if constexpr (SP2) {
        PG8_STAGE(PG8_SB(0, 0), cB, voffB); PG8_STAGE(PG8_SB(0, 1), cB + hstep, voffB); PG8_STAGE(PG8_SA(0, 0), cA, voffA); PG8_STAGE(PG8_SA(0, 1), cA + hstep, voffA);
        if (wr == 1) PG8_BAR;
        PG8_WAIT_V(2); PG8_BAR;
        PG8_STAGE(PG8_SB(1, 0), cB + kstep, voffB); PG8_STAGE(PG8_SA(1, 0), cA + kstep, voffA); PG8_STAGE(PG8_SB(1, 1), cB + hstep + kstep, voffB);
        PG8_WAIT_V(6); PG8_BAR;
    } else {
        PG8_STAGE(PG8_SB(0, 0), cB, voffB); PG8_STAGE(PG8_SA(0, 0), cA, voffA); PG8_STAGE(PG8_SB(0, 1), cB + hstep, voffB); PG8_STAGE(PG8_SA(0, 1), cA + hstep, voffA);
        if (wr == 1) PG8_BAR;
        PG8_WAIT_V(4); PG8_BAR;
        PG8_STAGE(PG8_SB(1, 0), cB + kstep, voffB); PG8_STAGE(PG8_SA(1, 0), cA + kstep, voffA); PG8_STAGE(PG8_SB(1, 1), cB + hstep + kstep, voffB);
        PG8_WAIT_V(6); PG8_BAR;
    }
    for (;;) {
        const bool has_next = S.next(ui + 1, nxt);
        const char* nA = has_next ? (const char*)g.A + (size_t)nxt.pm * tstep : cA; const char* nB = has_next ? (const char*)g.Bt + (size_t)nxt.pn * tstep : cB;
        for (int t = 0; t < nt; t += 2) {
            const bool last = (t == nt - 2);
            const char* a1 = cA + (size_t)(t + 1) * kstep;
            const char* a2 = last ? nA : cA + (size_t)(t + 2) * kstep; const char* b2 = last ? nB : cB + (size_t)(t + 2) * kstep;
            const char* a3 = a2 + kstep; const char* b3 = b2 + kstep;
            if (last && has_next) S.a_ready(nxt);
            if constexpr (SP2) {
            PG8_LDB(B0, 0, 0); PG8_LDB(B1, 0, 1); PG8_SCHED; PG8_LDA(At, 0, 0); PG8_STAGE(PG8_SA(1, 1), a1 + hstep, voffA);
            PG8_WAIT_V(8); PG8_WAIT_L(0); PG8_BAR; PG8_MMA(0, 0, At, B0); PG8_MMA(0, 1, At, B1); PG8_BAR; PG8_SCHED;
            PG8_LDA(At, 0, 1); PG8_STAGE(PG8_SB(0, 0), b2, voffB); PG8_STAGE(PG8_SB(0, 1), b2 + hstep, voffB); PG8_STAGE(PG8_SA(0, 0), a2, voffA);
            PG8_WAIT_V(8); PG8_WAIT_L(0); PG8_BAR; PG8_MMA(1, 0, At, B0); PG8_MMA(1, 1, At, B1); PG8_BAR; PG8_SCHED;
            PG8_LDB(B0, 1, 0); PG8_LDB(B1, 1, 1); PG8_SCHED; PG8_LDA(At, 1, 0); PG8_STAGE(PG8_SA(0, 1), a2 + hstep, voffA);
            PG8_WAIT_V(8); PG8_WAIT_L(0); PG8_BAR; PG8_MMA(0, 0, At, B0); PG8_MMA(0, 1, At, B1); PG8_BAR; PG8_SCHED;
            PG8_LDA(At, 1, 1); PG8_STAGE(PG8_SB(1, 0), b3, voffB); PG8_STAGE(PG8_SB(1, 1), b3 + hstep, voffB); PG8_STAGE(PG8_SA(1, 0), a3, voffA);
            PG8_WAIT_V(8); PG8_WAIT_L(0); PG8_BAR; PG8_MMA(1, 0, At, B0); PG8_MMA(1, 1, At, B1); PG8_BAR; PG8_SCHED;
            } else {
            PG8_LDB(B0, 0, 0); PG8_SCHED; PG8_LDA(At, 0, 0); PG8_STAGE(PG8_SA(1, 1), a1 + hstep, voffA);
            PG8_WAIT_L(8); PG8_BAR; PG8_WAIT_L(0); PG8_MMA(0, 0, At, B0); PG8_BAR; PG8_SCHED;
            PG8_LDB(B1, 0, 1); PG8_STAGE(PG8_SB(0, 0), b2, voffB);
            PG8_BAR; PG8_WAIT_L(0); PG8_MMA(0, 1, At, B1); PG8_BAR;
            PG8_LDA(At, 0, 1); PG8_STAGE(PG8_SA(0, 0), a2, voffA);
            PG8_BAR; PG8_WAIT_L(0); PG8_MMA(1, 0, At, B0); PG8_BAR; PG8_SCHED;
            PG8_STAGE(PG8_SB(0, 1), b2 + hstep, voffB);
            PG8_WAIT_V(6); PG8_BAR; PG8_MMA(1, 1, At, B1); PG8_BAR;
            PG8_LDB(B0, 1, 0); PG8_SCHED; PG8_LDA(At, 1, 0); PG8_STAGE(PG8_SA(0, 1), a2 + hstep, voffA);
            PG8_WAIT_L(8); PG8_BAR; PG8_WAIT_L(0); PG8_MMA(0, 0, At, B0); PG8_BAR; PG8_SCHED;
            PG8_LDB(B1, 1, 1); PG8_STAGE(PG8_SB(1, 0), b3, voffB);
            PG8_BAR; PG8_WAIT_L(0); PG8_MMA(0, 1, At, B1); PG8_BAR;
            PG8_LDA(At, 1, 1); PG8_STAGE(PG8_SA(1, 0), a3, voffA);
            PG8_BAR; PG8_WAIT_L(0); PG8_MMA(1, 0, At, B0); PG8_BAR; PG8_SCHED;
            PG8_STAGE(PG8_SB(1, 1), b3 + hstep, voffB);
            PG8_WAIT_V(6); PG8_BAR; PG8_MMA(1, 1, At, B1); PG8_BAR;
            }
        }
        if constexpr (ALIGN_EPI) { if (wr == 0) PG8_BAR; }
        if constexpr (!Epi::AFTER_DRAIN) { E(acc, cur, wr, wc, fr, fq); S.done(cur); }
        if (!has_next) break;
#pragma unroll
        for (int a = 0; a < 2; ++a)
#pragma unroll
            for (int b = 0; b < 2; ++b)
#pragma unroll
                for (int m = 0; m < 4; ++m)
#pragma unroll
                    for (int n = 0; n < 2; ++n) acc[a][b][m][n] = (f32x4){0.f, 0.f, 0.f, 0.f};
        cur = nxt; cA = nA; cB = nB; ++ui;
        if constexpr (ALIGN_EPI) { if (wr == 1) PG8_BAR; }
    }
    PG8_WAIT_V(0);
    if constexpr (!ALIGN_EPI) { if (wr == 0) PG8_BAR; }
    PG8_BAR;
    if constexpr (Epi::AFTER_DRAIN) { E.fused(acc, cur, wr, wc, fr, fq, lds, wid, lane); S.done(cur); }
#undef PG8_SA
#undef PG8_SB
#undef PG8_STAGE
#undef PG8_LDA
#undef PG8_LDB
#undef PG8_MMA
#undef PG8_WAIT_V
#undef PG8_WAIT_L
#undef PG8_BAR
#undef PG8_SCHED
}
}

constexpr int NWAVES = 8;
constexpr int BATCH = 8, SEQ = 4096, D = 1024, M = BATCH * SEQ;
constexpr int NH = 8, NKV = 2, HD = 64, AW = 512, KVW = 128, PW = 512, INW = 1280, FF = 4096, NMOD = 6;
constexpr float EPS = 1e-6f;
#ifndef MK_N_LAUNCHES
#define MK_N_LAUNCHES 1
#endif
constexpr int N_PHASES = 7;
constexpr int N_LAUNCHES = MK_N_LAUNCHES;

constexpr size_t MiB = 1u << 20;
constexpr size_t WS_CTL = 0, CTL_ZERO_BYTES = 64 * 1024;
constexpr size_t WS_MOD = 1 * MiB;
constexpr size_t WS_BIAS2 = 1 * MiB + 256 * 1024;
constexpr size_t WS_A2 = 1 * MiB + 512 * 1024;
constexpr size_t WS_ROPE = 2 * MiB;
constexpr size_t WS_STATS = 4 * MiB;
constexpr size_t WS_WIN = 6 * MiB, WS_WO = 9 * MiB, WS_W2 = 20 * MiB;
constexpr size_t WS_XB1 = 32 * MiB;
constexpr size_t WS_H = 96 * MiB;
constexpr size_t WS_XN = 96 * MiB, WS_Q = 160 * MiB, WS_K = 192 * MiB, WS_V = 200 * MiB, WS_U = 208 * MiB, WS_MIX = 240 * MiB;
constexpr size_t WS_W1 = 352 * MiB;
constexpr size_t WS_Z2 = 416 * MiB;
constexpr size_t WS_END = 480 * MiB;
constexpr int CW_BAR = 1024;

constexpr int LDS_BYTES = 160 * 1024;
constexpr int MISC_OFF = LDS_BYTES - 256;
constexpr int ATT_K = 0, ATT_V = 24576, ATT_WS = 49152, ATT_OST = ATT_WS + NWAVES * 256, ATT_END = ATT_OST + NWAVES * 4096;

#define GAS __attribute__((address_space(1)))
#define LAS __attribute__((address_space(3)))
typedef unsigned short bf16;
typedef unsigned v4u __attribute__((ext_vector_type(4)));
typedef float f32x4 __attribute__((ext_vector_type(4)));
typedef short bf16x8 __attribute__((ext_vector_type(8)));
typedef GAS unsigned gu32;
typedef GAS unsigned long long gu64;
#define RLX_AGENT __ATOMIC_RELAXED, __HIP_MEMORY_SCOPE_AGENT
#define LDS_WAIT() asm volatile("s_waitcnt lgkmcnt(0)" ::: "memory")
#define VM_WAIT() asm volatile("s_waitcnt vmcnt(0)" ::: "memory")
__device__ __forceinline__ unsigned long long rt() { return __builtin_amdgcn_s_memrealtime(); }
__device__ __forceinline__ unsigned f2bf(float f) { unsigned u = __builtin_bit_cast(unsigned, f); return (u + 0x7fffu + ((u >> 16) & 1u)) >> 16; }
__device__ __forceinline__ unsigned pk2(float lo, float hi) { return f2bf(lo) | (f2bf(hi) << 16); }

#define XB_TMO      128
#define XB_XCNT(j)  (256  + 64 * (j))
#define XB_XSUB(j)  (1280 + 64 * (j))
#define XB_XGEN(j)  (2304 + 64 * (j))
#define XB_TOP      3328
#define XB_TOPGEN   3392
#define XCD_BAR_WORDS 3456
#define XB_SPIN_CAP (1u << 18)

__device__ __forceinline__ unsigned xb_ld(unsigned* p)              { return __hip_atomic_load(p, __ATOMIC_RELAXED, __HIP_MEMORY_SCOPE_AGENT); }
__device__ __forceinline__ unsigned xb_add(unsigned* p, unsigned v) { return __hip_atomic_fetch_add(p, v, __ATOMIC_RELAXED, __HIP_MEMORY_SCOPE_AGENT); }
__device__ __forceinline__ unsigned xb_xcc_id() { return (unsigned)__builtin_amdgcn_s_getreg((3 << 11) | 20) & 0xFu; }
#define XB_SPIN(cond, bar) do { unsigned _sp = 0; while (cond) { __builtin_amdgcn_s_sleep(1); \
    if ((++_sp & 255u) == 0u) { if (xb_ld(&(bar)[XB_TMO])) break; if (_sp > XB_SPIN_CAP) { atomicAdd(&(bar)[XB_TMO], 1u); break; } } } } while (0)

struct XcdBarrier {
    unsigned* bar; unsigned x;
    volatile LAS unsigned* st;
};

__device__ __forceinline__ XcdBarrier xcd_barrier_post(unsigned* bar, volatile LAS unsigned* st) {
    XcdBarrier b; b.bar = bar; b.x = xb_xcc_id(); b.st = st;
    if (threadIdx.x == 0) (void)xb_add(&bar[XB_XCNT(b.x)], 1u);
    return b;
}
__device__ __forceinline__ void xcd_barrier_complete(unsigned* bar, unsigned x, unsigned& nloc, unsigned& nx) {
    const unsigned G = gridDim.x * gridDim.y * gridDim.z;
    unsigned sum, cnt, mine, sp = 0u;
    for (;;) {
        sum = 0u; cnt = 0u; mine = 0u;
#pragma unroll
        for (unsigned j = 0; j < 16; ++j) { const unsigned c = xb_ld(&bar[XB_XCNT(j)]); sum += c; cnt += (c > 0u) ? 1u : 0u; mine = (j == x) ? c : mine; }
        if (sum == G) break;
        __builtin_amdgcn_s_sleep(1);
        if ((++sp & 255u) == 0u) { if (xb_ld(&bar[XB_TMO])) break; if (sp > XB_SPIN_CAP) { atomicAdd(&bar[XB_TMO], 1u); break; } }
    }
    nloc = mine > 0u ? mine : 1u; nx = cnt > 0u ? cnt : 1u;
}

__device__ __forceinline__ void xcd_barrier(const XcdBarrier& b) {
    asm volatile("s_waitcnt vmcnt(0)" ::: "memory");
    __syncthreads();
    if (threadIdx.x == 0) {
        unsigned* bar = b.bar;
        __builtin_amdgcn_s_waitcnt(0);
        unsigned nloc = b.st[0], nx = b.st[1];
        if (nloc == 0u) { xcd_barrier_complete(bar, b.x, nloc, nx); b.st[0] = nloc; b.st[1] = nx; }
        const unsigned old = xb_add(&bar[XB_XSUB(b.x)], 1u);
        const unsigned gen = old / nloc;
        if (old + 1u == (gen + 1u) * nloc) {
            __builtin_amdgcn_fence(__ATOMIC_RELEASE, "agent");
            asm volatile("s_waitcnt vmcnt(0)" ::: "memory");
            const unsigned og = xb_add(&bar[XB_TOP], 1u);
            const unsigned tg = og / nx;
            if (og + 1u == (tg + 1u) * nx) xb_add(&bar[XB_TOPGEN], 1u);
            else XB_SPIN(xb_ld(&bar[XB_TOPGEN]) == tg, bar);
            __builtin_amdgcn_fence(__ATOMIC_ACQUIRE, "agent");
            xb_add(&bar[XB_XGEN(b.x)], 1u);
            asm volatile("s_waitcnt vmcnt(0)" ::: "memory");
        } else {
            XB_SPIN(xb_ld(&bar[XB_XGEN(b.x)]) == gen, bar);
            __builtin_amdgcn_fence(__ATOMIC_ACQUIRE, "agent");
            asm volatile("s_waitcnt vmcnt(0)" ::: "memory");
        }
    }
    __syncthreads();
}

#define NTLOAD(p) __builtin_nontemporal_load(p)
typedef float f32x16 __attribute__((ext_vector_type(16)));
typedef short s16x4 __attribute__((ext_vector_type(4)));
struct Frame {
    LAS unsigned char* lds;
    int tid, lane, wave, vcu, G;
};
__device__ __forceinline__ float wave_sum(float v) {
#pragma unroll
    for (int o = 1; o < 64; o <<= 1) v += __shfl_xor(v, o);
    return v;
}
__device__ __forceinline__ float bf2f(unsigned short h) { return __builtin_bit_cast(float, (unsigned)h << 16); }
__device__ __forceinline__ float bflo(unsigned w) { return __builtin_bit_cast(float, w << 16); }
__device__ __forceinline__ float bfhi(unsigned w) { return __builtin_bit_cast(float, w & 0xffff0000u); }

__device__ __forceinline__ void p0_transpose_item(const float* W, int N, bf16* WT, int Kd, int k0, int n0, int dst_row0, LAS float* scr, int lane) {
    f32x4 v[8];
#pragma unroll
    for (int i = 0; i < 8; ++i) v[i] = NTLOAD((const GAS f32x4*)(W + (size_t)(k0 + 8 * i + (lane >> 3)) * N + n0 + 4 * (lane & 7)));
#pragma unroll
    for (int i = 0; i < 8; ++i) { LAS float* d = scr + (8 * i + (lane >> 3)) * 33 + 4 * (lane & 7); d[0] = v[i][0]; d[1] = v[i][1]; d[2] = v[i][2]; d[3] = v[i][3]; }
    LDS_WAIT(); asm volatile("" ::: "memory");
    const int c = lane & 7;
#pragma unroll
    for (int j = 0; j < 4; ++j) { const int n = (lane >> 3) + 8 * j; const LAS float* s = scr + (8 * c) * 33 + n;
        v4u o; o.x = pk2(s[0 * 33], s[1 * 33]); o.y = pk2(s[2 * 33], s[3 * 33]); o.z = pk2(s[4 * 33], s[5 * 33]); o.w = pk2(s[6 * 33], s[7 * 33]);
        *(GAS v4u*)(WT + (size_t)(dst_row0 + n) * Kd + k0 + 8 * c) = o; }
    LDS_WAIT(); asm volatile("" ::: "memory");
}
__device__ __forceinline__ int win_slot(int n) { const int pn = n >> 8, r = n & 255; return 256 * pn + 128 * ((r >> 5) & 1) + 32 * (r >> 6) + (r & 31); }

struct Ptrs {
    const float *x, *c, *w_ada, *b_ada, *norm1_g, *w_in, *q_norm_g, *k_norm_g, *sinks, *pool_w, *pool_scale, *w_o, *norm2_g, *w1, *w2; const int* positions;
    float *out, *mod, *bias2, *a2, *rope, *stats; bf16 *Win_t, *Wo_t, *W1_t, *W2_t, *XN, *Q, *K, *V, *U, *MIX, *XB1, *H, *Z2;
};

template <bool SILU> __device__ __forceinline__ void skinny_task(Frame& F, const float* src, int spitch, const float* W, int wpitch, const float* bias, float* out, int opitch, int t) {
    LAS float* vT = (LAS float*)F.lds;
    LAS float* red = (LAS float*)(F.lds + 65536);
    { float cv[16];
#pragma unroll
      for (int i = 0; i < 16; ++i) { const int idx = F.tid + 512 * i; cv[i] = src[(size_t)(idx >> 10) * spitch + (idx & 1023)]; }
#pragma unroll
      for (int i = 0; i < 16; ++i) { const int idx = F.tid + 512 * i, b = idx >> 10, k = idx & 1023; vT[k * 16 + b] = SILU ? cv[i] / (1.f + __expf(-cv[i])) : cv[i]; vT[k * 16 + 8 + b] = 0.f; } }
    __syncthreads();
    const int j0 = 64 * t, kb = 128 * F.wave, kq = F.lane >> 4, jl = F.lane & 15;
    f32x4 acc[4];
#pragma unroll
    for (int e = 0; e < 4; ++e) acc[e] = (f32x4){0.f, 0.f, 0.f, 0.f};
    const GAS float* wp = (const GAS float*)W + (size_t)(kb + kq) * wpitch + j0 + 4 * jl;
#pragma unroll
    for (int s0 = 0; s0 < 32; s0 += 16) {
        f32x4 wv[16];
#pragma unroll
        for (int s = 0; s < 16; ++s) wv[s] = NTLOAD((const GAS f32x4*)(wp + (size_t)(4 * (s0 + s)) * wpitch));
#pragma unroll
        for (int s = 0; s < 16; ++s) { const float a = vT[(kb + 4 * (s0 + s) + kq) * 16 + jl];
#pragma unroll
            for (int e = 0; e < 4; ++e) acc[e] = __builtin_amdgcn_mfma_f32_16x16x4f32(a, wv[s][e], acc[e], 0, 0, 0); }
    }
    if (F.lane < 32) {
#pragma unroll
        for (int e = 0; e < 4; ++e)
#pragma unroll
            for (int r = 0; r < 4; ++r) red[((F.wave * 4 + e) * 4 + r) * 32 + F.lane] = acc[e][r];
    }
    __syncthreads();
    { const int b = F.tid >> 6, col = F.tid & 63, e = col & 3, lane = (b >> 2) * 16 + (col >> 2), r = b & 3; float sum = 0.f;
#pragma unroll
      for (int w = 0; w < NWAVES; ++w) sum += red[((w * 4 + e) * 4 + r) * 32 + lane];
      out[(size_t)b * opitch + j0 + col] = sum + (bias ? bias[j0 + col] : 0.f); }
    __syncthreads();
}
__device__ __forceinline__ void p0_fold_task(Frame& F, const Ptrs& P, int t) {
    const int g = t >> 5, n0 = (t & 31) * 32;
    LAS float* Pm = (LAS float*)F.lds;
    LAS float* Wm = (LAS float*)(F.lds + 128 * 129 * 4);
    { float pv[32], wv[8];
#pragma unroll
      for (int i = 0; i < 32; ++i) pv[i] = P.pool_w[(size_t)g * 16384 + F.tid + 512 * i];
#pragma unroll
      for (int i = 0; i < 8; ++i) { const int idx = F.tid + 512 * i; wv[i] = P.w_o[(size_t)(512 + 128 * g + (idx >> 5)) * D + n0 + (idx & 31)]; }
      const float sc = P.pool_scale[128 * g + (F.tid & 127)];
#pragma unroll
      for (int i = 0; i < 32; ++i) { const int idx = F.tid + 512 * i; Pm[(idx >> 7) * 129 + (idx & 127)] = pv[i] * sc; }
#pragma unroll
      for (int i = 0; i < 8; ++i) { const int idx = F.tid + 512 * i; Wm[(idx >> 5) * 33 + (idx & 31)] = wv[i]; } }
    __syncthreads();
    const int c0 = 16 * F.wave, li = F.lane & 15, lq = F.lane >> 4;
    f32x4 acc0 = (f32x4){0.f, 0.f, 0.f, 0.f}, acc1 = acc0;
#pragma unroll 8
    for (int d0 = 0; d0 < 128; d0 += 4) {
        const float a = Pm[(c0 + li) * 129 + d0 + lq], b0 = Wm[(d0 + lq) * 33 + li], b1 = Wm[(d0 + lq) * 33 + 16 + li];
        acc0 = __builtin_amdgcn_mfma_f32_16x16x4f32(a, b0, acc0, 0, 0, 0); acc1 = __builtin_amdgcn_mfma_f32_16x16x4f32(a, b1, acc1, 0, 0, 0);
    }
#pragma unroll
    for (int r = 0; r < 4; ++r) { const int c = c0 + 4 * lq + r;
        P.Wo_t[(size_t)(n0 + li) * D + 512 + 128 * g + c] = (bf16)f2bf(acc0[r]); P.Wo_t[(size_t)(n0 + 16 + li) * D + 512 + 128 * g + c] = (bf16)f2bf(acc1[r]); }
    __syncthreads();
}
__device__ __forceinline__ void p0a_prologue(Frame& F, const Ptrs& P) {
    for (int t = F.vcu; t < 96; t += F.G) skinny_task<true>(F, P.c, D, P.w_ada, NMOD * D, P.b_ada, P.mod, NMOD * D, t);
    LAS float* scr = (LAS float*)(F.lds + F.wave * 16384);
    const int gw = (F.G - 1 - F.vcu) * NWAVES + F.wave, NGW = F.G * NWAVES;
    constexpr int I_IN = (D / 64) * (INW / 32), I_2 = (FF / 64) * (D / 32);
    for (int it = gw; it < I_IN; it += NGW) { const int nblk = INW / 32, kb = it / nblk, nb = it % nblk; p0_transpose_item(P.w_in, INW, P.Win_t, D, 64 * kb, 32 * nb, win_slot(32 * nb), scr, F.lane); }
    { const int nfree = F.G > 96 ? F.G - 96 : F.G, ordf = F.G > 96 ? F.vcu - 96 : F.vcu;
      if (ordf >= 0) for (int it = ordf * NWAVES + F.wave; it < I_2; it += nfree * NWAVES) { const int nblk = D / 32, kb = it / nblk, nb = it % nblk; p0_transpose_item(P.w2, D, P.W2_t, FF, 64 * kb, 32 * nb, 32 * nb, scr, F.lane); } }
    for (int idx = (F.vcu * NWAVES * 64 + F.tid); idx < M * 8; idx += F.G * NWAVES * 64) {
        const int m = idx >> 3, i = idx & 7;
        const float inv_freq = (i == 0) ? 1.0f : (i == 1) ? 0.1939227432012558f : (i == 2) ? 0.03760603070259094f : (i == 3) ? 0.007292664609849453f : (i == 4) ? 0.0014142135623842478f : (i == 5) ? 0.00027424818836152554f : (i == 6) ? 5.3182957344688475e-05f : 1.0313385246263351e-05f;
        const float ang = (float)P.positions[m] * inv_freq;
        const float I2PI_HI = 0.15915493667125702f, I2PI_LO = 6.4206382432985265e-09f;
        const float pr = ang * I2PI_HI, er = __builtin_fmaf(ang, I2PI_HI, -pr), rl = __builtin_fmaf(ang, I2PI_LO, er);
        const float fr = (pr - __builtin_rintf(pr)) + rl;
        P.rope[(size_t)m * 16 + i] = __builtin_amdgcn_cosf(fr); P.rope[(size_t)m * 16 + 8 + i] = __builtin_amdgcn_sinf(fr);
    }
}

__device__ __forceinline__ void p1_tail_work(Frame& F, const Ptrs& P, int ord, int cnt) {
    for (int t = ord; t < 128; t += cnt) p0_fold_task(F, P, t);
    for (int t = cnt - 1 - ord; t < FF / 64; t += cnt) skinny_task<false>(F, P.mod + 3 * D, NMOD * D, P.w1, FF, nullptr, P.bias2, FF, t);
    LAS float* scr = (LAS float*)(F.lds + F.wave * 16384);
    constexpr int I_1 = (D / 64) * (FF / 32), I_O = (AW / 64) * (D / 32);
    for (int it = ord * NWAVES + F.wave; it < I_1 + I_O; it += cnt * NWAVES) {
        int r = it;
        if (r < I_1) { const int nblk = FF / 32, kb = r / nblk, nb = r % nblk; p0_transpose_item(P.w1, FF, P.W1_t, D, 64 * kb, 32 * nb, 32 * nb, scr, F.lane); continue; } r -= I_1;
        { const int nblk = D / 32, kb = r / nblk, nb = r % nblk; p0_transpose_item(P.w_o, D, P.Wo_t, D, 64 * kb, 32 * nb, 32 * nb, scr, F.lane); }
    }
}

__device__ __forceinline__ void p0b_norm(Frame& F, const Ptrs& P) {
    const int gt = F.vcu * NWAVES * 64 + F.tid, NGT = F.G * NWAVES * 64;
    for (int i = gt; i < BATCH * D; i += NGT) { const int b = i >> 10, col = i & 1023; P.a2[i] = P.norm2_g[col] * (1.f + P.mod[(size_t)b * NMOD * D + 4 * D + col]); }
    const int gw = F.vcu * NWAVES + F.wave, NGW = F.G * NWAVES;
    for (int rb = gw; rb < M / 16; rb += NGW) {
        const int b = (rb * 16) / SEQ; const float* mb = P.mod + (size_t)b * NMOD * D;
        f32x4 av[4], sv[4];
#pragma unroll
        for (int j = 0; j < 4; ++j) { const int col = 256 * j + 4 * F.lane; const f32x4 g = *(const f32x4*)(P.norm1_g + col), sc = *(const f32x4*)(mb + D + col); av[j] = g * (sc + 1.0f); sv[j] = *(const f32x4*)(mb + col); }
        for (int rr = 0; rr < 16; rr += 4) {
            f32x4 v[4][4]; float s[4];
#pragma unroll
            for (int q = 0; q < 4; ++q) { const GAS f32x4* xr = (const GAS f32x4*)(P.x + (size_t)(rb * 16 + rr + q) * D) + F.lane;
#pragma unroll
                for (int j = 0; j < 4; ++j) v[q][j] = NTLOAD(xr + 64 * j); }
#pragma unroll
            for (int q = 0; q < 4; ++q) { float t = 0.f;
#pragma unroll
                for (int j = 0; j < 4; ++j) t += (v[q][j][0] * v[q][j][0] + v[q][j][1] * v[q][j][1]) + (v[q][j][2] * v[q][j][2] + v[q][j][3] * v[q][j][3]);
                s[q] = t; }
#pragma unroll
            for (int o = 1; o < 64; o <<= 1) {
#pragma unroll
                for (int q = 0; q < 4; ++q) s[q] += __shfl_xor(s[q], o); }
#pragma unroll
            for (int q = 0; q < 4; ++q) { const float r = rsqrtf(s[q] * (1.f / D) + EPS);
                GAS unsigned long long* o8 = (GAS unsigned long long*)(P.XN + (size_t)(rb * 16 + rr + q) * D) + F.lane;
#pragma unroll
                for (int j = 0; j < 4; ++j) { const f32x4 y = v[q][j] * r * av[j] + sv[j]; o8[64 * j] = (unsigned long long)pk2(y[0], y[1]) | ((unsigned long long)pk2(y[2], y[3]) << 32); } }
        }
    }
}

__device__ __forceinline__ int crow(int r, int hi) { return (r & 3) + 8 * (r >> 2) + 4 * hi; }
__device__ __forceinline__ unsigned cvtpk(float lo, float hi) { unsigned r; asm volatile("v_cvt_pk_bf16_f32 %0, %1, %2" : "=v"(r) : "v"(lo), "v"(hi)); return r; }
typedef short v4i16_t __attribute__((ext_vector_type(4)));
__device__ __forceinline__ s16x4 vtr(LAS const unsigned char* p) { return __builtin_bit_cast(s16x4, __builtin_amdgcn_ds_read_tr16_b64_v4i16((LAS v4i16_t*)p)); }

struct AttnRegs { v4u k[3], v[3]; bf16x8 q[4]; };
__device__ __forceinline__ void attn_load(Frame& F, const Ptrs& P, int unit, AttnRegs& R) {
    const int lane = F.lane, wid = F.wave, r32 = lane & 31, hi = lane >> 5;
    const int bk = unit >> 6, qb = unit & 63, b = bk >> 1, kvh = bk & 1, wh = wid & 1, hq = kvh * 4 + (wid >> 1);
    const long rowbase = (long)b * SEQ; const int q0 = qb * 64, kv0 = q0 - 128, qw0 = q0 + 32 * wh;
#pragma unroll
    for (int i = 0; i < 3; ++i) { const int kvr = kv0 + 64 * i + lane, kc = kvr < 0 ? 0 : kvr; const v4u t = *(const GAS v4u*)(P.K + (rowbase + kc) * KVW + kvh * 64 + wid * 8); const unsigned mk = kvr < 0 ? 0u : 0xffffffffu; R.k[i] = (v4u){t.x & mk, t.y & mk, t.z & mk, t.w & mk}; }
#pragma unroll
    for (int i = 0; i < 3; ++i) { const int kvr = kv0 + 64 * i + 16 * (wid & 3) + (lane >> 2), kc = kvr < 0 ? 0 : kvr; const v4u t = *(const GAS v4u*)(P.V + (rowbase + kc) * KVW + kvh * 64 + (wid >> 2) * 32 + (lane & 3) * 8); const unsigned mk = kvr < 0 ? 0u : 0xffffffffu; R.v[i] = (v4u){t.x & mk, t.y & mk, t.z & mk, t.w & mk}; }
    const bf16* Qw = P.Q + (rowbase + qw0 + r32) * AW + hq * 64 + hi * 8;
#pragma unroll
    for (int d0 = 0; d0 < 4; ++d0) R.q[d0] = *(const GAS bf16x8*)(Qw + d0 * 16);
}
__device__ __forceinline__ void attn_compute(Frame& F, const Ptrs& P, int unit, const bf16x8 (&qr)[4], float sink0, float sink1) {
    const int lane = F.lane, wid = F.wave, r32 = lane & 31, hi = lane >> 5;
    const int bk = unit >> 6, qb = unit & 63, b = bk >> 1, kvh = bk & 1, wh = wid & 1, hq = kvh * 4 + (wid >> 1);
    const long rowbase = (long)b * SEQ; const int q0 = qb * 64, qw0 = q0 + 32 * wh;
    LAS unsigned char* lds = F.lds;
    f32x16 p[5];
#pragma unroll
    for (int j = 0; j < 5; ++j) {
        const int hb = wh + j; const LAS unsigned char* kp = lds + ATT_K + (hb >> 1) * 8192 + hi * 1024 + ((hb & 1) * 32 + r32) * 16;
        f32x16 a = {0.f, 0.f, 0.f, 0.f, 0.f, 0.f, 0.f, 0.f, 0.f, 0.f, 0.f, 0.f, 0.f, 0.f, 0.f, 0.f};
#pragma unroll
        for (int d0 = 0; d0 < 4; ++d0) { const bf16x8 kf = *(const LAS bf16x8*)(kp + d0 * 2048); a = __builtin_amdgcn_mfma_f32_32x32x16_bf16(kf, qr[d0], a, 0, 0, 0); }
        p[j] = a;
    }
    const float NEG = -INFINITY;
#pragma unroll
    for (int j = 0; j < 5; ++j) {
        const bool valid = (qw0 - 128 + 32 * j) >= 0;
#pragma unroll
        for (int r = 0; r < 16; ++r) { bool keep = valid; if (j == 0) keep = keep && (crow(r, hi) > r32); if (j == 4) keep = keep && (crow(r, hi) <= r32); if (!keep) p[j][r] = NEG; }
    }
    const float sinkl2 = (kvh ? sink1 : sink0) * 1.4426950408889634f;
    float mx = sinkl2;
#pragma unroll
    for (int j = 0; j < 5; ++j)
#pragma unroll
        for (int r = 0; r < 16; ++r) mx = fmaxf(mx, p[j][r]);
    { auto rr = __builtin_amdgcn_permlane32_swap(__float_as_uint(mx), __float_as_uint(mx), false, false); mx = fmaxf(__uint_as_float(rr[0]), __uint_as_float(rr[1])); }
    float l = 0.f;
#pragma unroll
    for (int j = 0; j < 5; ++j)
#pragma unroll
        for (int r = 0; r < 16; ++r) { const float e = __builtin_amdgcn_exp2f(p[j][r] - mx); p[j][r] = e; l += e; }
    { auto rr = __builtin_amdgcn_permlane32_swap(__float_as_uint(l), __float_as_uint(l), false, false); l = __uint_as_float(rr[0]) + __uint_as_float(rr[1]); }
    l += __builtin_amdgcn_exp2f(sinkl2 - mx);
    f32x16 o[2];
    o[0] = (f32x16){0.f, 0.f, 0.f, 0.f, 0.f, 0.f, 0.f, 0.f, 0.f, 0.f, 0.f, 0.f, 0.f, 0.f, 0.f, 0.f}; o[1] = o[0];
    const LAS unsigned char* vb = lds + ATT_V + ((lane >> 4) & 1) * 32 + (lane & 3) * 8 + (4 * hi + ((lane & 15) >> 2)) * 64;
#pragma unroll
    for (int j = 0; j < 5; ++j) {
        const int hb = wh + j; const LAS unsigned char* vt = vb + (hb >> 1) * 8192 + (hb & 1) * 2048;
#pragma unroll
        for (int s = 0; s < 2; ++s) {
            v4u pw; pw.x = cvtpk(p[j][8 * s + 0], p[j][8 * s + 1]); pw.y = cvtpk(p[j][8 * s + 2], p[j][8 * s + 3]); pw.z = cvtpk(p[j][8 * s + 4], p[j][8 * s + 5]); pw.w = cvtpk(p[j][8 * s + 6], p[j][8 * s + 7]);
            const bf16x8 pf = __builtin_bit_cast(bf16x8, pw);
#pragma unroll
            for (int d0 = 0; d0 < 2; ++d0) {
                const s16x4 lo = vtr(vt + d0 * 4096 + s * 1024), hh = vtr(vt + d0 * 4096 + s * 1024 + 512);
                const bf16x8 vf = (bf16x8){lo[0], lo[1], lo[2], lo[3], hh[0], hh[1], hh[2], hh[3]};
                o[d0] = __builtin_amdgcn_mfma_f32_32x32x16_bf16(pf, vf, o[d0], 0, 0, 0);
            }
        }
    }
    LAS float* wsf = (LAS float*)(lds + ATT_WS) + wid * 64;
    if (hi == 0) wsf[r32] = l;
    LDS_WAIT(); asm volatile("" ::: "memory");
    float rli[16];
#pragma unroll
    for (int r = 0; r < 16; ++r) rli[r] = __builtin_amdgcn_rcpf(wsf[crow(r, hi)]);
    LAS bf16* stg = (LAS bf16*)(lds + ATT_OST) + wid * 2048;
#pragma unroll
    for (int r = 0; r < 16; ++r) { const int orow = crow(r, hi);
#pragma unroll
        for (int d0 = 0; d0 < 2; ++d0) stg[orow * 64 + d0 * 32 + r32] = (bf16)f2bf(o[d0][r] * rli[r]); }
    LDS_WAIT(); asm volatile("" ::: "memory");
    bf16* Ow = P.MIX + (rowbase + qw0) * D + hq * 64;
#pragma unroll
    for (int i = 0; i < 4; ++i) { const int row = i * 8 + (lane >> 3), ch = lane & 7; const v4u v = *(const LAS v4u*)(stg + row * 64 + ch * 8); *(GAS v4u*)(Ow + (size_t)row * D + ch * 8) = v; }
}
__device__ __forceinline__ void unpack8(const v4u w, float (&f)[8]) { f[0] = bflo(w.x); f[1] = bfhi(w.x); f[2] = bflo(w.y); f[3] = bfhi(w.y); f[4] = bflo(w.z); f[5] = bfhi(w.z); f[6] = bflo(w.w); f[7] = bfhi(w.w); }
template <int W> __device__ __forceinline__ void pool_task_w(Frame& F, const Ptrs& P, int g, int rb) {
    const int ch = F.lane & 15, run = F.lane >> 4;
    const int t0 = (rb * 64 + run * 16) & (SEQ - 1);
    const GAS char* ub = (const GAS char*)(P.U + (size_t)(rb * 64) * PW + g * 128);
    GAS char* ob = (GAS char*)(P.MIX + (size_t)(rb * 64) * D + AW + g * 128);
    const unsigned loff = (unsigned)((run * 16 * PW + ch * 8) * 2), ooff = (unsigned)((run * 16 * D + ch * 8) * 2);
    v4u cur[16], prev[W];
#pragma unroll
    for (int i = 0; i < 16; ++i) cur[i] = *(const GAS v4u*)(ub + (size_t)i * (PW * 2) + loff);
#pragma unroll
    for (int j = 1; j <= W; ++j) { const bool ok = (t0 - j) >= 0; const v4u t = *(const GAS v4u*)(ub + loff - (ok ? (size_t)j * (PW * 2) : (size_t)0)); const unsigned mk = ok ? 0xffffffffu : 0u; prev[j - 1] = (v4u){t.x & mk, t.y & mk, t.z & mk, t.w & mk}; }
    float S[8];
#pragma unroll
    for (int e = 0; e < 8; ++e) S[e] = 0.f;
#pragma unroll
    for (int j = 1; j <= W; ++j) { float f[8]; unpack8(prev[j - 1], f);
#pragma unroll
        for (int e = 0; e < 8; ++e) S[e] += f[e]; }
#pragma unroll
    for (int i = 0; i < 16; ++i) {
        const int t = t0 + i; float u[8]; unpack8(cur[i], u);
        float f[8]; unpack8(i < W ? prev[(W - 1 - i) >= 0 ? (W - 1 - i) : 0] : cur[(i - W) >= 0 ? (i - W) : 0], f);
#pragma unroll
        for (int e = 0; e < 8; ++e) S[e] += u[e] - f[e];
        const float inv = 1.0f / (float)((t + 1) < W ? (t + 1) : W);
        v4u o; o.x = pk2(S[0] * inv - u[0], S[1] * inv - u[1]); o.y = pk2(S[2] * inv - u[2], S[3] * inv - u[3]); o.z = pk2(S[4] * inv - u[4], S[5] * inv - u[5]); o.w = pk2(S[6] * inv - u[6], S[7] * inv - u[7]);
        *(GAS v4u*)(ob + (size_t)i * (D * 2) + ooff) = o;
    }
}
__device__ __forceinline__ void pool_task(Frame& F, const Ptrs& P, int task) {
    const int g = task & 3, rb = task >> 2;
    if (g == 0) pool_task_w<2>(F, P, 0, rb); else if (g == 1) pool_task_w<4>(F, P, 1, rb); else if (g == 2) pool_task_w<8>(F, P, 2, rb); else pool_task_w<16>(F, P, 3, rb);
}
__device__ __forceinline__ void p2_attn_pool(Frame& F, const Ptrs& P) {
    constexpr int NUNITS = BATCH * NKV * (SEQ / 64);
    const int upw = (NUNITS + F.G - 1) / F.G, first = F.vcu * upw;
    int n = NUNITS - first; n = n < 0 ? 0 : (n > upw ? upw : n);
    const int gw = F.vcu * NWAVES + F.wave, NGW = F.G * NWAVES;
    const float sink0 = P.sinks[F.wave >> 1], sink1 = P.sinks[4 + (F.wave >> 1)];
    AttnRegs R;
    if (n > 0) attn_load(F, P, first, R);
    for (int i = 0; i < n; ++i) {
        bf16x8 qr[4];
#pragma unroll
        for (int d0 = 0; d0 < 4; ++d0) qr[d0] = R.q[d0];
#pragma unroll
        for (int t = 0; t < 3; ++t) { *(LAS v4u*)(F.lds + ATT_K + t * 8192 + F.wave * 1024 + F.lane * 16) = R.k[t]; *(LAS v4u*)(F.lds + ATT_V + t * 8192 + F.wave * 1024 + F.lane * 16) = R.v[t]; }
        __syncthreads();
        if (i + 1 < n) attn_load(F, P, first + i + 1, R);
        attn_compute(F, P, first + i, qr, sink0, sink1);
        __syncthreads();
    }
    for (int t = gw; t < 4 * (M / 64); t += NGW) pool_task(F, P, t);
}

struct Args { const void* in[16]; float* out; unsigned char* ws; int ph_lo, ph_hi; };
__global__ void __launch_bounds__(NWAVES * 64, 2) fwd_megakernel(Args args) {
    extern __shared__ __attribute__((aligned(16))) unsigned char lds[];
    asm volatile("s_nop 0");
    asm volatile("s_nop 0");
    asm volatile("s_nop 0");
    asm volatile("s_nop 0");
    asm volatile("s_nop 0");
    asm volatile("s_nop 0");
    asm volatile("s_nop 0");
    asm volatile("s_nop 0");
    Frame F;
    F.lds = (LAS unsigned char*)lds;
    F.tid = threadIdx.x; F.lane = F.tid & 63; F.wave = __builtin_amdgcn_readfirstlane(F.tid >> 6);
    F.G = gridDim.x; { const int bx = blockIdx.x; F.vcu = (F.G % 8 == 0) ? (bx % 8) * (F.G / 8) + bx / 8 : bx; }
    unsigned char* ws = args.ws;
    Ptrs P;
    P.x = (const float*)args.in[0]; P.c = (const float*)args.in[1]; P.positions = (const int*)args.in[2]; P.w_ada = (const float*)args.in[3]; P.b_ada = (const float*)args.in[4];
    P.norm1_g = (const float*)args.in[5]; P.w_in = (const float*)args.in[6]; P.q_norm_g = (const float*)args.in[7]; P.k_norm_g = (const float*)args.in[8]; P.sinks = (const float*)args.in[9];
    P.pool_w = (const float*)args.in[10]; P.pool_scale = (const float*)args.in[11]; P.w_o = (const float*)args.in[12]; P.norm2_g = (const float*)args.in[13]; P.w1 = (const float*)args.in[14]; P.w2 = (const float*)args.in[15];
    P.out = args.out; P.mod = (float*)(ws + WS_MOD); P.bias2 = (float*)(ws + WS_BIAS2); P.a2 = (float*)(ws + WS_A2); P.rope = (float*)(ws + WS_ROPE); P.stats = (float*)(ws + WS_STATS);
    P.Win_t = (bf16*)(ws + WS_WIN); P.Wo_t = (bf16*)(ws + WS_WO); P.W1_t = (bf16*)(ws + WS_W1); P.W2_t = (bf16*)(ws + WS_W2);
    P.XN = (bf16*)(ws + WS_XN); P.Q = (bf16*)(ws + WS_Q); P.K = (bf16*)(ws + WS_K); P.V = (bf16*)(ws + WS_V); P.U = (bf16*)(ws + WS_U); P.MIX = (bf16*)(ws + WS_MIX); P.XB1 = (bf16*)(ws + WS_XB1); P.Z2 = (bf16*)(ws + WS_Z2); P.H = (bf16*)(ws + WS_H);
    volatile LAS unsigned* MISC = (volatile LAS unsigned*)(F.lds + MISC_OFF);
    if (F.tid < 64) MISC[F.tid] = 0u;
    __syncthreads();
    XcdBarrier bar; bar.bar = (unsigned*)(ws + WS_CTL) + CW_BAR; bar.x = 0; bar.st = nullptr;
    if (N_LAUNCHES == 1) bar = xcd_barrier_post((unsigned*)(ws + WS_CTL) + CW_BAR, MISC + 8);
    const int lo = args.ph_lo, hi = args.ph_hi;
#define IN(k) (lo <= (k) && (k) < hi)
#define SEAM(k) do { if (IN(k) && IN((k) + 1)) xcd_barrier(bar); } while (0)

    if (IN(0)) { p0a_prologue(F, P); SEAM(0); }
    if (IN(1)) { p0b_norm(F, P); SEAM(1); }
    if (IN(2)) {
        pg8::Gemm g{P.XN, P.Win_t, M, INW, D}; pg8::StaticOrder S; S.init(M, INW, F.G, (int)blockIdx.x);
        pg8::EpiProj E{P.Q, P.K, P.V, P.U, P.rope, P.q_norm_g, P.k_norm_g};
        pg8::gemm_phase<pg8::EpiProj, pg8::StaticOrder, true, true>(F.lds, g, S, E);
        { const int nwg = (M / 256) * (INW / 256), rem = nwg % F.G;
          if (rem == 0) p1_tail_work(F, P, (int)blockIdx.x, F.G); else if ((int)blockIdx.x >= rem) p1_tail_work(F, P, (int)blockIdx.x - rem, F.G - rem); }
        SEAM(2);
    }
    if (IN(3)) { p2_attn_pool(F, P); SEAM(3); }
    if (IN(4)) {
        pg8::Gemm g{P.MIX, P.Wo_t, M, D, D}; pg8::StaticOrder S; S.init(M, D, F.G, (int)blockIdx.x);
        pg8::EpiWo E{P.x, P.XB1, P.mod, P.stats, P.Z2, P.a2};
        pg8::gemm_phase<pg8::EpiWo, pg8::StaticOrder, true, true>(F.lds, g, S, E);
        SEAM(4);
    }
    if (IN(5)) {
        pg8::Gemm g{P.Z2, P.W1_t, M, FF, D}; pg8::StaticOrder S; S.init(M, FF, F.G, (int)blockIdx.x);
        pg8::EpiUp E{P.H, P.stats, P.bias2, FF};
        pg8::gemm_phase<pg8::EpiUp, pg8::StaticOrder, true, true>(F.lds, g, S, E);
        SEAM(5);
    }
    if (IN(6)) {
        pg8::Gemm g{P.H, P.W2_t, M, D, FF}; pg8::StaticOrder S; S.init(M, D, F.G, (int)blockIdx.x, pg8::WGM, 1);
        pg8::EpiDown E{P.out, P.XB1, P.mod};
        pg8::gemm_phase<pg8::EpiDown, pg8::StaticOrder, true, true>(F.lds, g, S, E);
    }
#undef IN
#undef SEAM
}

extern "C" void kernel_launch(void* const* d_in, const int* in_sizes, int n_in, void* d_out, int out_size, void* d_ws, size_t ws_size, hipStream_t stream) {
    static int grid = 0;
    if (grid == 0) {
        if (n_in != 16 || out_size != M * D || ws_size < WS_END) { fprintf(stderr, "kernel_launch: unexpected shapes (n_in %d out %d ws %zu)\n", n_in, out_size, ws_size); grid = -1; return; }
        int dev = 0, cus = 0, per_cu = 0;
        if (hipGetDevice(&dev) != hipSuccess || hipDeviceGetAttribute(&cus, hipDeviceAttributeMultiprocessorCount, dev) != hipSuccess) { grid = -1; return; }
        if (hipFuncSetAttribute((const void*)fwd_megakernel, hipFuncAttributeMaxDynamicSharedMemorySize, LDS_BYTES) != hipSuccess) { fprintf(stderr, "kernel_launch: hipFuncSetAttribute failed\n"); grid = -1; return; }
        if (hipOccupancyMaxActiveBlocksPerMultiprocessor(&per_cu, (const void*)fwd_megakernel, NWAVES * 64, LDS_BYTES) != hipSuccess || per_cu < 1) { fprintf(stderr, "kernel_launch: occupancy query says %d\n", per_cu); per_cu = 1; }
        (void)hipGetLastError();
        if (per_cu > 1) per_cu = 1;
        grid = cus * per_cu;
    }
    if (grid < 0) return;
    (void)hipMemsetAsync((char*)d_ws + WS_CTL, 0, CTL_ZERO_BYTES, stream);
    Args a{};
    for (int i = 0; i < 16; ++i) a.in[i] = d_in[i];
    a.out = (float*)d_out; a.ws = (unsigned char*)d_ws;
    if (N_LAUNCHES == 1) { a.ph_lo = 0; a.ph_hi = N_PHASES; hipLaunchKernelGGL(fwd_megakernel, dim3(grid), dim3(NWAVES * 64), LDS_BYTES, stream, a); }
    else for (int li = 0; li < N_PHASES; ++li) { a.ph_lo = li; a.ph_hi = li + 1; hipLaunchKernelGGL(fwd_megakernel, dim3(grid), dim3(NWAVES * 64), LDS_BYTES, stream, a); }
}
```

```cpp
#include <hip/hip_runtime.h>
#include <cstdio>
#include <cstdint>
#include <cmath>
namespace pg8 {
#define PG8_LAS __attribute__((address_space(3)))
typedef unsigned short bf16_t;
typedef short bf16x8 __attribute__((ext_vector_type(8)));
typedef float f32x4 __attribute__((ext_vector_type(4)));
typedef unsigned u32x4 __attribute__((ext_vector_type(4)));
constexpr int BM = 256, BK = 64, HALF = 128, HTB = HALF * BK * 2  , STAGE_BYTES = 8 * HTB, NXCD = 8, WGM = 8;

__host__ __device__ __forceinline__ int lds_byte(int r, int c) { const int st = (r >> 4) * 2 + (c >> 5), rr = r & 15, cc = c & 31, ob = rr * 64 + cc * 2; return st * 1024 + (ob ^ (((ob >> 9) & 1) << 5)); }
__host__ __device__ __forceinline__ void stage_rc(int b, int& R, int& C) { const int st = b / 1024, sb = b % 1024, swz = sb ^ (((sb >> 9) & 1) << 5); R = (st >> 1) * 16 + swz / 64; C = (st & 1) * 32 + (swz % 64) / 2; }
__host__ __device__ __forceinline__ int perm32(int rho) { const int n = rho >> 4, i = rho & 15; return 8 * (i >> 2) + 4 * n + (i & 3); }

struct Unit { int pm, pn; };
struct Gemm { const bf16_t* A; const bf16_t* Bt; int M, N, K; };

struct StaticOrder {
    int nM, nN, nwg, G, c, wgm, rev;
    __host__ __device__ void init(int M, int N, int G_, int c_, int wgm_ = WGM, int rev_ = 0) { nM = M / BM; nN = N / BM; nwg = nM * nN; G = G_; c = c_; wgm = wgm_; rev = (rev_ && nwg % G_ == 0) ? 1 : 0; }
    __host__ __device__ bool next(int i, Unit& u) const {
        if ((long)i * G + c >= nwg) return false;
        const long L = (long)(rev ? (nwg / G - 1 - i) : i) * G + c;
        int wgid = (int)L; { const int q = nwg / NXCD, r = nwg % NXCD, xcd = wgid % NXCD, off = wgid / NXCD; wgid = (xcd < r ? xcd * (q + 1) : r * (q + 1) + (xcd - r) * q) + off; }
        const int nig = wgm * nN, gid = wgid / nig, fm = gid * wgm, gsz = (nM - fm) < wgm ? (nM - fm) : wgm;
        u.pm = fm + ((wgid % nig) % gsz); u.pn = (wgid % nig) / gsz; return true;
    }
    __device__ __forceinline__ void a_ready(const Unit&) const {}
    __device__ __forceinline__ void done(const Unit&) const {}
};

__device__ __forceinline__ unsigned cvt_pk_bf16(float lo, float hi) { unsigned r; asm volatile("v_cvt_pk_bf16_f32 %0, %1, %2" : "=v"(r) : "v"(lo), "v"(hi)); return r; }
typedef float f32x2 __attribute__((ext_vector_type(2)));
constexpr int SEQ_ = 4096, DM_ = 1024, NMOD_ = 6;
constexpr float EPS_ = 1e-6f;
constexpr float QSCALE = 0.125f * 1.4426950408889634f;

__device__ __forceinline__ u32x4 pack8(const f32x4 a, const f32x4 b) { u32x4 w; w.x = cvt_pk_bf16(a[0], a[1]); w.y = cvt_pk_bf16(a[2], a[3]); w.z = cvt_pk_bf16(b[0], b[1]); w.w = cvt_pk_bf16(b[2], b[3]); return w; }

struct EpiProj {
    static constexpr bool PERM = true, AFTER_DRAIN = false;
    bf16_t *Q, *Kb, *V, *U; const float* rope; const float* qg; const float* kg;
    __device__ __forceinline__ void operator()(const f32x4 (&acc)[2][2][4][2], const Unit& u, int wr, int wc, int fr, int fq) const {
        const int row0 = u.pm * BM + wr * 64 + fr;
        if (u.pn >= 3 || (u.pn == 2 && wc >= 2)) {
            bf16_t* base; int pitch;
            if (u.pn >= 3) { base = U + (u.pn - 3) * 256 + wc * 64 + 8 * fq; pitch = 512; } else { base = V + (wc - 2) * 64 + 8 * fq; pitch = 128; }
#pragma unroll
            for (int ai = 0; ai < 2; ++ai)
#pragma unroll
                for (int m = 0; m < 4; ++m) { bf16_t* rowp = base + (size_t)(row0 + ai * HALF + m * 16) * pitch;
#pragma unroll
                    for (int bj = 0; bj < 2; ++bj) *(u32x4*)(rowp + bj * 32) = pack8(acc[ai][bj][m][0], acc[ai][bj][m][1]); }
        } else {
            const bool isq = u.pn < 2; const float* g = isq ? qg : kg; const float sc = isq ? QSCALE : 1.0f;
            bf16_t* base = isq ? Q + (4 * u.pn + wc) * 64 + 8 * fq : Kb + wc * 64 + 8 * fq; const int pitch = isq ? 512 : 128;
            f32x4 gv[2][2];
#pragma unroll
            for (int bj = 0; bj < 2; ++bj)
#pragma unroll
                for (int n = 0; n < 2; ++n) gv[bj][n] = *(const f32x4*)(g + 32 * bj + 8 * fq + 4 * n);
#pragma unroll
            for (int ai = 0; ai < 2; ++ai)
#pragma unroll
                for (int m = 0; m < 4; ++m) {
                    const int row = row0 + ai * HALF + m * 16;
                    f32x4 cs[2], sn[2];
#pragma unroll
                    for (int n = 0; n < 2; ++n) { cs[n] = *(const f32x4*)(rope + (size_t)row * 16 + 4 * n); sn[n] = *(const f32x4*)(rope + (size_t)row * 16 + 8 + 4 * n); }
                    float ss = 0.f;
#pragma unroll
                    for (int bj = 0; bj < 2; ++bj)
#pragma unroll
                        for (int n = 0; n < 2; ++n) { const f32x4 v = acc[ai][bj][m][n]; ss += (v[0] * v[0] + v[1] * v[1]) + (v[2] * v[2] + v[3] * v[3]); }
                    ss += __shfl_xor(ss, 16); ss += __shfl_xor(ss, 32);
                    const float r = rsqrtf(ss * (1.0f / 64.0f) + EPS_);
                    f32x4 y[2][2];
#pragma unroll
                    for (int bj = 0; bj < 2; ++bj)
#pragma unroll
                        for (int n = 0; n < 2; ++n) y[bj][n] = acc[ai][bj][m][n] * r * gv[bj][n];
#pragma unroll
                    for (int n = 0; n < 2; ++n)
#pragma unroll
                        for (int e = 0; e < 4; ++e) { const float mine = y[0][n][e]; const float other = __shfl_xor(mine, 16);
                            const float ro = (fq == 0) ? mine * cs[n][e] - other * sn[n][e] : mine * cs[n][e] + other * sn[n][e];
                            y[0][n][e] = (fq < 2) ? ro : mine; }
                    bf16_t* rowp = base + (size_t)row * pitch;
#pragma unroll
                    for (int bj = 0; bj < 2; ++bj) *(u32x4*)(rowp + bj * 32) = pack8(y[bj][0] * sc, y[bj][1] * sc);
                }
        }
    }
};

struct EpiWo {
    static constexpr bool PERM = true, AFTER_DRAIN = false;
    const float* x; bf16_t* xb1; const float* mod; float* stats; bf16_t* z; const float* a2;
    __device__ __forceinline__ void operator()(const f32x4 (&acc)[2][2][4][2], const Unit& u, int wr, int wc, int fr, int fq) const {
        const int b = (u.pm * BM) / SEQ_; const int col0 = u.pn * BM + wc * 32 + 8 * fq; const int row0 = u.pm * BM + wr * 64 + fr;
        f32x4 gv[2][2], av[2][2];
#pragma unroll
        for (int bj = 0; bj < 2; ++bj)
#pragma unroll
            for (int n = 0; n < 2; ++n) { gv[bj][n] = *(const f32x4*)(mod + (size_t)b * NMOD_ * DM_ + 2 * DM_ + col0 + bj * HALF + 4 * n); av[bj][n] = *(const f32x4*)(a2 + (size_t)b * DM_ + col0 + bj * HALF + 4 * n); }
#pragma unroll
        for (int ai = 0; ai < 2; ++ai)
#pragma unroll
            for (int m = 0; m < 4; ++m) {
                const int row = row0 + ai * HALF + m * 16; const size_t off = (size_t)row * DM_ + col0; float ss = 0.f;
#pragma unroll
                for (int bj = 0; bj < 2; ++bj) {
                    const f32x4 xa = __builtin_nontemporal_load((const f32x4*)(x + off + bj * HALF)), xb = __builtin_nontemporal_load((const f32x4*)(x + off + bj * HALF + 4));
                    const f32x4 v0 = xa + gv[bj][0] * acc[ai][bj][m][0], v1 = xb + gv[bj][1] * acc[ai][bj][m][1];
                    ss += (v0[0] * v0[0] + v0[1] * v0[1]) + (v0[2] * v0[2] + v0[3] * v0[3]) + (v1[0] * v1[0] + v1[1] * v1[1]) + (v1[2] * v1[2] + v1[3] * v1[3]);
                    *(u32x4*)(xb1 + off + bj * HALF) = pack8(v0, v1);
                    *(u32x4*)(z + off + bj * HALF) = pack8(v0 * av[bj][0], v1 * av[bj][1]);
                }
                ss += __shfl_xor(ss, 16); ss += __shfl_xor(ss, 32);
                if (fq == 0) stats[(size_t)row * 16 + u.pn * 4 + wc] = ss;
            }
    }
};

struct EpiUp {
    static constexpr bool PERM = true, AFTER_DRAIN = false;
    bf16_t* H; const float* stats; const float* bias2; int ldc;
    __device__ __forceinline__ void operator()(const f32x4 (&acc)[2][2][4][2], const Unit& u, int wr, int wc, int fr, int fq) const {
        const int b = (u.pm * BM) / SEQ_; const int col0 = u.pn * BM + wc * 32 + 8 * fq; const int row0 = u.pm * BM + wr * 64 + fr;
        f32x4 bv[2][2];
#pragma unroll
        for (int bj = 0; bj < 2; ++bj)
#pragma unroll
            for (int n = 0; n < 2; ++n) bv[bj][n] = *(const f32x4*)(bias2 + (size_t)b * ldc + col0 + bj * HALF + 4 * n);
#pragma unroll
        for (int ai = 0; ai < 2; ++ai)
#pragma unroll
            for (int m = 0; m < 4; ++m) {
                const int row = row0 + ai * HALF + m * 16;
                const f32x4 st = *(const f32x4*)(stats + (size_t)row * 16 + 4 * fq);
                float s = (st[0] + st[1]) + (st[2] + st[3]); s += __shfl_xor(s, 16); s += __shfl_xor(s, 32);
                const float r = rsqrtf(s * (1.0f / DM_) + EPS_);
                bf16_t* rowp = H + (size_t)row * ldc + col0;
#pragma unroll
                for (int bj = 0; bj < 2; ++bj) {
                    f32x4 v0 = acc[ai][bj][m][0] * r + bv[bj][0], v1 = acc[ai][bj][m][1] * r + bv[bj][1];
#pragma unroll
                    for (int e = 0; e < 4; ++e) { const float t0 = fmaxf(v0[e], 0.f), t1 = fmaxf(v1[e], 0.f); v0[e] = t0 * t0; v1[e] = t1 * t1; }
                    *(u32x4*)(rowp + bj * HALF) = pack8(v0, v1);
                }
            }
    }
};

struct EpiDown {
    static constexpr bool PERM = true, AFTER_DRAIN = false;
    float* out; const bf16_t* xb1; const float* mod;
    __device__ __forceinline__ void operator()(const f32x4 (&acc)[2][2][4][2], const Unit& u, int wr, int wc, int fr, int fq) const {
        const int b = (u.pm * BM) / SEQ_; const int col0 = u.pn * BM + wc * 32 + 8 * fq; const int row0 = u.pm * BM + wr * 64 + fr;
        f32x4 gv[2][2];
#pragma unroll
        for (int bj = 0; bj < 2; ++bj)
#pragma unroll
            for (int n = 0; n < 2; ++n) gv[bj][n] = *(const f32x4*)(mod + (size_t)b * NMOD_ * DM_ + 5 * DM_ + col0 + bj * HALF + 4 * n);
#pragma unroll
        for (int ai = 0; ai < 2; ++ai)
#pragma unroll
            for (int m = 0; m < 4; ++m) {
                const size_t off = (size_t)(row0 + ai * HALF + m * 16) * DM_ + col0;
#pragma unroll
                for (int bj = 0; bj < 2; ++bj) {
                    const u32x4 w = *(const u32x4*)(xb1 + off + bj * HALF);
                    const f32x4 xa = (f32x4){__builtin_bit_cast(float, w.x << 16), __builtin_bit_cast(float, w.x & 0xffff0000u), __builtin_bit_cast(float, w.y << 16), __builtin_bit_cast(float, w.y & 0xffff0000u)};
                    const f32x4 xb = (f32x4){__builtin_bit_cast(float, w.z << 16), __builtin_bit_cast(float, w.z & 0xffff0000u), __builtin_bit_cast(float, w.w << 16), __builtin_bit_cast(float, w.w & 0xffff0000u)};
                    *(f32x4*)(out + off + bj * HALF) = xa + gv[bj][0] * acc[ai][bj][m][0]; *(f32x4*)(out + off + bj * HALF + 4) = xb + gv[bj][1] * acc[ai][bj][m][1];
                }
            }
    }
};

template <class Epi, class Sched, bool ALIGN_EPI = false, bool SP2 = false>
__device__ __forceinline__ void gemm_phase(PG8_LAS unsigned char* lds, const Gemm g, const Sched& S, const Epi& E) {
    const int tid = threadIdx.x, wid = __builtin_amdgcn_readfirstlane(tid >> 6), lane = tid & 63, wr = wid >> 2, wc = wid & 3, fr = lane & 15, fq = lane >> 4;
    const int K = g.K, nt = K / BK;
    unsigned voffA[2], voffB[2];
#pragma unroll
    for (int i = 0; i < 2; ++i) { int R, C; stage_rc(tid * 16 + i * 8192, R, C); const int Rb = Epi::PERM ? ((R & ~31) + perm32(R & 31)) : R;
        voffA[i] = (unsigned)(R * K + C) * 2u; voffB[i] = (unsigned)(Rb * K + C) * 2u; }
    const size_t kstep = (size_t)(BK * 2);
    const size_t hstep = (size_t)HALF * K * 2;
    const size_t tstep = 2 * hstep;
    const unsigned ldsw = (unsigned)wid * 1024u;
    const int aoff = lds_byte(wr * 64 + fr, fq * 8), boff = lds_byte(wc * 32 + fr, fq * 8);
#define PG8_SA(b, h) (((b) * 2 + (h)) * HTB)
#define PG8_SB(b, h) ((4 + (b) * 2 + (h)) * HTB)
#define PG8_STAGE(bufoff, gbase, voff) do { _Pragma("unroll") for (int _i = 0; _i < 2; ++_i) \
        __builtin_amdgcn_global_load_lds((const unsigned*)((const char*)(gbase) + (voff)[_i]), (PG8_LAS unsigned*)(lds + (bufoff) + ldsw + _i * 8192), 16, 0, 0); } while (0)
#define PG8_LDA(dst, b, h) do { _Pragma("unroll") for (int m = 0; m < 4; ++m) _Pragma("unroll") for (int k = 0; k < 2; ++k) dst[m][k] = *(const PG8_LAS bf16x8*)(lds + PG8_SA(b, h) + aoff + m * 2048 + k * 1024); } while (0)
#define PG8_LDB(dst, b, h) do { _Pragma("unroll") for (int n = 0; n < 2; ++n) _Pragma("unroll") for (int k = 0; k < 2; ++k) dst[n][k] = *(const PG8_LAS bf16x8*)(lds + PG8_SB(b, h) + boff + n * 2048 + k * 1024); } while (0)
#define PG8_MMA(ai, bj, At, Bt) do { __builtin_amdgcn_s_setprio(1); _Pragma("unroll") for (int m = 0; m < 4; ++m) _Pragma("unroll") for (int n = 0; n < 2; ++n) _Pragma("unroll") for (int k = 0; k < 2; ++k) \
        acc[ai][bj][m][n] = __builtin_amdgcn_mfma_f32_16x16x32_bf16(Bt[n][k], At[m][k], acc[ai][bj][m][n], 0, 0, 0); __builtin_amdgcn_s_setprio(0); } while (0)
#define PG8_WAIT_V(n) asm volatile("s_waitcnt vmcnt(" #n ")" ::: "memory")
#define PG8_WAIT_L(n) asm volatile("s_waitcnt lgkmcnt(" #n ")" ::: "memory")
#define PG8_BAR __builtin_amdgcn_s_barrier()
#define PG8_SCHED __builtin_amdgcn_sched_barrier(0)
    Unit cur, nxt; int ui = 0;
    if (!S.next(0, cur)) return;
    f32x4 acc[2][2][4][2];
#pragma unroll
    for (int a = 0; a < 2; ++a)
#pragma unroll
        for (int b = 0; b < 2; ++b)
#pragma unroll
            for (int m = 0; m < 4; ++m)
#pragma unroll
                for (int n = 0; n < 2; ++n) acc[a][b][m][n] = (f32x4){0.f, 0.f, 0.f, 0.f};
    bf16x8 At[4][2], B0[2][2], B1[2][2];
    const char* cA = (const char*)g.A + (size_t)cur.pm * tstep; const char* cB = (const char*)g.Bt + (size_t)cur.pn * tstep;
    S.a_ready(cur);
    if constexpr (SP2) {
        PG8_STAGE(PG8_SB(0, 0), cB, voffB); PG8_STAGE(PG8_SB(0, 1), cB + hstep, voffB); PG8_STAGE(PG8_SA(0, 0), cA, voffA); PG8_STAGE(PG8_SA(0, 1), cA + hstep, voffA);
        if (wr == 1) PG8_BAR;
        PG8_WAIT_V(2); PG8_BAR;
        PG8_STAGE(PG8_SB(1, 0), cB + kstep, voffB); PG8_STAGE(PG8_SA(1, 0), cA + kstep, voffA); PG8_STAGE(PG8_SB(1, 1), cB + hstep + kstep, voffB);
        PG8_WAIT_V(6); PG8_BAR;
    } else {
        PG8_STAGE(PG8_SB(0, 0), cB, voffB); PG8_STAGE(PG8_SA(0, 0), cA, voffA); PG8_STAGE(PG8_SB(0, 1), cB + hstep, voffB); PG8_STAGE(PG8_SA(0, 1), cA + hstep, voffA);
        if (wr == 1) PG8_BAR;
        PG8_WAIT_V(4); PG8_BAR;
        PG8_STAGE(PG8_SB(1, 0), cB + kstep, voffB); PG8_STAGE(PG8_SA(1, 0), cA + kstep, voffA); PG8_STAGE(PG8_SB(1, 1), cB + hstep + kstep, voffB);
        PG8_WAIT_V(6); PG8_BAR;
    }
    for (;;) {
        const bool has_next = S.next(ui + 1, nxt);
        const char* nA = has_next ? (const char*)g.A + (size_t)nxt.pm * tstep : cA; const char* nB = has_next ? (const char*)g.Bt + (size_t)nxt.pn * tstep : cB;
        for (int t = 0; t < nt; t += 2) {
            const bool last = (t == nt - 2);
            const char* a1 = cA + (size_t)(t + 1) * kstep;
            const char* a2 = last ? nA : cA + (size_t)(t + 2) * kstep; const char* b2 = last ? nB : cB + (size_t)(t + 2) * kstep;
            const char* a3 = a2 + kstep; const char* b3 = b2 + kstep;
            if (last && has_next) S.a_ready(nxt);
            if constexpr (SP2) {
            PG8_LDB(B0, 0, 0); PG8_LDB(B1, 0, 1); PG8_SCHED; PG8_LDA(At, 0, 0); PG8_STAGE(PG8_SA(1, 1), a1 + hstep, voffA);
            PG8_WAIT_V(8); PG8_WAIT_L(0); PG8_BAR; PG8_MMA(0, 0, At, B0); PG8_MMA(0, 1, At, B1); PG8_BAR; PG8_SCHED;
            PG8_LDA(At, 0, 1); PG8_STAGE(PG8_SB(0, 0), b2, voffB); PG8_STAGE(PG8_SB(0, 1), b2 + hstep, voffB); PG8_STAGE(PG8_SA(0, 0), a2, voffA);
            PG8_WAIT_V(8); PG8_WAIT_L(0); PG8_BAR; PG8_MMA(1, 0, At, B0); PG8_MMA(1, 1, At, B1); PG8_BAR; PG8_SCHED;
            PG8_LDB(B0, 1, 0); PG8_LDB(B1, 1, 1); PG8_SCHED; PG8_LDA(At, 1, 0); PG8_STAGE(PG8_SA(0, 1), a2 + hstep, voffA);
            PG8_WAIT_V(8); PG8_WAIT_L(0); PG8_BAR; PG8_MMA(0, 0, At, B0); PG8_MMA(0, 1, At, B1); PG8_BAR; PG8_SCHED;
            PG8_LDA(At, 1, 1); PG8_STAGE(PG8_SB(1, 0), b3, voffB); PG8_STAGE(PG8_SB(1, 1), b3 + hstep, voffB); PG8_STAGE(PG8_SA(1, 0), a3, voffA);
            PG8_WAIT_V(8); PG8_WAIT_L(0); PG8_BAR; PG8_MMA(1, 0, At, B0); PG8_MMA(1, 1, At, B1); PG8_BAR; PG8_SCHED;
            } else {
            PG8_LDB(B0, 0, 0); PG8_SCHED; PG8_LDA(At, 0, 0); PG8_STAGE(PG8_SA(1, 1), a1 + hstep, voffA);
            PG8_WAIT_L(8); PG8_BAR; PG8_WAIT_L(0); PG8_MMA(0, 0, At, B0); PG8_BAR; PG8_SCHED;
            PG8_LDB(B1, 0, 1); PG8_STAGE(PG8_SB(0, 0), b2, voffB);
            PG8_BAR; PG8_WAIT_L(0); PG8_MMA(0, 1, At, B1); PG8_BAR;
            PG8_LDA(At, 0, 1); PG8_STAGE(PG8_SA(0, 0), a2, voffA);
            PG8_BAR; PG8_WAIT_L(0); PG8_MMA(1, 0, At, B0); PG8_BAR; PG8_SCHED;
            PG8_STAGE(PG8_SB(0, 1), b2 + hstep, voffB);
            PG8_WAIT_V(6); PG8_BAR; PG8_MMA(1, 1, At, B1); PG8_BAR;
            PG8_LDB(B0, 1, 0); PG8_SCHED; PG8_LDA(At, 1, 0); PG8_STAGE(PG8_SA(0, 1), a2 + hstep, voffA);
            PG8_WAIT_L(8); PG8_BAR; PG8_WAIT_L(0); PG8_MMA(0, 0, At, B0); PG8_BAR; PG8_SCHED;
            PG8_LDB(B1, 1, 1); PG8_STAGE(PG8_SB(1, 0), b3, voffB);
            PG8_BAR; PG8_WAIT_L(0); PG8_MMA(0, 1, At, B1); PG8_BAR;
            PG8_LDA(At, 1, 1); PG8_STAGE(PG8_SA(1, 0), a3, voffA);
            PG8_BAR; PG8_WAIT_L(0); PG8_MMA(1, 0, At, B0); PG8_BAR; PG8_SCHED;
            PG8_STAGE(PG8_SB(1, 1), b3 + hstep, voffB);
            PG8_WAIT_V(6); PG8_BAR; PG8_MMA(1, 1, At, B1); PG8_BAR;
            }
        }
        if constexpr (ALIGN_EPI) { if (wr == 0) PG8_BAR; }
        if constexpr (!Epi::AFTER_DRAIN) { E(acc, cur, wr, wc, fr, fq); S.done(cur); }
        if (!has_next) break;
#pragma unroll
        for (int a = 0; a < 2; ++a)
#pragma unroll
            for (int b = 0; b < 2; ++b)
#pragma unroll
                for (int m = 0; m < 4; ++m)
#pragma unroll
                    for (int n = 0; n < 2; ++n) acc[a][b][m][n] = (f32x4){0.f, 0.f, 0.f, 0.f};
        cur = nxt; cA = nA; cB = nB; ++ui;
        if constexpr (ALIGN_EPI) { if (wr == 1) PG8_BAR; }
    }
    PG8_WAIT_V(0);
    if constexpr (!ALIGN_EPI) { if (wr == 0) PG8_BAR; }
    PG8_BAR;
    if constexpr (Epi::AFTER_DRAIN) { E.fused(acc, cur, wr, wc, fr, fq, lds, wid, lane); S.done(cur); }
#undef PG8_SA
#undef PG8_SB
#undef PG8_STAGE
#undef PG8_LDA
#undef PG8_LDB
#undef PG8_MMA
#undef PG8_WAIT_V
#undef PG8_WAIT_L
#undef PG8_BAR
#undef PG8_SCHED
}
}

constexpr int NWAVES = 8;
constexpr int BATCH = 8, SEQ = 4096, D = 1024, M = BATCH * SEQ;
constexpr int NH = 8, NKV = 2, HD = 64, AW = 512, KVW = 128, PW = 512, INW = 1280, FF = 4096, NMOD = 6;
constexpr float EPS = 1e-6f;
#ifndef MK_N_LAUNCHES
#define MK_N_LAUNCHES 1
#endif
constexpr int N_PHASES = 7;
constexpr int N_LAUNCHES = MK_N_LAUNCHES;

constexpr size_t MiB = 1u << 20;
constexpr size_t WS_CTL = 0, CTL_ZERO_BYTES = 64 * 1024;
constexpr size_t WS_MOD = 1 * MiB;
constexpr size_t WS_BIAS2 = 1 * MiB + 256 * 1024;
constexpr size_t WS_A2 = 1 * MiB + 512 * 1024;
constexpr size_t WS_ROPE = 2 * MiB;
constexpr size_t WS_STATS = 4 * MiB;
constexpr size_t WS_WIN = 6 * MiB, WS_WO = 9 * MiB, WS_W2 = 20 * MiB;
constexpr size_t WS_XB1 = 32 * MiB;
constexpr size_t WS_H = 96 * MiB;
constexpr size_t WS_XN = 96 * MiB, WS_Q = 160 * MiB, WS_K = 192 * MiB, WS_V = 200 * MiB, WS_U = 208 * MiB, WS_MIX = 240 * MiB;
constexpr size_t WS_W1 = 352 * MiB;
constexpr size_t WS_Z2 = 416 * MiB;
constexpr size_t WS_END = 480 * MiB;
constexpr int CW_BAR = 1024;

constexpr int LDS_BYTES = 160 * 1024;
constexpr int MISC_OFF = LDS_BYTES - 256;
constexpr int ATT_K = 0, ATT_V = 24576, ATT_WS = 49152, ATT_OST = ATT_WS + NWAVES * 256, ATT_END = ATT_OST + NWAVES * 4096;

#define GAS __attribute__((address_space(1)))
#define LAS __attribute__((address_space(3)))
typedef unsigned short bf16;
typedef unsigned v4u __attribute__((ext_vector_type(4)));
typedef float f32x4 __attribute__((ext_vector_type(4)));
typedef short bf16x8 __attribute__((ext_vector_type(8)));
typedef GAS unsigned gu32;
typedef GAS unsigned long long gu64;
#define RLX_AGENT __ATOMIC_RELAXED, __HIP_MEMORY_SCOPE_AGENT
#define LDS_WAIT() asm volatile("s_waitcnt lgkmcnt(0)" ::: "memory")
#define VM_WAIT() asm volatile("s_waitcnt vmcnt(0)" ::: "memory")
__device__ __forceinline__ unsigned long long rt() { return __builtin_amdgcn_s_memrealtime(); }
__device__ __forceinline__ unsigned f2bf(float f) { unsigned u = __builtin_bit_cast(unsigned, f); return (u + 0x7fffu + ((u >> 16) & 1u)) >> 16; }
__device__ __forceinline__ unsigned pk2(float lo, float hi) { return f2bf(lo) | (f2bf(hi) << 16); }

#define XB_TMO      128
#define XB_XCNT(j)  (256  + 64 * (j))
#define XB_XSUB(j)  (1280 + 64 * (j))
#define XB_XGEN(j)  (2304 + 64 * (j))
#define XB_TOP      3328
#define XB_TOPGEN   3392
#define XCD_BAR_WORDS 3456
#define XB_SPIN_CAP (1u << 18)

__device__ __forceinline__ unsigned xb_ld(unsigned* p)              { return __hip_atomic_load(p, __ATOMIC_RELAXED, __HIP_MEMORY_SCOPE_AGENT); }
__device__ __forceinline__ unsigned xb_add(unsigned* p, unsigned v) { return __hip_atomic_fetch_add(p, v, __ATOMIC_RELAXED, __HIP_MEMORY_SCOPE_AGENT); }
__device__ __forceinline__ unsigned xb_xcc_id() { return (unsigned)__builtin_amdgcn_s_getreg((3 << 11) | 20) & 0xFu; }
#define XB_SPIN(cond, bar) do { unsigned _sp = 0; while (cond) { __builtin_amdgcn_s_sleep(1); \
    if ((++_sp & 255u) == 0u) { if (xb_ld(&(bar)[XB_TMO])) break; if (_sp > XB_SPIN_CAP) { atomicAdd(&(bar)[XB_TMO], 1u); break; } } } } while (0)

struct XcdBarrier {
    unsigned* bar; unsigned x;
    volatile LAS unsigned* st;
};

__device__ __forceinline__ XcdBarrier xcd_barrier_post(unsigned* bar, volatile LAS unsigned* st) {
    XcdBarrier b; b.bar = bar; b.x = xb_xcc_id(); b.st = st;
    if (threadIdx.x == 0) (void)xb_add(&bar[XB_XCNT(b.x)], 1u);
    return b;
}
__device__ __forceinline__ void xcd_barrier_complete(unsigned* bar, unsigned x, unsigned& nloc, unsigned& nx) {
    const unsigned G = gridDim.x * gridDim.y * gridDim.z;
    unsigned sum, cnt, mine, sp = 0u;
    for (;;) {
        sum = 0u; cnt = 0u; mine = 0u;
#pragma unroll
        for (unsigned j = 0; j < 16; ++j) { const unsigned c = xb_ld(&bar[XB_XCNT(j)]); sum += c; cnt += (c > 0u) ? 1u : 0u; mine = (j == x) ? c : mine; }
        if (sum == G) break;
        __builtin_amdgcn_s_sleep(1);
        if ((++sp & 255u) == 0u) { if (xb_ld(&bar[XB_TMO])) break; if (sp > XB_SPIN_CAP) { atomicAdd(&bar[XB_TMO], 1u); break; } }
    }
    nloc = mine > 0u ? mine : 1u; nx = cnt > 0u ? cnt : 1u;
}

__device__ __forceinline__ void xcd_barrier(const XcdBarrier& b) {
    asm volatile("s_waitcnt vmcnt(0)" ::: "memory");
    __syncthreads();
    if (threadIdx.x == 0) {
        unsigned* bar = b.bar;
        __builtin_amdgcn_s_waitcnt(0);
        unsigned nloc = b.st[0], nx = b.st[1];
        if (nloc == 0u) { xcd_barrier_complete(bar, b.x, nloc, nx); b.st[0] = nloc; b.st[1] = nx; }
        const unsigned old = xb_add(&bar[XB_XSUB(b.x)], 1u);
        const unsigned gen = old / nloc;
        if (old + 1u == (gen + 1u) * nloc) {
            __builtin_amdgcn_fence(__ATOMIC_RELEASE, "agent");
            asm volatile("s_waitcnt vmcnt(0)" ::: "memory");
            const unsigned og = xb_add(&bar[XB_TOP], 1u);
            const unsigned tg = og / nx;
            if (og + 1u == (tg + 1u) * nx) xb_add(&bar[XB_TOPGEN], 1u);
            else XB_SPIN(xb_ld(&bar[XB_TOPGEN]) == tg, bar);
            __builtin_amdgcn_fence(__ATOMIC_ACQUIRE, "agent");
            xb_add(&bar[XB_XGEN(b.x)], 1u);
            asm volatile("s_waitcnt vmcnt(0)" ::: "memory");
        } else {
            XB_SPIN(xb_ld(&bar[XB_XGEN(b.x)]) == gen, bar);
            __builtin_amdgcn_fence(__ATOMIC_ACQUIRE, "agent");
            asm volatile("s_waitcnt vmcnt(0)" ::: "memory");
        }
    }
    __syncthreads();
}

#define NTLOAD(p) __builtin_nontemporal_load(p)
typedef float f32x16 __attribute__((ext_vector_type(16)));
typedef short s16x4 __attribute__((ext_vector_type(4)));
struct Frame {
    LAS unsigned char* lds;
    int tid, lane, wave, vcu, G;
};
__device__ __forceinline__ float wave_sum(float v) {
#pragma unroll
    for (int o = 1; o < 64; o <<= 1) v += __shfl_xor(v, o);
    return v;
}
__device__ __forceinline__ float bf2f(unsigned short h) { return __builtin_bit_cast(float, (unsigned)h << 16); }
__device__ __forceinline__ float bflo(unsigned w) { return __builtin_bit_cast(float, w << 16); }
__device__ __forceinline__ float bfhi(unsigned w) { return __builtin_bit_cast(float, w & 0xffff0000u); }

__device__ __forceinline__ void p0_transpose_item(const float* W, int N, bf16* WT, int Kd, int k0, int n0, int dst_row0, LAS float* scr, int lane) {
    f32x4 v[8];
#pragma unroll
    for (int i = 0; i < 8; ++i) v[i] = NTLOAD((const GAS f32x4*)(W + (size_t)(k0 + 8 * i + (lane >> 3)) * N + n0 + 4 * (lane & 7)));
#pragma unroll
    for (int i = 0; i < 8; ++i) { LAS float* d = scr + (8 * i + (lane >> 3)) * 33 + 4 * (lane & 7); d[0] = v[i][0]; d[1] = v[i][1]; d[2] = v[i][2]; d[3] = v[i][3]; }
    LDS_WAIT(); asm volatile("" ::: "memory");
    const int c = lane & 7;
#pragma unroll
    for (int j = 0; j < 4; ++j) { const int n = (lane >> 3) + 8 * j; const LAS float* s = scr + (8 * c) * 33 + n;
        v4u o; o.x = pk2(s[0 * 33], s[1 * 33]); o.y = pk2(s[2 * 33], s[3 * 33]); o.z = pk2(s[4 * 33], s[5 * 33]); o.w = pk2(s[6 * 33], s[7 * 33]);
        *(GAS v4u*)(WT + (size_t)(dst_row0 + n) * Kd + k0 + 8 * c) = o; }
    LDS_WAIT(); asm volatile("" ::: "memory");
}
__device__ __forceinline__ int win_slot(int n) { const int pn = n >> 8, r = n & 255; return 256 * pn + 128 * ((r >> 5) & 1) + 32 * (r >> 6) + (r & 31); }

struct Ptrs {
    const float *x, *c, *w_ada, *b_ada, *norm1_g, *w_in, *q_norm_g, *k_norm_g, *sinks, *pool_w, *pool_scale, *w_o, *norm2_g, *w1, *w2; const int* positions;
    float *out, *mod, *bias2, *a2, *rope, *stats; bf16 *Win_t, *Wo_t, *W1_t, *W2_t, *XN, *Q, *K, *V, *U, *MIX, *XB1, *H, *Z2;
};

template <bool SILU> __device__ __forceinline__ void skinny_task(Frame& F, const float* src, int spitch, const float* W, int wpitch, const float* bias, float* out, int opitch, int t) {
    LAS float* vT = (LAS float*)F.lds;
    LAS float* red = (LAS float*)(F.lds + 65536);
    { float cv[16];
#pragma unroll
      for (int i = 0; i < 16; ++i) { const int idx = F.tid + 512 * i; cv[i] = src[(size_t)(idx >> 10) * spitch + (idx & 1023)]; }
#pragma unroll
      for (int i = 0; i < 16; ++i) { const int idx = F.tid + 512 * i, b = idx >> 10, k = idx & 1023; vT[k * 16 + b] = SILU ? cv[i] / (1.f + __expf(-cv[i])) : cv[i]; vT[k * 16 + 8 + b] = 0.f; } }
    __syncthreads();
    const int j0 = 64 * t, kb = 128 * F.wave, kq = F.lane >> 4, jl = F.lane & 15;
    f32x4 acc[4];
#pragma unroll
    for (int e = 0; e < 4; ++e) acc[e] = (f32x4){0.f, 0.f, 0.f, 0.f};
    const GAS float* wp = (const GAS float*)W + (size_t)(kb + kq) * wpitch + j0 + 4 * jl;
#pragma unroll
    for (int s0 = 0; s0 < 32; s0 += 16) {
        f32x4 wv[16];
#pragma unroll
        for (int s = 0; s < 16; ++s) wv[s] = NTLOAD((const GAS f32x4*)(wp + (size_t)(4 * (s0 + s)) * wpitch));
#pragma unroll
        for (int s = 0; s < 16; ++s) { const float a = vT[(kb + 4 * (s0 + s) + kq) * 16 + jl];
#pragma unroll
            for (int e = 0; e < 4; ++e) acc[e] = __builtin_amdgcn_mfma_f32_16x16x4f32(a, wv[s][e], acc[e], 0, 0, 0); }
    }
    if (F.lane < 32) {
#pragma unroll
        for (int e = 0; e < 4; ++e)
#pragma unroll
            for (int r = 0; r < 4; ++r) red[((F.wave * 4 + e) * 4 + r) * 32 + F.lane] = acc[e][r];
    }
    __syncthreads();
    { const int b = F.tid >> 6, col = F.tid & 63, e = col & 3, lane = (b >> 2) * 16 + (col >> 2), r = b & 3; float sum = 0.f;
#pragma unroll
      for (int w = 0; w < NWAVES; ++w) sum += red[((w * 4 + e) * 4 + r) * 32 + lane];
      out[(size_t)b * opitch + j0 + col] = sum + (bias ? bias[j0 + col] : 0.f); }
    __syncthreads();
}
__device__ __forceinline__ void p0_fold_task(Frame& F, const Ptrs& P, int t) {
    const int g = t >> 5, n0 = (t & 31) * 32;
    LAS float* Pm = (LAS float*)F.lds;
    LAS float* Wm = (LAS float*)(F.lds + 128 * 129 * 4);
    { float pv[32], wv[8];
#pragma unroll
      for (int i = 0; i < 32; ++i) pv[i] = P.pool_w[(size_t)g * 16384 + F.tid + 512 * i];
#pragma unroll
      for (int i = 0; i < 8; ++i) { const int idx = F.tid + 512 * i; wv[i] = P.w_o[(size_t)(512 + 128 * g + (idx >> 5)) * D + n0 + (idx & 31)]; }
      const float sc = P.pool_scale[128 * g + (F.tid & 127)];
#pragma unroll
      for (int i = 0; i < 32; ++i) { const int idx = F.tid + 512 * i; Pm[(idx >> 7) * 129 + (idx & 127)] = pv[i] * sc; }
#pragma unroll
      for (int i = 0; i < 8; ++i) { const int idx = F.tid + 512 * i; Wm[(idx >> 5) * 33 + (idx & 31)] = wv[i]; } }
    __syncthreads();
    const int c0 = 16 * F.wave, li = F.lane & 15, lq = F.lane >> 4;
    f32x4 acc0 = (f32x4){0.f, 0.f, 0.f, 0.f}, acc1 = acc0;
#pragma unroll 8
    for (int d0 = 0; d0 < 128; d0 += 4) {
        const float a = Pm[(c0 + li) * 129 + d0 + lq], b0 = Wm[(d0 + lq) * 33 + li], b1 = Wm[(d0 + lq) * 33 + 16 + li];
        acc0 = __builtin_amdgcn_mfma_f32_16x16x4f32(a, b0, acc0, 0, 0, 0); acc1 = __builtin_amdgcn_mfma_f32_16x16x4f32(a, b1, acc1, 0, 0, 0);
    }
#pragma unroll
    for (int r = 0; r < 4; ++r) { const int c = c0 + 4 * lq + r;
        P.Wo_t[(size_t)(n0 + li) * D + 512 + 128 * g + c] = (bf16)f2bf(acc0[r]); P.Wo_t[(size_t)(n0 + 16 + li) * D + 512 + 128 * g + c] = (bf16)f2bf(acc1[r]); }
    __syncthreads();
}
__device__ __forceinline__ void p0a_prologue(Frame& F, const Ptrs& P) {
    for (int t = F.vcu; t < 96; t += F.G) skinny_task<true>(F, P.c, D, P.w_ada, NMOD * D, P.b_ada, P.mod, NMOD * D, t);
    LAS float* scr = (LAS float*)(F.lds + F.wave * 16384);
    const int gw = (F.G - 1 - F.vcu) * NWAVES + F.wave, NGW = F.G * NWAVES;
    constexpr int I_IN = (D / 64) * (INW / 32), I_2 = (FF / 64) * (D / 32);
    for (int it = gw; it < I_IN; it += NGW) { const int nblk = INW / 32, kb = it / nblk, nb = it % nblk; p0_transpose_item(P.w_in, INW, P.Win_t, D, 64 * kb, 32 * nb, win_slot(32 * nb), scr, F.lane); }
    { const int nfree = F.G > 96 ? F.G - 96 : F.G, ordf = F.G > 96 ? F.vcu - 96 : F.vcu;
      if (ordf >= 0) for (int it = ordf * NWAVES + F.wave; it < I_2; it += nfree * NWAVES) { const int nblk = D / 32, kb = it / nblk, nb = it % nblk; p0_transpose_item(P.w2, D, P.W2_t, FF, 64 * kb, 32 * nb, 32 * nb, scr, F.lane); } }
    for (int idx = (F.vcu * NWAVES * 64 + F.tid); idx < M * 8; idx += F.G * NWAVES * 64) {
        const int m = idx >> 3, i = idx & 7;
        const float inv_freq = (i == 0) ? 1.0f : (i == 1) ? 0.1939227432012558f : (i == 2) ? 0.03760603070259094f : (i == 3) ? 0.007292664609849453f : (i == 4) ? 0.0014142135623842478f : (i == 5) ? 0.00027424818836152554f : (i == 6) ? 5.3182957344688475e-05f : 1.0313385246263351e-05f;
        const float ang = (float)P.positions[m] * inv_freq;
        const float I2PI_HI = 0.15915493667125702f, I2PI_LO = 6.4206382432985265e-09f;
        const float pr = ang * I2PI_HI, er = __builtin_fmaf(ang, I2PI_HI, -pr), rl = __builtin_fmaf(ang, I2PI_LO, er);
        const float fr = (pr - __builtin_rintf(pr)) + rl;
        P.rope[(size_t)m * 16 + i] = __builtin_amdgcn_cosf(fr); P.rope[(size_t)m * 16 + 8 + i] = __builtin_amdgcn_sinf(fr);
    }
}

__device__ __forceinline__ void p1_tail_work(Frame& F, const Ptrs& P, int ord, int cnt) {
    for (int t = ord; t < 128; t += cnt) p0_fold_task(F, P, t);
    for (int t = cnt - 1 - ord; t < FF / 64; t += cnt) skinny_task<false>(F, P.mod + 3 * D, NMOD * D, P.w1, FF, nullptr, P.bias2, FF, t);
    LAS float* scr = (LAS float*)(F.lds + F.wave * 16384);
    constexpr int I_1 = (D / 64) * (FF / 32), I_O = (AW / 64) * (D / 32);
    for (int it = ord * NWAVES + F.wave; it < I_1 + I_O; it += cnt * NWAVES) {
        int r = it;
        if (r < I_1) { const int nblk = FF / 32, kb = r / nblk, nb = r % nblk; p0_transpose_item(P.w1, FF, P.W1_t, D, 64 * kb, 32 * nb, 32 * nb, scr, F.lane); continue; } r -= I_1;
        { const int nblk = D / 32, kb = r / nblk, nb = r % nblk; p0_transpose_item(P.w_o, D, P.Wo_t, D, 64 * kb, 32 * nb, 32 * nb, scr, F.lane); }
    }
}

__device__ __forceinline__ void p0b_norm(Frame& F, const Ptrs& P) {
    const int gt = F.vcu * NWAVES * 64 + F.tid, NGT = F.G * NWAVES * 64;
    for (int i = gt; i < BATCH * D; i += NGT) { const int b = i >> 10, col = i & 1023; P.a2[i] = P.norm2_g[col] * (1.f + P.mod[(size_t)b * NMOD * D + 4 * D + col]); }
    const int gw = F.vcu * NWAVES + F.wave, NGW = F.G * NWAVES;
    for (int rb = gw; rb < M / 16; rb += NGW) {
        const int b = (rb * 16) / SEQ; const float* mb = P.mod + (size_t)b * NMOD * D;
        f32x4 av[4], sv[4];
#pragma unroll
        for (int j = 0; j < 4; ++j) { const int col = 256 * j + 4 * F.lane; const f32x4 g = *(const f32x4*)(P.norm1_g + col), sc = *(const f32x4*)(mb + D + col); av[j] = g * (sc + 1.0f); sv[j] = *(const f32x4*)(mb + col); }
        for (int rr = 0; rr < 16; rr += 4) {
            f32x4 v[4][4]; float s[4];
#pragma unroll
            for (int q = 0; q < 4; ++q) { const GAS f32x4* xr = (const GAS f32x4*)(P.x + (size_t)(rb * 16 + rr + q) * D) + F.lane;
#pragma unroll
                for (int j = 0; j < 4; ++j) v[q][j] = NTLOAD(xr + 64 * j); }
#pragma unroll
            for (int q = 0; q < 4; ++q) { float t = 0.f;
#pragma unroll
                for (int j = 0; j < 4; ++j) t += (v[q][j][0] * v[q][j][0] + v[q][j][1] * v[q][j][1]) + (v[q][j][2] * v[q][j][2] + v[q][j][3] * v[q][j][3]);
                s[q] = t; }
#pragma unroll
            for (int o = 1; o < 64; o <<= 1) {
#pragma unroll
                for (int q = 0; q < 4; ++q) s[q] += __shfl_xor(s[q], o); }
#pragma unroll
            for (int q = 0; q < 4; ++q) { const float r = rsqrtf(s[q] * (1.f / D) + EPS);
                GAS unsigned long long* o8 = (GAS unsigned long long*)(P.XN + (size_t)(rb * 16 + rr + q) * D) + F.lane;
#pragma unroll
                for (int j = 0; j < 4; ++j) { const f32x4 y = v[q][j] * r * av[j] + sv[j]; o8[64 * j] = (unsigned long long)pk2(y[0], y[1]) | ((unsigned long long)pk2(y[2], y[3]) << 32); } }
        }
    }
}

__device__ __forceinline__ int crow(int r, int hi) { return (r & 3) + 8 * (r >> 2) + 4 * hi; }
__device__ __forceinline__ unsigned cvtpk(float lo, float hi) { unsigned r; asm volatile("v_cvt_pk_bf16_f32 %0, %1, %2" : "=v"(r) : "v"(lo), "v"(hi)); return r; }
typedef short v4i16_t __attribute__((ext_vector_type(4)));
__device__ __forceinline__ s16x4 vtr(LAS const unsigned char* p) { return __builtin_bit_cast(s16x4, __builtin_amdgcn_ds_read_tr16_b64_v4i16((LAS v4i16_t*)p)); }

struct AttnRegs { v4u k[3], v[3]; bf16x8 q[4]; };
__device__ __forceinline__ void attn_load(Frame& F, const Ptrs& P, int unit, AttnRegs& R) {
    const int lane = F.lane, wid = F.wave, r32 = lane & 31, hi = lane >> 5;
    const int bk = unit >> 6, qb = unit & 63, b = bk >> 1, kvh = bk & 1, wh = wid & 1, hq = kvh * 4 + (wid >> 1);
    const long rowbase = (long)b * SEQ; const int q0 = qb * 64, kv0 = q0 - 128, qw0 = q0 + 32 * wh;
#pragma unroll
    for (int i = 0; i < 3; ++i) { const int kvr = kv0 + 64 * i + lane, kc = kvr < 0 ? 0 : kvr; const v4u t = *(const GAS v4u*)(P.K + (rowbase + kc) * KVW + kvh * 64 + wid * 8); const unsigned mk = kvr < 0 ? 0u : 0xffffffffu; R.k[i] = (v4u){t.x & mk, t.y & mk, t.z & mk, t.w & mk}; }
#pragma unroll
    for (int i = 0; i < 3; ++i) { const int kvr = kv0 + 64 * i + 16 * (wid & 3) + (lane >> 2), kc = kvr < 0 ? 0 : kvr; const v4u t = *(const GAS v4u*)(P.V + (rowbase + kc) * KVW + kvh * 64 + (wid >> 2) * 32 + (lane & 3) * 8); const unsigned mk = kvr < 0 ? 0u : 0xffffffffu; R.v[i] = (v4u){t.x & mk, t.y & mk, t.z & mk, t.w & mk}; }
    const bf16* Qw = P.Q + (rowbase + qw0 + r32) * AW + hq * 64 + hi * 8;
#pragma unroll
    for (int d0 = 0; d0 < 4; ++d0) R.q[d0] = *(const GAS bf16x8*)(Qw + d0 * 16);
}
__device__ __forceinline__ void attn_compute(Frame& F, const Ptrs& P, int unit, const bf16x8 (&qr)[4], float sink0, float sink1) {
    const int lane = F.lane, wid = F.wave, r32 = lane & 31, hi = lane >> 5;
    const int bk = unit >> 6, qb = unit & 63, b = bk >> 1, kvh = bk & 1, wh = wid & 1, hq = kvh * 4 + (wid >> 1);
    const long rowbase = (long)b * SEQ; const int q0 = qb * 64, qw0 = q0 + 32 * wh;
    LAS unsigned char* lds = F.lds;
    f32x16 p[5];
#pragma unroll
    for (int j = 0; j < 5; ++j) {
        const int hb = wh + j; const LAS unsigned char* kp = lds + ATT_K + (hb >> 1) * 8192 + hi * 1024 + ((hb & 1) * 32 + r32) * 16;
        f32x16 a = {0.f, 0.f, 0.f, 0.f, 0.f, 0.f, 0.f, 0.f, 0.f, 0.f, 0.f, 0.f, 0.f, 0.f, 0.f, 0.f};
#pragma unroll
        for (int d0 = 0; d0 < 4; ++d0) { const bf16x8 kf = *(const LAS bf16x8*)(kp + d0 * 2048); a = __builtin_amdgcn_mfma_f32_32x32x16_bf16(kf, qr[d0], a, 0, 0, 0); }
        p[j] = a;
    }
    const float NEG = -INFINITY;
#pragma unroll
    for (int j = 0; j < 5; ++j) {
        const bool valid = (qw0 - 128 + 32 * j) >= 0;
#pragma unroll
        for (int r = 0; r < 16; ++r) { bool keep = valid; if (j == 0) keep = keep && (crow(r, hi) > r32); if (j == 4) keep = keep && (crow(r, hi) <= r32); if (!keep) p[j][r] = NEG; }
    }
    const float sinkl2 = (kvh ? sink1 : sink0) * 1.4426950408889634f;
    float mx = sinkl2;
#pragma unroll
    for (int j = 0; j < 5; ++j)
#pragma unroll
        for (int r = 0; r < 16; ++r) mx = fmaxf(mx, p[j][r]);
    { auto rr = __builtin_amdgcn_permlane32_swap(__float_as_uint(mx), __float_as_uint(mx), false, false); mx = fmaxf(__uint_as_float(rr[0]), __uint_as_float(rr[1])); }
    float l = 0.f;
#pragma unroll
    for (int j = 0; j < 5; ++j)
#pragma unroll
        for (int r = 0; r < 16; ++r) { const float e = __builtin_amdgcn_exp2f(p[j][r] - mx); p[j][r] = e; l += e; }
    { auto rr = __builtin_amdgcn_permlane32_swap(__float_as_uint(l), __float_as_uint(l), false, false); l = __uint_as_float(rr[0]) + __uint_as_float(rr[1]); }
    l += __builtin_amdgcn_exp2f(sinkl2 - mx);
    f32x16 o[2];
    o[0] = (f32x16){0.f, 0.f, 0.f, 0.f, 0.f, 0.f, 0.f, 0.f, 0.f, 0.f, 0.f, 0.f, 0.f, 0.f, 0.f, 0.f}; o[1] = o[0];
    const LAS unsigned char* vb = lds + ATT_V + ((lane >> 4) & 1) * 32 + (lane & 3) * 8 + (4 * hi + ((lane & 15) >> 2)) * 64;
#pragma unroll
    for (int j = 0; j < 5; ++j) {
        const int hb = wh + j; const LAS unsigned char* vt = vb + (hb >> 1) * 8192 + (hb & 1) * 2048;
#pragma unroll
        for (int s = 0; s < 2; ++s) {
            v4u pw; pw.x = cvtpk(p[j][8 * s + 0], p[j][8 * s + 1]); pw.y = cvtpk(p[j][8 * s + 2], p[j][8 * s + 3]); pw.z = cvtpk(p[j][8 * s + 4], p[j][8 * s + 5]); pw.w = cvtpk(p[j][8 * s + 6], p[j][8 * s + 7]);
            const bf16x8 pf = __builtin_bit_cast(bf16x8, pw);
#pragma unroll
            for (int d0 = 0; d0 < 2; ++d0) {
                const s16x4 lo = vtr(vt + d0 * 4096 + s * 1024), hh = vtr(vt + d0 * 4096 + s * 1024 + 512);
                const bf16x8 vf = (bf16x8){lo[0], lo[1], lo[2], lo[3], hh[0], hh[1], hh[2], hh[3]};
                o[d0] = __builtin_amdgcn_mfma_f32_32x32x16_bf16(pf, vf, o[d0], 0, 0, 0);
            }
        }
    }
    LAS float* wsf = (LAS float*)(lds + ATT_WS) + wid * 64;
    if (hi == 0) wsf[r32] = l;
    LDS_WAIT(); asm volatile("" ::: "memory");
    float rli[16];
#pragma unroll
    for (int r = 0; r < 16; ++r) rli[r] = __builtin_amdgcn_rcpf(wsf[crow(r, hi)]);
    LAS bf16* stg = (LAS bf16*)(lds + ATT_OST) + wid * 2048;
#pragma unroll
    for (int r = 0; r < 16; ++r) { const int orow = crow(r, hi);
#pragma unroll
        for (int d0 = 0; d0 < 2; ++d0) stg[orow * 64 + d0 * 32 + r32] = (bf16)f2bf(o[d0][r] * rli[r]); }
    LDS_WAIT(); asm volatile("" ::: "memory");
    bf16* Ow = P.MIX + (rowbase + qw0) * D + hq * 64;
#pragma unroll
    for (int i = 0; i < 4; ++i) { const int row = i * 8 + (lane >> 3), ch = lane & 7; const v4u v = *(const LAS v4u*)(stg + row * 64 + ch * 8); *(GAS v4u*)(Ow + (size_t)row * D + ch * 8) = v; }
}
__device__ __forceinline__ void unpack8(const v4u w, float (&f)[8]) { f[0] = bflo(w.x); f[1] = bfhi(w.x); f[2] = bflo(w.y); f[3] = bfhi(w.y); f[4] = bflo(w.z); f[5] = bfhi(w.z); f[6] = bflo(w.w); f[7] = bfhi(w.w); }
template <int W> __device__ __forceinline__ void pool_task_w(Frame& F, const Ptrs& P, int g, int rb) {
    const int ch = F.lane & 15, run = F.lane >> 4;
    const int t0 = (rb * 64 + run * 16) & (SEQ - 1);
    const GAS char* ub = (const GAS char*)(P.U + (size_t)(rb * 64) * PW + g * 128);
    GAS char* ob = (GAS char*)(P.MIX + (size_t)(rb * 64) * D + AW + g * 128);
    const unsigned loff = (unsigned)((run * 16 * PW + ch * 8) * 2), ooff = (unsigned)((run * 16 * D + ch * 8) * 2);
    v4u cur[16], prev[W];
#pragma unroll
    for (int i = 0; i < 16; ++i) cur[i] = *(const GAS v4u*)(ub + (size_t)i * (PW * 2) + loff);
#pragma unroll
    for (int j = 1; j <= W; ++j) { const bool ok = (t0 - j) >= 0; const v4u t = *(const GAS v4u*)(ub + loff - (ok ? (size_t)j * (PW * 2) : (size_t)0)); const unsigned mk = ok ? 0xffffffffu : 0u; prev[j - 1] = (v4u){t.x & mk, t.y & mk, t.z & mk, t.w & mk}; }
    float S[8];
#pragma unroll
    for (int e = 0; e < 8; ++e) S[e] = 0.f;
#pragma unroll
    for (int j = 1; j <= W; ++j) { float f[8]; unpack8(prev[j - 1], f);
#pragma unroll
        for (int e = 0; e < 8; ++e) S[e] += f[e]; }
#pragma unroll
    for (int i = 0; i < 16; ++i) {
        const int t = t0 + i; float u[8]; unpack8(cur[i], u);
        float f[8]; unpack8(i < W ? prev[(W - 1 - i) >= 0 ? (W - 1 - i) : 0] : cur[(i - W) >= 0 ? (i - W) : 0], f);
#pragma unroll
        for (int e = 0; e < 8; ++e) S[e] += u[e] - f[e];
        const float inv = 1.0f / (float)((t + 1) < W ? (t + 1) : W);
        v4u o; o.x = pk2(S[0] * inv - u[0], S[1] * inv - u[1]); o.y = pk2(S[2] * inv - u[2], S[3] * inv - u[3]); o.z = pk2(S[4] * inv - u[4], S[5] * inv - u[5]); o.w = pk2(S[6] * inv - u[6], S[7] * inv - u[7]);
        *(GAS v4u*)(ob + (size_t)i * (D * 2) + ooff) = o;
    }
}
__device__ __forceinline__ void pool_task(Frame& F, const Ptrs& P, int task) {
    const int g = task & 3, rb = task >> 2;
    if (g == 0) pool_task_w<2>(F, P, 0, rb); else if (g == 1) pool_task_w<4>(F, P, 1, rb); else if (g == 2) pool_task_w<8>(F, P, 2, rb); else pool_task_w<16>(F, P, 3, rb);
}
__device__ __forceinline__ void p2_attn_pool(Frame& F, const Ptrs& P) {
    constexpr int NUNITS = BATCH * NKV * (SEQ / 64);
    const int upw = (NUNITS + F.G - 1) / F.G, first = F.vcu * upw;
    int n = NUNITS - first; n = n < 0 ? 0 : (n > upw ? upw : n);
    const int gw = F.vcu * NWAVES + F.wave, NGW = F.G * NWAVES;
    const float sink0 = P.sinks[F.wave >> 1], sink1 = P.sinks[4 + (F.wave >> 1)];
    AttnRegs R;
    if (n > 0) attn_load(F, P, first, R);
    for (int i = 0; i < n; ++i) {
        bf16x8 qr[4];
#pragma unroll
        for (int d0 = 0; d0 < 4; ++d0) qr[d0] = R.q[d0];
#pragma unroll
        for (int t = 0; t < 3; ++t) { *(LAS v4u*)(F.lds + ATT_K + t * 8192 + F.wave * 1024 + F.lane * 16) = R.k[t]; *(LAS v4u*)(F.lds + ATT_V + t * 8192 + F.wave * 1024 + F.lane * 16) = R.v[t]; }
        __syncthreads();
        if (i + 1 < n) attn_load(F, P, first + i + 1, R);
        attn_compute(F, P, first + i, qr, sink0, sink1);
        __syncthreads();
    }
    for (int t = gw; t < 4 * (M / 64); t += NGW) pool_task(F, P, t);
}

template <int NL> __device__ __forceinline__ void warm_buffer(Frame& F, const void* buf) {
    const size_t per = (size_t)F.G * NWAVES * 64;
    const GAS v4u* p = (const GAS v4u*)buf + ((size_t)F.vcu * NWAVES * 64 + F.tid);
    v4u t[NL];
#pragma unroll
    for (int i = 0; i < NL; ++i) t[i] = p[(size_t)i * per];
#pragma unroll
    for (int i = 0; i < NL; ++i) asm volatile("" :: "v"(t[i]));
}

struct Args { const void* in[16]; float* out; unsigned char* ws; int ph_lo, ph_hi; };
__global__ void __launch_bounds__(NWAVES * 64, 2) fwd_megakernel(Args args) {
    extern __shared__ __attribute__((aligned(16))) unsigned char lds[];
    asm volatile("s_nop 0");
    asm volatile("s_nop 0");
    asm volatile("s_nop 0");
    asm volatile("s_nop 0");
    Frame F;
    F.lds = (LAS unsigned char*)lds;
    F.tid = threadIdx.x; F.lane = F.tid & 63; F.wave = __builtin_amdgcn_readfirstlane(F.tid >> 6);
    F.G = gridDim.x; { const int bx = blockIdx.x; F.vcu = (F.G % 8 == 0) ? (bx % 8) * (F.G / 8) + bx / 8 : bx; }
    unsigned char* ws = args.ws;
    Ptrs P;
    P.x = (const float*)args.in[0]; P.c = (const float*)args.in[1]; P.positions = (const int*)args.in[2]; P.w_ada = (const float*)args.in[3]; P.b_ada = (const float*)args.in[4];
    P.norm1_g = (const float*)args.in[5]; P.w_in = (const float*)args.in[6]; P.q_norm_g = (const float*)args.in[7]; P.k_norm_g = (const float*)args.in[8]; P.sinks = (const float*)args.in[9];
    P.pool_w = (const float*)args.in[10]; P.pool_scale = (const float*)args.in[11]; P.w_o = (const float*)args.in[12]; P.norm2_g = (const float*)args.in[13]; P.w1 = (const float*)args.in[14]; P.w2 = (const float*)args.in[15];
    P.out = args.out; P.mod = (float*)(ws + WS_MOD); P.bias2 = (float*)(ws + WS_BIAS2); P.a2 = (float*)(ws + WS_A2); P.rope = (float*)(ws + WS_ROPE); P.stats = (float*)(ws + WS_STATS);
    P.Win_t = (bf16*)(ws + WS_WIN); P.Wo_t = (bf16*)(ws + WS_WO); P.W1_t = (bf16*)(ws + WS_W1); P.W2_t = (bf16*)(ws + WS_W2);
    P.XN = (bf16*)(ws + WS_XN); P.Q = (bf16*)(ws + WS_Q); P.K = (bf16*)(ws + WS_K); P.V = (bf16*)(ws + WS_V); P.U = (bf16*)(ws + WS_U); P.MIX = (bf16*)(ws + WS_MIX); P.XB1 = (bf16*)(ws + WS_XB1); P.Z2 = (bf16*)(ws + WS_Z2); P.H = (bf16*)(ws + WS_H);
    volatile LAS unsigned* MISC = (volatile LAS unsigned*)(F.lds + MISC_OFF);
    if (F.tid < 64) MISC[F.tid] = 0u;
    __syncthreads();
    XcdBarrier bar; bar.bar = (unsigned*)(ws + WS_CTL) + CW_BAR; bar.x = 0; bar.st = nullptr;
    if (N_LAUNCHES == 1) bar = xcd_barrier_post((unsigned*)(ws + WS_CTL) + CW_BAR, MISC + 8);
    const int lo = args.ph_lo, hi = args.ph_hi;
#define IN(k) (lo <= (k) && (k) < hi)
#define SEAM(k) do { if (IN(k) && IN((k) + 1)) xcd_barrier(bar); } while (0)

    if (IN(0)) { p0a_prologue(F, P); SEAM(0); }
    if (IN(1)) { p0b_norm(F, P); SEAM(1); }
    if (IN(2)) {   warm_buffer<2>(F, P.Win_t);
        pg8::Gemm g{P.XN, P.Win_t, M, INW, D}; pg8::StaticOrder S; S.init(M, INW, F.G, (int)blockIdx.x);
        pg8::EpiProj E{P.Q, P.K, P.V, P.U, P.rope, P.q_norm_g, P.k_norm_g};
        pg8::gemm_phase<pg8::EpiProj, pg8::StaticOrder, true, true>(F.lds, g, S, E);
        { const int nwg = (M / 256) * (INW / 256), rem = nwg % F.G;
          if (rem == 0) p1_tail_work(F, P, (int)blockIdx.x, F.G); else if ((int)blockIdx.x >= rem) p1_tail_work(F, P, (int)blockIdx.x - rem, F.G - rem); }
        SEAM(2);
    }
    if (IN(3)) { p2_attn_pool(F, P); SEAM(3); }
    if (IN(4)) {   warm_buffer<1>(F, P.Wo_t);
        pg8::Gemm g{P.MIX, P.Wo_t, M, D, D}; pg8::StaticOrder S; S.init(M, D, F.G, (int)blockIdx.x);
        pg8::EpiWo E{P.x, P.XB1, P.mod, P.stats, P.Z2, P.a2};
        pg8::gemm_phase<pg8::EpiWo, pg8::StaticOrder, true, true>(F.lds, g, S, E);
        SEAM(4);
    }
    if (IN(5)) {   warm_buffer<4>(F, P.W1_t);
        pg8::Gemm g{P.Z2, P.W1_t, M, FF, D}; pg8::StaticOrder S; S.init(M, FF, F.G, (int)blockIdx.x);
        pg8::EpiUp E{P.H, P.stats, P.bias2, FF};
        pg8::gemm_phase<pg8::EpiUp, pg8::StaticOrder, true, true>(F.lds, g, S, E);
        SEAM(5);
    }
    if (IN(6)) {   warm_buffer<4>(F, P.W2_t);
        pg8::Gemm g{P.H, P.W2_t, M, D, FF}; pg8::StaticOrder S; S.init(M, D, F.G, (int)blockIdx.x, pg8::WGM, 1);
        pg8::EpiDown E{P.out, P.XB1, P.mod};
        pg8::gemm_phase<pg8::EpiDown, pg8::StaticOrder, true, true>(F.lds, g, S, E);
    }
#undef IN
#undef SEAM
}

extern "C" void kernel_launch(void* const* d_in, const int* in_sizes, int n_in, void* d_out, int out_size, void* d_ws, size_t ws_size, hipStream_t stream) {
    static int grid = 0;
    if (grid == 0) {
        if (n_in != 16 || out_size != M * D || ws_size < WS_END) { fprintf(stderr, "kernel_launch: unexpected shapes (n_in %d out %d ws %zu)\n", n_in, out_size, ws_size); grid = -1; return; }
        int dev = 0, cus = 0, per_cu = 0;
        if (hipGetDevice(&dev) != hipSuccess || hipDeviceGetAttribute(&cus, hipDeviceAttributeMultiprocessorCount, dev) != hipSuccess) { grid = -1; return; }
        if (hipFuncSetAttribute((const void*)fwd_megakernel, hipFuncAttributeMaxDynamicSharedMemorySize, LDS_BYTES) != hipSuccess) { fprintf(stderr, "kernel_launch: hipFuncSetAttribute failed\n"); grid = -1; return; }
        if (hipOccupancyMaxActiveBlocksPerMultiprocessor(&per_cu, (const void*)fwd_megakernel, NWAVES * 64, LDS_BYTES) != hipSuccess || per_cu < 1) { fprintf(stderr, "kernel_launch: occupancy query says %d\n", per_cu); per_cu = 1; }
        (void)hipGetLastError();
        if (per_cu > 1) per_cu = 1;
        grid = cus * per_cu;
    }
    if (grid < 0) return;
    (void)hipMemsetAsync((char*)d_ws + WS_CTL, 0, CTL_ZERO_BYTES, stream);
    Args a{};
    for (int i = 0; i < 16; ++i) a.in[i] = d_in[i];
    a.out = (float*)d_out; a.ws = (unsigned char*)d_ws;
    if (N_LAUNCHES == 1) { a.ph_lo = 0; a.ph_hi = N_PHASES; hipLaunchKernelGGL(fwd_megakernel, dim3(grid), dim3(NWAVES * 64), LDS_BYTES, stream, a); }
    else for (int li = 0; li < N_PHASES; ++li) { a.ph_lo = li; a.ph_hi = li + 1; hipLaunchKernelGGL(fwd_megakernel, dim3(grid), dim3(NWAVES * 64), LDS_BYTES, stream, a); }
}
```
